# Optimizing an MI355X kernel written in HIP

```python
import math, functools
import jax, jax.numpy as jnp
from jax import lax
import numpy as np

D_MODEL = 1024
BATCH = 8
SEQ = 8192
DEPTH = 2

GRID_W = 64
CTX_LEN = 256
ROPE_BASE = 10000.0
Q_BLOCK = 128
NORM_EPS = 1e-6

MLA_HEADS = 8
MLA_NOPE = 64
MLA_ROPE = 32
MLA_V = 64
MLA_Q_RANK = 384
MLA_KV_RANK = 256

GDN_HEADS = 8
GDN_DK = 64
GDN_DV = 64
GDN_CONV = 5
GDN_CHUNK = 64
GDN_QKV = GDN_HEADS * (2 * GDN_DK + GDN_DV)

DIFF_HEADS = 4
DIFF_DH = 64

GQA_HEADS = 8
GQA_KV_HEADS = 2
GQA_DH = 64
GQA_GROUP = GQA_HEADS // GQA_KV_HEADS

MIX_WIDTH = 1024
EVEN_SPLITS = (MLA_Q_RANK, MLA_KV_RANK, MLA_ROPE, GDN_QKV, GDN_HEADS * GDN_DV, 2 * GDN_HEADS, 2 * GDN_HEADS)
ODD_SPLITS = (DIFF_HEADS * 2 * DIFF_DH, DIFF_HEADS * 2 * DIFF_DH, DIFF_HEADS * 2 * DIFF_DH,
              GQA_HEADS * GQA_DH, GQA_KV_HEADS * GQA_DH, GQA_KV_HEADS * GQA_DH)
EVEN_IN = sum(EVEN_SPLITS)
ODD_IN = sum(ODD_SPLITS)

FFN_DIM = 2816
N_EXPERTS = 8
TOP_K = 2
EXPERT_DIM = 3584
MOE_BLOCK = 512

kernel_name = 'hybrid_mla_gdn_diff_gqa_moe_dit'


def rms_norm(x, g):
    xf = x.astype(jnp.float32)
    y = xf * lax.rsqrt(jnp.mean(xf * xf, axis=-1, keepdims=True) + NORM_EPS)
    return (y * g.astype(jnp.float32)).astype(x.dtype)


def l2_normalize(x):
    xf = x.astype(jnp.float32)
    return xf * lax.rsqrt(jnp.sum(xf * xf, axis=-1, keepdims=True) + NORM_EPS)


def split_cols(z, sizes):
    cuts, acc = [], 0
    for s in sizes[:-1]:
        acc += s
        cuts.append(acc)
    return jnp.split(z, cuts, axis=-1)


def modulation(cvec, w, b):
    m = jax.nn.silu(cvec) @ w + b
    m = m.reshape(cvec.shape[:-1] + (6, cvec.shape[-1]))
    return tuple(jnp.expand_dims(m[..., k, :], -2) for k in range(6))


def axial_rope_tables(n_rows, rot_dim):
    n_freq = rot_dim // 4
    inv = 1.0 / (ROPE_BASE ** (jnp.arange(n_freq, dtype=jnp.float32) / n_freq))
    rows = jnp.repeat(jnp.arange(n_rows, dtype=jnp.float32), GRID_W)
    cols = jnp.tile(jnp.arange(GRID_W, dtype=jnp.float32), n_rows)
    ang_r = rows[:, None] * inv
    ang_c = cols[:, None] * inv
    return (jnp.cos(ang_r), jnp.sin(ang_r), jnp.cos(ang_c), jnp.sin(ang_c))


def _rotate_half(x, cos, sin):
    shape = (cos.shape[0],) + (1,) * (x.ndim - 3) + (cos.shape[1],)
    cs = cos.reshape(shape).astype(x.dtype)
    sn = sin.reshape(shape).astype(x.dtype)
    x1, x2 = jnp.split(x, 2, axis=-1)
    return jnp.concatenate([x1 * cs - x2 * sn, x2 * cs + x1 * sn], axis=-1)


def apply_axial_rope(x, tables):
    cos_r, sin_r, cos_c, sin_c = tables
    x_row, x_col = jnp.split(x, 2, axis=-1)
    return jnp.concatenate([_rotate_half(x_row, cos_r, sin_r), _rotate_half(x_col, cos_c, sin_c)], axis=-1)


def depthwise_conv_centred(x, w):
    width, ch = w.shape
    return lax.conv_general_dilated(
        x, w[:, None, :].astype(x.dtype), window_strides=(1,),
        padding=[(width // 2, width // 2)],
        dimension_numbers=('NWC', 'WIO', 'NWC'), feature_group_count=ch)


def sweep_query_blocks(fn, q):
    bsz, tq = q.shape[:2]
    nb = tq // Q_BLOCK
    qb = jnp.swapaxes(q.reshape((bsz, nb, Q_BLOCK) + q.shape[2:]), 0, 1)
    o = lax.map(fn, qb)
    return jnp.swapaxes(o, 0, 1).reshape((bsz, tq) + o.shape[3:])


def softmax_attention(q, k, v):
    scale = q.shape[-1] ** -0.5

    def block(qb):
        s = jnp.einsum('bqhgd,bkhd->bhgqk', qb, k, preferred_element_type=jnp.float32) * scale
        p = jax.nn.softmax(s, axis=-1).astype(v.dtype)
        return jnp.einsum('bhgqk,bkhe->bqhge', p, v)

    return sweep_query_blocks(block, q)


def differential_attention(q, k, v, lam):
    scale = q.shape[-1] ** -0.5

    def block(qb):
        s = jnp.einsum('bqhmd,bkhmd->bhmqk', qb, k, preferred_element_type=jnp.float32) * scale
        p = jax.nn.softmax(s, axis=-1)
        p = (p[:, :, 0] - lam * p[:, :, 1]).astype(v.dtype)
        return jnp.einsum('bhqk,bkhe->bqhe', p, v)

    return sweep_query_blocks(block, q)


def gated_delta_chunked(q, k, v, g, beta, s0):
    bsz, t, h, dk = k.shape
    dv = v.shape[-1]
    n = t // GDN_CHUNK

    def chunks(a):
        a = a.reshape((bsz, n, GDN_CHUNK, h) + a.shape[3:])
        return jnp.moveaxis(a, (1, 3), (0, 2))

    qc, kc, vc, bc = chunks(q), chunks(k), chunks(v), chunks(beta)
    gc = jnp.cumsum(chunks(g), axis=-1)
    pos = jnp.arange(GDN_CHUNK)
    incl = pos[:, None] >= pos[None, :]
    decay = jnp.exp(jnp.where(incl, gc[..., :, None] - gc[..., None, :], -jnp.inf))
    kbk = jnp.einsum('nbhcd,nbhsd->nbhcs', kc * bc[..., None], kc) * decay
    lower = jnp.where(pos[:, None] > pos[None, :], kbk, 0.0) + jnp.eye(GDN_CHUNK, dtype=kbk.dtype)
    rhs = jnp.concatenate([vc * bc[..., None], kc * (bc * jnp.exp(gc))[..., None]], axis=-1)
    sol = lax.linalg.triangular_solve(lower, rhs, left_side=True, lower=True, unit_diagonal=True)
    u, w = sol[..., :dv], sol[..., dv:]
    qk = jnp.einsum('nbhcd,nbhsd->nbhcs', qc, kc) * decay
    q_dec = qc * jnp.exp(gc)[..., None]
    k_dec = kc * jnp.exp(gc[..., -1:] - gc)[..., None]
    chunk_decay = jnp.exp(gc[..., -1])

    def step(state, inp):
        u_i, w_i, qk_i, qd_i, kd_i, cd_i = inp
        v_new = u_i - jnp.einsum('bhcd,bhde->bhce', w_i, state)
        o_i = jnp.einsum('bhcd,bhde->bhce', qd_i, state) + jnp.einsum('bhcs,bhse->bhce', qk_i, v_new)
        state = state * cd_i[..., None, None] + jnp.einsum('bhcd,bhce->bhde', kd_i, v_new)
        return state, o_i

    state, o = lax.scan(step, s0, (u, w, qk, q_dec, k_dec, chunk_decay))
    o = jnp.moveaxis(o, (0, 2), (1, 3)).reshape(bsz, t, h, dv)
    return o, state


def swiglu(h, w_gu, w_down):
    gate, up = jnp.split(h @ w_gu, 2, axis=-1)
    return (jax.nn.silu(gate) * up) @ w_down


def moe_swiglu(h, router_w, w_gu, w_down):
    shape = h.shape
    xt = h.reshape(-1, shape[-1])
    n_tok = xt.shape[0]
    nk = n_tok * TOP_K
    logits = jnp.einsum('nd,de->ne', xt, router_w, preferred_element_type=jnp.float32)
    top_logit, top_e = lax.top_k(logits, TOP_K)
    top_w = jax.nn.softmax(top_logit, axis=-1)
    flat_e = top_e.reshape(-1)
    flat_tok = jnp.repeat(jnp.arange(n_tok, dtype=jnp.int32), TOP_K)
    flat_w = top_w.reshape(-1)
    order = jnp.argsort(flat_e)
    e_sorted = flat_e[order]
    counts = jnp.bincount(flat_e, length=N_EXPERTS)
    padded = (counts + MOE_BLOCK - 1) // MOE_BLOCK * MOE_BLOCK
    pad_end = jnp.cumsum(padded)
    pad_start = pad_end - padded
    start = jnp.cumsum(counts) - counts
    dest = pad_start[e_sorted] + jnp.arange(nk, dtype=jnp.int32) - start[e_sorted]
    n_blocks = -(-nk // MOE_BLOCK) + N_EXPERTS
    rows = n_blocks * MOE_BLOCK
    buf_tok = jnp.full((rows,), n_tok, jnp.int32).at[dest].set(flat_tok[order])
    buf_w = jnp.zeros((rows,), jnp.float32).at[dest].set(flat_w[order])
    block_e = jnp.minimum(
        jnp.searchsorted(pad_end, jnp.arange(n_blocks) * MOE_BLOCK, side='right'), N_EXPERTS - 1)

    def run_block(args):
        tok, e = args
        xb = jnp.take(xt, tok, axis=0, mode='clip')
        return swiglu(xb, w_gu[e], w_down[e])

    y = lax.map(run_block, (buf_tok.reshape(n_blocks, MOE_BLOCK), block_e))
    y = y.reshape(rows, -1) * buf_w[:, None].astype(y.dtype)
    out = jnp.zeros_like(xt).at[buf_tok].add(y, mode='drop')
    return out.reshape(shape)


def mla_gdn_mixer(h_ctx, h_lat, rope_lat, need_ctx, w_in, q_norm, kv_norm, w_uq, w_ukv,
                  conv_w, a_log, dt_bias, out_norm, w_out):
    pc = split_cols(h_ctx @ w_in, EVEN_SPLITS)
    pl = split_cols(h_lat @ w_in, EVEN_SPLITS)

    def mla_qkv(cq, ckv, k_pe, rope):
        bsz, t = cq.shape[:2]
        q = (rms_norm(cq, q_norm) @ w_uq).reshape(bsz, t, MLA_HEADS, MLA_NOPE + MLA_ROPE)
        kv = (rms_norm(ckv, kv_norm) @ w_ukv).reshape(bsz, t, MLA_HEADS, MLA_NOPE + MLA_V)
        q_nope, q_pe = jnp.split(q, [MLA_NOPE], axis=-1)
        k_nope, v = jnp.split(kv, [MLA_NOPE], axis=-1)
        k_pe = k_pe[:, :, None, :]
        if rope is not None:
            q_pe = apply_axial_rope(q_pe, rope)
            k_pe = apply_axial_rope(k_pe, rope)
        q = jnp.concatenate([q_nope, q_pe], axis=-1)[:, :, :, None, :]
        k = jnp.concatenate([k_nope, jnp.broadcast_to(k_pe, (bsz, t, MLA_HEADS, MLA_ROPE))], axis=-1)
        return q, k, v

    qc, kc, vc = mla_qkv(pc[0], pc[1], pc[2], None)
    ql, kl, vl = mla_qkv(pl[0], pl[1], pl[2], rope_lat)
    bsz, t_lat = h_lat.shape[:2]
    mla_lat = softmax_attention(ql, jnp.concatenate([kc, kl], axis=1),
                                jnp.concatenate([vc, vl], axis=1)).reshape(bsz, t_lat, MLA_HEADS * MLA_V)

    def gdn_prepare(qkv, a, b):
        t = qkv.shape[1]
        qkv = jax.nn.silu(depthwise_conv_centred(qkv, conv_w))
        q, k, v = split_cols(qkv, (GDN_HEADS * GDN_DK, GDN_HEADS * GDN_DK, GDN_HEADS * GDN_DV))
        q = l2_normalize(q.reshape(bsz, t, GDN_HEADS, GDN_DK)) * GDN_DK ** -0.5
        k = l2_normalize(k.reshape(bsz, t, GDN_HEADS, GDN_DK))
        v = v.reshape(bsz, t, GDN_HEADS, GDN_DV).astype(jnp.float32)
        g = -jnp.exp(a_log.astype(jnp.float32)) * jax.nn.softplus(
            a.reshape(bsz, t, 2, GDN_HEADS).astype(jnp.float32) + dt_bias.astype(jnp.float32))
        beta = jax.nn.sigmoid(b.reshape(bsz, t, 2, GDN_HEADS).astype(jnp.float32))
        return q, k, v, g, beta

    def gdn_bidirectional(inputs, s_fwd, s_bwd):
        q, k, v, g, beta = inputs
        rev = lambda a: jnp.flip(a, axis=1)
        o_f, s_fwd = gated_delta_chunked(q, k, v, g[:, :, 0], beta[:, :, 0], s_fwd)
        o_b, s_bwd = gated_delta_chunked(rev(q), rev(k), rev(v), rev(g[:, :, 1]), rev(beta[:, :, 1]), s_bwd)
        return o_f + rev(o_b), s_fwd, s_bwd

    def gdn_output(o, z):
        t = z.shape[1]
        o = rms_norm(o, out_norm) * jax.nn.silu(z.reshape(bsz, t, GDN_HEADS, GDN_DV).astype(jnp.float32))
        return o.reshape(bsz, t, GDN_HEADS * GDN_DV).astype(z.dtype)

    s0 = jnp.zeros((bsz, GDN_HEADS, GDN_DK, GDN_DV), jnp.float32)
    o_c, s_f, s_b = gdn_bidirectional(gdn_prepare(pc[3], pc[5], pc[6]), s0, s0)
    o_l, _, _ = gdn_bidirectional(gdn_prepare(pl[3], pl[5], pl[6]), s_f, s_b)

    out_lat = jnp.concatenate([mla_lat, gdn_output(o_l, pl[4])], axis=-1) @ w_out
    if not need_ctx:
        return None, out_lat
    mla_ctx = softmax_attention(qc, kc, vc).reshape(bsz, h_ctx.shape[1], MLA_HEADS * MLA_V)
    out_ctx = jnp.concatenate([mla_ctx, gdn_output(o_c, pc[4])], axis=-1) @ w_out
    return out_ctx, out_lat


def diff_gqa_mixer(h_ctx, h_lat, rope_diff, rope_gqa, need_ctx, lambda_init, w_in, diff_lambda,
                   diff_norm, q_norm, k_norm, w_out):
    def heads(h, use_rope):
        bsz, t = h.shape[:2]
        dq, dk, dv, gq, gk, gv = split_cols(h @ w_in, ODD_SPLITS)
        dq = dq.reshape(bsz, t, DIFF_HEADS, 2, DIFF_DH)
        dk = dk.reshape(bsz, t, DIFF_HEADS, 2, DIFF_DH)
        dv = dv.reshape(bsz, t, DIFF_HEADS, 2 * DIFF_DH)
        gq = rms_norm(gq.reshape(bsz, t, GQA_HEADS, GQA_DH), q_norm)
        gk = rms_norm(gk.reshape(bsz, t, GQA_KV_HEADS, GQA_DH), k_norm)
        gv = gv.reshape(bsz, t, GQA_KV_HEADS, GQA_DH)
        if use_rope:
            dq, dk = apply_axial_rope(dq, rope_diff), apply_axial_rope(dk, rope_diff)
            gq, gk = apply_axial_rope(gq, rope_gqa), apply_axial_rope(gk, rope_gqa)
        return dq, dk, dv, gq.reshape(bsz, t, GQA_KV_HEADS, GQA_GROUP, GQA_DH), gk, gv

    lam_p = diff_lambda.astype(jnp.float32)
    lam = jnp.exp(jnp.sum(lam_p[0] * lam_p[1])) - jnp.exp(jnp.sum(lam_p[2] * lam_p[3])) + lambda_init

    def mix(dq, gq, dk, dv, gk, gv):
        bsz, t = dq.shape[:2]
        d = differential_attention(dq, dk, dv, lam)
        d = (rms_norm(d, diff_norm) * (1.0 - lambda_init)).reshape(bsz, t, DIFF_HEADS * 2 * DIFF_DH)
        a = softmax_attention(gq, gk, gv).reshape(bsz, t, GQA_HEADS * GQA_DH)
        return jnp.concatenate([d, a], axis=-1) @ w_out

    cdq, cdk, cdv, cgq, cgk, cgv = heads(h_ctx, False)
    ldq, ldk, ldv, lgq, lgk, lgv = heads(h_lat, True)
    cat = lambda a, b: jnp.concatenate([a, b], axis=1)
    out_lat = mix(ldq, lgq, cat(cdk, ldk), cat(cdv, ldv), cat(cgk, lgk), cat(cgv, lgv))
    out_ctx = mix(cdq, cgq, cdk, cdv, cgk, cgv) if need_ctx else None
    return out_ctx, out_lat


def setup_inputs(seed: int = 0) -> dict:
    key = jax.random.key(seed)
    keys = jax.random.split(key, 32)
    counter = iter(range(32))
    f32 = jnp.float32

    def normal(shape, scale):
        return jax.random.normal(keys[next(counter)], shape, f32) * scale

    def gain(shape):
        return 1.0 + 0.02 * jax.random.normal(keys[next(counter)], shape, f32)

    n_ev, n_od = (DEPTH + 1) // 2, DEPTH // 2
    d = D_MODEL
    a_log = jnp.log(jax.random.uniform(keys[next(counter)], (n_ev, 2, GDN_HEADS), f32, 1.0, 16.0))
    dt = jnp.exp(jax.random.uniform(keys[next(counter)], (n_ev, 2, GDN_HEADS), f32,
                                    math.log(1e-3), math.log(1e-1)))
    dt_bias = dt + jnp.log(-jnp.expm1(-dt))
    return {
        'x': normal((BATCH, SEQ, d), 1.0),
        'c': normal((BATCH, d), 1.0),
        'ctx': normal((BATCH, CTX_LEN, d), 1.0),
        'c_ctx': normal((d,), 1.0),
        'mod_w': normal((DEPTH, d, 6 * d), d ** -0.5),
        'mod_b': normal((DEPTH, 6 * d), 0.02),
        'norm_g': gain((DEPTH, 2, d)),
        'ev_w_in': normal((n_ev, d, EVEN_IN), d ** -0.5),
        'ev_mla_q_norm': gain((n_ev, MLA_Q_RANK)),
        'ev_mla_kv_norm': gain((n_ev, MLA_KV_RANK)),
        'ev_mla_w_uq': normal((n_ev, MLA_Q_RANK, MLA_HEADS * (MLA_NOPE + MLA_ROPE)), MLA_Q_RANK ** -0.5),
        'ev_mla_w_ukv': normal((n_ev, MLA_KV_RANK, MLA_HEADS * (MLA_NOPE + MLA_V)), MLA_KV_RANK ** -0.5),
        'ev_gdn_conv': normal((n_ev, GDN_CONV, GDN_QKV), GDN_CONV ** -0.5),
        'ev_gdn_a_log': a_log,
        'ev_gdn_dt_bias': dt_bias,
        'ev_gdn_out_norm': gain((n_ev, GDN_DV)),
        'ev_w_out': normal((n_ev, MIX_WIDTH, d), MIX_WIDTH ** -0.5),
        'ev_ffn_w_gu': normal((n_ev, d, 2 * FFN_DIM), d ** -0.5),
        'ev_ffn_w_down': normal((n_ev, FFN_DIM, d), FFN_DIM ** -0.5),
        'od_w_in': normal((n_od, d, ODD_IN), d ** -0.5),
        'od_diff_lambda': normal((n_od, 4, DIFF_DH), 0.1),
        'od_diff_norm': gain((n_od, 2 * DIFF_DH)),
        'od_gqa_q_norm': gain((n_od, GQA_DH)),
        'od_gqa_k_norm': gain((n_od, GQA_DH)),
        'od_w_out': normal((n_od, MIX_WIDTH, d), MIX_WIDTH ** -0.5),
        'od_router_w': normal((n_od, d, N_EXPERTS), d ** -0.5),
        'od_moe_w_gu': normal((n_od, N_EXPERTS, d, 2 * EXPERT_DIM), d ** -0.5),
        'od_moe_w_down': normal((n_od, N_EXPERTS, EXPERT_DIM, d), EXPERT_DIM ** -0.5),
        'final_norm': gain((d,)),
    }


def reference(x, c, ctx, c_ctx, mod_w, mod_b, norm_g, ev_w_in, ev_mla_q_norm, ev_mla_kv_norm,
              ev_mla_w_uq, ev_mla_w_ukv, ev_gdn_conv, ev_gdn_a_log, ev_gdn_dt_bias, ev_gdn_out_norm,
              ev_w_out, ev_ffn_w_gu, ev_ffn_w_down, od_w_in, od_diff_lambda, od_diff_norm,
              od_gqa_q_norm, od_gqa_k_norm, od_w_out, od_router_w, od_moe_w_gu, od_moe_w_down,
              final_norm):
    n_rows = x.shape[1] // GRID_W
    rope_mla = axial_rope_tables(n_rows, MLA_ROPE)
    rope_diff = axial_rope_tables(n_rows, DIFF_DH)
    rope_gqa = axial_rope_tables(n_rows, GQA_DH)
    for i in range(DEPTH):
        last = i == DEPTH - 1
        j = i // 2
        sh1, sc1, gt1, sh2, sc2, gt2 = modulation(c, mod_w[i], mod_b[i])
        csh1, csc1, cgt1, csh2, csc2, cgt2 = modulation(c_ctx, mod_w[i], mod_b[i])
        h_lat = rms_norm(x, norm_g[i, 0]) * (1.0 + sc1) + sh1
        h_ctx = rms_norm(ctx, norm_g[i, 0]) * (1.0 + csc1) + csh1
        if i % 2 == 0:
            mix_ctx, mix_lat = mla_gdn_mixer(
                h_ctx, h_lat, rope_mla, not last, ev_w_in[j], ev_mla_q_norm[j], ev_mla_kv_norm[j],
                ev_mla_w_uq[j], ev_mla_w_ukv[j], ev_gdn_conv[j], ev_gdn_a_log[j], ev_gdn_dt_bias[j],
                ev_gdn_out_norm[j], ev_w_out[j])
            ffn = functools.partial(swiglu, w_gu=ev_ffn_w_gu[j], w_down=ev_ffn_w_down[j])
        else:
            lambda_init = 0.8 - 0.6 * math.exp(-0.3 * i)
            mix_ctx, mix_lat = diff_gqa_mixer(
                h_ctx, h_lat, rope_diff, rope_gqa, not last, lambda_init, od_w_in[j],
                od_diff_lambda[j], od_diff_norm[j], od_gqa_q_norm[j], od_gqa_k_norm[j], od_w_out[j])
            ffn = functools.partial(moe_swiglu, router_w=od_router_w[j], w_gu=od_moe_w_gu[j],
                                    w_down=od_moe_w_down[j])
        x = x + gt1 * mix_lat
        x = x + gt2 * ffn(rms_norm(x, norm_g[i, 1]) * (1.0 + sc2) + sh2)
        if not last:
            ctx = ctx + cgt1 * mix_ctx
            ctx = ctx + cgt2 * ffn(rms_norm(ctx, norm_g[i, 1]) * (1.0 + csc2) + csh2)
    return rms_norm(x, final_norm)
```

```cpp
#include <hip/hip_runtime.h>
#include <cstdio>
#include <cstdint>

#define LAS __attribute__((address_space(3)))
#define GAS __attribute__((address_space(1)))
typedef unsigned short bf16_t;
typedef short bf16x8 __attribute__((ext_vector_type(8)));
typedef short s16x4 __attribute__((ext_vector_type(4)));
typedef float f32x4 __attribute__((ext_vector_type(4)));
typedef float f32x2 __attribute__((ext_vector_type(2)));
typedef float f32x16 __attribute__((ext_vector_type(16)));
typedef unsigned u32x4 __attribute__((ext_vector_type(4)));
typedef unsigned u32x2 __attribute__((ext_vector_type(2)));
typedef int i32x4 __attribute__((ext_vector_type(4)));

#ifndef I8_STRIP
#define I8_STRIP 1
#endif
#ifndef I8_WIN0
#define I8_WIN0 1
#endif
#ifndef I8_GU0
#define I8_GU0 1
#endif
#ifndef I8_WIN1
#define I8_WIN1 1
#endif
constexpr int DM = 1024, NBATCH = 8, SEQ = 8192, CTXL = 256, TT = SEQ + CTXL;
constexpr int GB = 4, NGRP = NBATCH / GB, RROWS = GB * TT, RTILES = RROWS / 256;
constexpr int EV_IN = 2752, EV_INP = 2816, OD_IN = 2304, FFN = 2816, EXD = 3584, NEXP = 8;
constexpr int MOD_ROW = 6 * DM;
constexpr int NTOK_G = GB * SEQ;
constexpr int MOE_ROWS = 2 * NTOK_G + NEXP * 256;
constexpr float NORM_EPS = 1e-6f;
constexpr float ATT_C64 = 0.125f * 1.4426950408889634f, ATT_C96 = 0.10206207261596575f * 1.4426950408889634f;
constexpr int PC_CQ = 0, PC_CKV = 384, PC_KPE = 640, PC_GQKV = 672, PC_Z = 2208, PC_A = 2720, PC_B = 2736;
constexpr int P1_DQ = 0, P1_DK = 512, P1_DV = 1024, P1_GQ = 1536, P1_GK = 2048, P1_GV = 2176;
constexpr int NCHUNK = TT / 64;
constexpr int GPRE_CHUNK = 3 * 8192;

constexpr size_t MiB = 1u << 20;
constexpr size_t WS_CTL = 0, CTL_BYTES = 1 * MiB;
constexpr size_t WS_MOD = 1 * MiB;
constexpr size_t WS_TAB8 = WS_MOD + 448 * 1024;
constexpr size_t WS_TAB16 = WS_TAB8 + 8 * 1024;
constexpr size_t WS_TOPE = WS_TAB16 + 16 * 1024;
constexpr size_t WS_TOPW = WS_TOPE + 256 * 1024;
constexpr size_t WS_SLOT = WS_TOPW + 256 * 1024;
constexpr size_t WS_SWD = 2 * MiB + 256 * 1024;
constexpr size_t WS_SATOK = 2 * MiB + 512 * 1024;
constexpr size_t WS_SWD2 = 2 * MiB + 704 * 1024;
static_assert(WS_SLOT + 256 * 1024 <= WS_SWD && WS_SWD + 8 * 7168 * 4 <= WS_SATOK && WS_SATOK + RROWS * 4 <= WS_SWD2 && WS_SWD2 + (2816 + 5632 + 2304) * 4 <= 3 * MiB, "small region");
constexpr size_t WS_CX = 3 * MiB;
constexpr size_t WS_W = 11 * MiB;
constexpr size_t WS_WI0 = WS_W;
constexpr size_t WS_WUQ = WS_WI0 + (size_t)EV_INP * 1024 * 2;
constexpr size_t WS_WUKV = WS_WUQ + (size_t)768 * 384 * 2;
constexpr size_t WS_WO0 = WS_WUKV + (size_t)1024 * 256 * 2;
constexpr size_t WS_WGU0 = WS_WO0 + (size_t)1024 * 1024 * 2;
constexpr size_t WS_WD0 = WS_WGU0 + (size_t)2 * FFN * 1024 * 2;
constexpr size_t WS_WI1 = WS_WD0 + (size_t)1024 * FFN * 2;
constexpr size_t WS_WO1 = WS_WI1 + (size_t)OD_IN * 1024 * 2;
constexpr size_t WS_WGU1 = WS_WO1 + (size_t)1024 * 1024 * 2;
constexpr size_t WS_WD1 = WS_WGU1 + (size_t)NEXP * 2 * EXD * 1024 * 2;
constexpr size_t WS_WEND = WS_WD1 + (size_t)NEXP * 1024 * EXD * 2;
static_assert(WS_WEND <= 211 * MiB, "weights region");
constexpr size_t WS_HB = 211 * MiB;
constexpr size_t WS_PB = 277 * MiB;
constexpr size_t WS_QR = 459 * MiB;
constexpr size_t WS_KV = 509 * MiB;
constexpr size_t WS_KPE = 575 * MiB;
constexpr size_t WS_GQ = 578 * MiB, WS_GK = 611 * MiB, WS_GV = 644 * MiB;
constexpr size_t WS_GG = 677 * MiB, WS_GBT = 680 * MiB;
constexpr size_t WS_OF = 683 * MiB, WS_OB = 716 * MiB;
constexpr size_t WS_GPRE = 749 * MiB;
constexpr size_t WS_ACT1 = 277 * MiB;
constexpr size_t WS_PART = 749 * MiB;
constexpr size_t WS_XG = 749 * MiB;
constexpr size_t WS_X16 = 947 * MiB;
constexpr size_t WS_GCB = 1011 * MiB;
constexpr size_t WS_END = 1014 * MiB;
static_assert(WS_ACT1 + (size_t)MOE_ROWS * EXD * 2 <= WS_XG && WS_XG + (size_t)MOE_ROWS * 1024 * 2 <= WS_END, "moe map");
static_assert(WS_GPRE + (size_t)GB * 8 * 2 * NCHUNK * GPRE_CHUNK <= WS_END, "gpre map");
constexpr int CW_BAR = 4096;
constexpr int CW_KMAX = 40960;
constexpr int CW_SWMAX = 65536;
constexpr int CW_SWMAX2 = 122880;
constexpr int CW_WGB = 32768;
constexpr int CW_CNT = 16384;

constexpr int RING_BYTES = 131072;
constexpr int LDSCTL_OFF = 147456;
constexpr int LDS_BYTES = 163840;
constexpr int NWAVES = 8, NTHREADS = 512;

#define RLX_AGENT __ATOMIC_RELAXED, __HIP_MEMORY_SCOPE_AGENT
__device__ __forceinline__ unsigned f2bf(float f) { unsigned u = __builtin_bit_cast(unsigned, f); return (u + 0x7fffu + ((u >> 16) & 1u)) >> 16; }
__device__ __forceinline__ unsigned pk2(float lo, float hi) { return f2bf(lo) | (f2bf(hi) << 16); }
__device__ __forceinline__ float bflo(unsigned w) { return __builtin_bit_cast(float, w << 16); }
__device__ __forceinline__ float bfhi(unsigned w) { return __builtin_bit_cast(float, w & 0xffff0000u); }
__device__ __forceinline__ float bf2f(bf16_t v) { return __builtin_bit_cast(float, (unsigned)v << 16); }
typedef __bf16 bf16x2_t __attribute__((ext_vector_type(2)));
__device__ __forceinline__ unsigned cvt_pk_bf16(float lo, float hi) { const f32x2 v = {lo, hi}; return __builtin_bit_cast(unsigned, __builtin_convertvector(v, bf16x2_t)); }
__device__ __forceinline__ float sx(float v, int mask, int lane) { return __builtin_bit_cast(float, __builtin_amdgcn_ds_bpermute((lane ^ mask) << 2, __builtin_bit_cast(int, v))); }
template <int CTRL> __device__ __forceinline__ float dppf(float v) { return __builtin_bit_cast(float, __builtin_amdgcn_update_dpp(0, __builtin_bit_cast(int, v), CTRL, 0xf, 0xf, true)); }
template <int N> __device__ __forceinline__ float red_sum(float v) {
    if constexpr (N >= 2) v += dppf<0xB1>(v);
    if constexpr (N >= 4) v += dppf<0x4E>(v);
    if constexpr (N >= 8) v += dppf<0x141>(v);
    if constexpr (N >= 16) v += dppf<0x140>(v);
    if constexpr (N >= 32) { auto rr = __builtin_amdgcn_permlane16_swap(__float_as_uint(v), __float_as_uint(v), false, false); v = __uint_as_float(rr[0]) + __uint_as_float(rr[1]); }
    if constexpr (N >= 64) { auto rr = __builtin_amdgcn_permlane32_swap(__float_as_uint(v), __float_as_uint(v), false, false); v = __uint_as_float(rr[0]) + __uint_as_float(rr[1]); }
    return v;
}
template <int N> __device__ __forceinline__ float red_max(float v) {
    if constexpr (N >= 2) v = fmaxf(v, dppf<0xB1>(v));
    if constexpr (N >= 4) v = fmaxf(v, dppf<0x4E>(v));
    if constexpr (N >= 8) v = fmaxf(v, dppf<0x141>(v));
    if constexpr (N >= 16) v = fmaxf(v, dppf<0x140>(v));
    if constexpr (N >= 32) { auto rr = __builtin_amdgcn_permlane16_swap(__float_as_uint(v), __float_as_uint(v), false, false); v = fmaxf(__uint_as_float(rr[0]), __uint_as_float(rr[1])); }
    if constexpr (N >= 64) { auto rr = __builtin_amdgcn_permlane32_swap(__float_as_uint(v), __float_as_uint(v), false, false); v = fmaxf(__uint_as_float(rr[0]), __uint_as_float(rr[1])); }
    return v;
}
__device__ __forceinline__ float wave_sum(float v, int lane) { (void)lane; return red_sum<64>(v); }
__device__ __forceinline__ float silu_f(float x) { return x * __builtin_amdgcn_rcpf(1.f + __expf(-x)); }
__device__ __forceinline__ float rsq_f(float x) { return __builtin_amdgcn_rsqf(x); }

namespace pg8 {
constexpr int BM = 256, BK = 64, HALF = 128, HTB = HALF * BK * 2, STAGE_BYTES = 8 * HTB, NXCD = 8, WGM = 4;
__host__ __device__ __forceinline__ int lds_byte(int r, int c) { const int st = (r >> 4) * 2 + (c >> 5), rr = r & 15, cc = c & 31, ob = rr * 64 + cc * 2; return st * 1024 + (ob ^ (((ob >> 9) & 1) << 5)); }
__host__ __device__ __forceinline__ void stage_rc(int b, int& R, int& C) { const int st = b / 1024, sb = b % 1024, swz = sb ^ (((sb >> 9) & 1) << 5); R = (st >> 1) * 16 + swz / 64; C = (st & 1) * 32 + (swz % 64) / 2; }
__host__ __device__ __forceinline__ int perm32(int rho) { const int n = rho >> 4, i = rho & 15; return 8 * (i >> 2) + 4 * n + (i & 3); }

struct Unit { int pm, pn; size_t boff, aoff; };
struct Gemm { const bf16_t* A; const bf16_t* Bt; int M, N, K, lda, ldb; const int* rowtab; };

struct StaticOrder {
    int nM, nN, nwg, G, c, lat, wgm; const int* tend; size_t estride;
    __device__ void init(int M, int N, int G_, int c_, int lat_ = 0, int wgm_ = WGM) { nM = M / BM; nN = N / BM; nwg = nM * nN; G = G_; c = c_; tend = nullptr; estride = 0; lat = lat_; wgm = wgm_; }
    __device__ bool next(int i, Unit& u) const {
        const long L = (long)i * G + c; if (L >= nwg) return false;
        int wgid = (int)L; { const int q = nwg / NXCD, r = nwg % NXCD, xcd = wgid % NXCD, off = wgid / NXCD; wgid = (xcd < r ? xcd * (q + 1) : r * (q + 1) + (xcd - r) * q) + off; }
        const int nig = wgm * nN, gid = wgid / nig, fm = gid * wgm, gsz = (nM - fm) < wgm ? (nM - fm) : wgm;
        u.pm = fm + ((wgid % nig) % gsz); u.pn = (wgid % nig) / gsz; u.boff = 0; u.aoff = 0;
        if (lat) u.pm = u.pm + (u.pm >> 5) + 1;
        if (tend) { int e = 0;
#pragma unroll
            for (int j = 0; j < 7; ++j) e += (u.pm >= tend[j]) ? 1 : 0;
            u.boff = (size_t)e * estride; }
        return true;
    }
};

struct CtxSplitOrder {
    int S, G, c;
    __device__ void init(int S_, int G_, int c_) { S = S_; G = G_; c = c_; }
    __device__ bool next(int i, Unit& u) const {
        const int L = i * G + c; if (L >= GB * 4 * S) return false;
        const int sl = L % S, r = L / S; u.pn = r & 3; u.pm = (r >> 2) * 33; u.boff = (size_t)sl * 512; u.aoff = (size_t)sl * 512; return true;
    }
};
struct EpiBf16 {
    static constexpr bool PERM = true;
    bf16_t* O; int ldc;
    __device__ __forceinline__ void operator()(const f32x4 (&acc)[2][2][4][2], const Unit& u, int wr, int wc, int fr_, int fq) const {
        const int fr = fr_;
        const int row0 = u.pm * BM + wr * 64 + fr, col0 = u.pn * BM + wc * 32 + 8 * fq;
#pragma unroll
        for (int ai = 0; ai < 2; ++ai)
#pragma unroll
            for (int m = 0; m < 4; ++m) { bf16_t* rowp = O + (size_t)(row0 + ai * HALF + m * 16) * ldc + col0;
#pragma unroll
                for (int bj = 0; bj < 2; ++bj) { const f32x4 v0 = acc[ai][bj][m][0], v1 = acc[ai][bj][m][1];
                    u32x4 w; w.x = cvt_pk_bf16(v0[0], v0[1]); w.y = cvt_pk_bf16(v0[2], v0[3]); w.z = cvt_pk_bf16(v1[0], v1[1]); w.w = cvt_pk_bf16(v1[2], v1[3]);
                    *(u32x4*)(rowp + bj * HALF) = w; } }
    }
};
struct EpiBf16I8 {
    static constexpr bool PERM = true;
    bf16_t* O; int ldc; const float* sa; const float* swd;
    __device__ __forceinline__ void operator()(const i32x4 (&acc)[2][2][4][2], const Unit& u, int wr, int wc, int fr_, int fq) const {
        const int fr = fr_;
        const int row0 = u.pm * BM + wr * 64 + fr, col0 = u.pn * BM + wc * 32 + 8 * fq;
        f32x4 sw[2][2];
#pragma unroll
        for (int bj = 0; bj < 2; ++bj) { sw[bj][0] = *(const f32x4*)(swd + col0 + bj * HALF); sw[bj][1] = *(const f32x4*)(swd + col0 + bj * HALF + 4); }
        float srv[2][4];
#pragma unroll
        for (int ai = 0; ai < 2; ++ai)
#pragma unroll
            for (int m = 0; m < 4; ++m) srv[ai][m] = sa[row0 + ai * HALF + m * 16];
#pragma unroll
        for (int ai = 0; ai < 2; ++ai)
#pragma unroll
            for (int m = 0; m < 4; ++m) { const int row = row0 + ai * HALF + m * 16; bf16_t* rowp = O + (size_t)row * ldc + col0; const float sr = srv[ai][m];
#pragma unroll
                for (int bj = 0; bj < 2; ++bj) { const i32x4 a0 = acc[ai][bj][m][0], a1 = acc[ai][bj][m][1]; const f32x4 s0 = sw[bj][0] * sr, s1 = sw[bj][1] * sr;
                    u32x4 w; w.x = cvt_pk_bf16((float)a0[0] * s0[0], (float)a0[1] * s0[1]); w.y = cvt_pk_bf16((float)a0[2] * s0[2], (float)a0[3] * s0[3]);
                    w.z = cvt_pk_bf16((float)a1[0] * s1[0], (float)a1[1] * s1[1]); w.w = cvt_pk_bf16((float)a1[2] * s1[2], (float)a1[3] * s1[3]);
                    *(u32x4*)(rowp + bj * HALF) = w; } }
    }
};
struct EpiSwiGLU {
    static constexpr bool PERM = true;
    bf16_t* O; int ldc;
    __device__ __forceinline__ void operator()(const f32x4 (&acc)[2][2][4][2], const Unit& u, int wr, int wc, int fr_, int fq) const {
        const int fr = fr_;
        const int row0 = u.pm * BM + wr * 64 + fr, col0 = u.pn * HALF + wc * 32 + 8 * fq;
#pragma unroll
        for (int ai = 0; ai < 2; ++ai)
#pragma unroll
            for (int m = 0; m < 4; ++m) { bf16_t* rowp = O + (size_t)(row0 + ai * HALF + m * 16) * ldc + col0;
                float h[8];
#pragma unroll
                for (int n = 0; n < 2; ++n)
#pragma unroll
                    for (int e = 0; e < 4; ++e) { const float g = acc[ai][0][m][n][e], up = acc[ai][1][m][n][e]; h[n * 4 + e] = g * __builtin_amdgcn_rcpf(1.f + __builtin_amdgcn_exp2f(-1.4426950408889634f * g)) * up; }
                u32x4 w; w.x = cvt_pk_bf16(h[0], h[1]); w.y = cvt_pk_bf16(h[2], h[3]); w.z = cvt_pk_bf16(h[4], h[5]); w.w = cvt_pk_bf16(h[6], h[7]);
                *(u32x4*)rowp = w; }
    }
};
struct EpiSwiGLUI8 {
    static constexpr bool PERM = true;
    bf16_t* O; int ldc; const float* sa; const float* swd;
    __device__ __forceinline__ void operator()(const i32x4 (&acc)[2][2][4][2], const Unit& u, int wr, int wc, int fr_, int fq) const {
        const int fr = fr_;
        const int row0 = u.pm * BM + wr * 64 + fr, col0 = u.pn * HALF + wc * 32 + 8 * fq;
        const float* sw = swd + (u.boff / ((size_t)2 * EXD * 1024)) * (size_t)(2 * EXD) + u.pn * BM + wc * 32 + 8 * fq;
        const f32x4 sg0 = *(const f32x4*)sw, sg1 = *(const f32x4*)(sw + 4), su0 = *(const f32x4*)(sw + HALF), su1 = *(const f32x4*)(sw + HALF + 4);
        const float sgv[8] = {sg0.x, sg0.y, sg0.z, sg0.w, sg1.x, sg1.y, sg1.z, sg1.w}, suv[8] = {su0.x, su0.y, su0.z, su0.w, su1.x, su1.y, su1.z, su1.w};
        float srv[2][4];
#pragma unroll
        for (int ai = 0; ai < 2; ++ai)
#pragma unroll
            for (int m = 0; m < 4; ++m) srv[ai][m] = sa[row0 + ai * HALF + m * 16];
#pragma unroll
        for (int ai = 0; ai < 2; ++ai)
#pragma unroll
            for (int m = 0; m < 4; ++m) { const int row = row0 + ai * HALF + m * 16; bf16_t* rowp = O + (size_t)row * ldc + col0; const float sr = srv[ai][m];
                float h[8];
#pragma unroll
                for (int n = 0; n < 2; ++n)
#pragma unroll
                    for (int e = 0; e < 4; ++e) { const float g = (float)acc[ai][0][m][n][e] * (sr * sgv[n * 4 + e]), up = (float)acc[ai][1][m][n][e] * (sr * suv[n * 4 + e]);
                        h[n * 4 + e] = g * __builtin_amdgcn_rcpf(1.f + __builtin_amdgcn_exp2f(-1.4426950408889634f * g)) * up; }
                u32x4 w; w.x = cvt_pk_bf16(h[0], h[1]); w.y = cvt_pk_bf16(h[2], h[3]); w.z = cvt_pk_bf16(h[4], h[5]); w.w = cvt_pk_bf16(h[6], h[7]);
                *(u32x4*)rowp = w; }
    }
};
struct EpiResid {
    static constexpr bool PERM = true;
    bf16_t* X16; float* CX; const float* mod; int gidx; int grp; int skip_ctx;
    __device__ __forceinline__ void operator()(const f32x4 (&acc)[2][2][4][2], const Unit& u, int wr, int wc, int fr_, int fq) const {
        const int fr = fr_;
        const int bl = u.pm / 33, tt = u.pm % 33, b = grp * GB + bl;
        const int col0 = u.pn * BM + wc * 32 + 8 * fq;
        if (tt == 0) { if (skip_ctx) return;
            float* base = CX + (size_t)b * CTXL * DM; const float* gate = mod + 8 * MOD_ROW + gidx * DM;
#pragma unroll
            for (int bj = 0; bj < 2; ++bj) { const f32x4 g0 = *(const f32x4*)(gate + col0 + bj * HALF), g1 = *(const f32x4*)(gate + col0 + bj * HALF + 4);
#pragma unroll
                for (int ai = 0; ai < 2; ++ai) {
#pragma unroll
                    for (int m = 0; m < 4; ++m) { f32x4* p = (f32x4*)(base + (size_t)(ai * HALF + wr * 64 + m * 16 + fr) * DM + col0 + bj * HALF); p[0] = p[0] + g0 * acc[ai][bj][m][0]; p[1] = p[1] + g1 * acc[ai][bj][m][1]; }
                    asm volatile("" ::: "memory"); } }
        } else {
            bf16_t* base = X16 + ((size_t)bl * SEQ + (size_t)(tt - 1) * 256) * DM; const float* gate = mod + b * MOD_ROW + gidx * DM;
#pragma unroll
            for (int bj = 0; bj < 2; ++bj) { const f32x4 g0 = *(const f32x4*)(gate + col0 + bj * HALF), g1 = *(const f32x4*)(gate + col0 + bj * HALF + 4);
#pragma unroll
                for (int ai = 0; ai < 2; ++ai) {
#pragma unroll
                    for (int m = 0; m < 4; ++m) { u32x4* p = (u32x4*)(base + (size_t)(ai * HALF + wr * 64 + m * 16 + fr) * DM + col0 + bj * HALF); const u32x4 w = *p; const f32x4 a0 = acc[ai][bj][m][0], a1 = acc[ai][bj][m][1];
                        u32x4 o; o.x = cvt_pk_bf16(bflo(w.x) + g0.x * a0.x, bfhi(w.x) + g0.y * a0.y); o.y = cvt_pk_bf16(bflo(w.y) + g0.z * a0.z, bfhi(w.y) + g0.w * a0.w);
                        o.z = cvt_pk_bf16(bflo(w.z) + g1.x * a1.x, bfhi(w.z) + g1.y * a1.y); o.w = cvt_pk_bf16(bflo(w.w) + g1.z * a1.z, bfhi(w.w) + g1.w * a1.w); *p = o; }
                    } }
        }
    }
};

struct EpiCtxPartial {
    static constexpr bool PERM = false;
    float* PART;
    __device__ __forceinline__ void operator()(const f32x4 (&acc)[2][2][4][2], const Unit& u, int wr, int wc, int fr_, int fq) const {
        int fr = fr_; asm volatile("" : "+v"(fr));
        const int bl = u.pm / 33, sl = (int)(u.aoff >> 9);
        float* base = PART + ((size_t)sl * (GB * CTXL) + (size_t)bl * CTXL) * DM;
        const int col0 = u.pn * BM + wc * 32 + 4 * fq;
#pragma unroll
        for (int ai = 0; ai < 2; ++ai)
#pragma unroll
            for (int m = 0; m < 4; ++m) { float* rowp = base + (size_t)(ai * HALF + wr * 64 + m * 16 + fr) * DM + col0;
#pragma unroll
                for (int bj = 0; bj < 2; ++bj)
#pragma unroll
                    for (int n = 0; n < 2; ++n) *(f32x4*)(rowp + bj * HALF + n * 16) = acc[ai][bj][m][n]; }
    }
};

template <bool I8> struct AccT { typedef f32x4 T; };
template <> struct AccT<true> { typedef i32x4 T; };
template <class Epi, class Sched, bool ALIGN_EPI = true, bool SP2 = true, bool I8 = false, bool GATHER = false>
__device__ __forceinline__ void gemm_phase(LAS unsigned char* lds, const Gemm g, const Sched& S, const Epi& E, const int tid) {
    const int wid = __builtin_amdgcn_readfirstlane(tid >> 6), lane = tid & 63, wr = wid >> 2, wc = wid & 3, fr = lane & 15, fq = lane >> 4;
    constexpr int ES = I8 ? 1 : 2; typedef typename AccT<I8>::T acc_t;
    const int K = g.K, nt = K * ES / (BK * 2);
    unsigned voffA[2], voffB[2];
    int gRow[2]; unsigned gC2[2];
#pragma unroll
    for (int i = 0; i < 2; ++i) { int R, C; stage_rc(tid * 16 + i * 8192, R, C); const int Rb = Epi::PERM ? ((R & ~31) + perm32(R & 31)) : R;
        voffA[i] = (unsigned)(R * g.lda * ES + C * 2); voffB[i] = (unsigned)(Rb * g.ldb * ES + C * 2); gRow[i] = R; gC2[i] = (unsigned)(C * 2); }
    unsigned vc0[2], vc1[2], vn0[2], vn1[2], vq0[2], vq1[2];
#define PG8_GATH(u, v0, v1) do { _Pragma("unroll") for (int _i = 0; _i < 2; ++_i) { const GAS int* _tp = (const GAS int*)g.rowtab + (u).pm * BM + gRow[_i]; \
        v0[_i] = (unsigned)_tp[0] * (unsigned)(g.lda * ES) + gC2[_i]; v1[_i] = (unsigned)_tp[HALF] * (unsigned)(g.lda * ES) + gC2[_i]; } } while (0)
    const size_t kstep = (size_t)(BK * 2);
    const size_t hstepA = GATHER ? (size_t)0 : (size_t)HALF * g.lda * ES, hstepB = (size_t)HALF * g.ldb * ES;
    const size_t tstepA = 2 * hstepA, tstepB = 2 * hstepB;
    const unsigned ldsw = (unsigned)wid * 1024u;
    const int aoff = lds_byte(wr * 64 + fr, fq * 8), boff = lds_byte(wc * 32 + fr, fq * 8);
#define PG8_SA(b, h) (((b) * 2 + (h)) * HTB)
#define PG8_SB(b, h) ((4 + (b) * 2 + (h)) * HTB)
#define PG8_STAGE(bufoff, gbase, voff) do { _Pragma("unroll") for (int _i = 0; _i < 2; ++_i) \
        __builtin_amdgcn_global_load_lds((const unsigned*)((const char*)(gbase) + (voff)[_i]), (LAS unsigned*)(lds + (bufoff) + ldsw + _i * 8192), 16, 0, 0); } while (0)
#define PG8_LDA(dst, b, h) do { _Pragma("unroll") for (int m = 0; m < 4; ++m) _Pragma("unroll") for (int k = 0; k < 2; ++k) dst[m][k] = *(const LAS bf16x8*)(lds + PG8_SA(b, h) + aoff + m * 2048 + k * 1024); } while (0)
#define PG8_LDB(dst, b, h) do { _Pragma("unroll") for (int n = 0; n < 2; ++n) _Pragma("unroll") for (int k = 0; k < 2; ++k) dst[n][k] = *(const LAS bf16x8*)(lds + PG8_SB(b, h) + boff + n * 2048 + k * 1024); } while (0)
#define PG8_MMA(ai, bj, At, Bt) do { __builtin_amdgcn_s_setprio(1); _Pragma("unroll") for (int m = 0; m < 4; ++m) _Pragma("unroll") for (int n = 0; n < 2; ++n) _Pragma("unroll") for (int k = 0; k < 2; ++k) \
        { if constexpr (I8) acc[ai][bj][m][n] = __builtin_amdgcn_mfma_i32_16x16x64_i8(__builtin_bit_cast(i32x4, Bt[n][k]), __builtin_bit_cast(i32x4, At[m][k]), acc[ai][bj][m][n], 0, 0, 0); \
          else acc[ai][bj][m][n] = __builtin_amdgcn_mfma_f32_16x16x32_bf16(Bt[n][k], At[m][k], acc[ai][bj][m][n], 0, 0, 0); } __builtin_amdgcn_s_setprio(0); } while (0)
#define PG8_WAIT_V(n) asm volatile("s_waitcnt vmcnt(" #n ")" ::: "memory")
#define PG8_WAIT_L(n) asm volatile("s_waitcnt lgkmcnt(" #n ")" ::: "memory")
#define PG8_BAR __builtin_amdgcn_s_barrier()
#define PG8_SCHED __builtin_amdgcn_sched_barrier(0)
    Unit cur, nxt; int ui = 0;
    if (!S.next(0, cur)) return;
    acc_t acc[2][2][4][2];
#pragma unroll
    for (int a = 0; a < 2; ++a)
#pragma unroll
        for (int b = 0; b < 2; ++b)
#pragma unroll
            for (int m = 0; m < 4; ++m)
#pragma unroll
                for (int n = 0; n < 2; ++n) acc[a][b][m][n] = acc_t{};
    bf16x8 At[4][2], B0[2][2], B1[2][2];
    const char* cA = (const char*)g.A + cur.aoff + (size_t)cur.pm * tstepA; const char* cB = (const char*)g.Bt + cur.boff + (size_t)cur.pn * tstepB;
    if constexpr (GATHER) { PG8_GATH(cur, vc0, vc1); Unit t1; if (S.next(1, t1)) PG8_GATH(t1, vn0, vn1); else { vn0[0] = vc0[0]; vn0[1] = vc0[1]; vn1[0] = vc1[0]; vn1[1] = vc1[1]; } }
    else {
#pragma unroll
        for (int i = 0; i < 2; ++i) { vc0[i] = vc1[i] = vn0[i] = vn1[i] = voffA[i]; } }
    if constexpr (SP2) {
        PG8_STAGE(PG8_SB(0, 0), cB, voffB); PG8_STAGE(PG8_SB(0, 1), cB + hstepB, voffB); PG8_STAGE(PG8_SA(0, 0), cA, vc0); PG8_STAGE(PG8_SA(0, 1), cA + hstepA, vc1);
        if (wr == 1) PG8_BAR;
        PG8_WAIT_V(2); PG8_BAR;
        PG8_STAGE(PG8_SB(1, 0), cB + kstep, voffB); PG8_STAGE(PG8_SA(1, 0), cA + kstep, vc0); PG8_STAGE(PG8_SB(1, 1), cB + hstepB + kstep, voffB);
        PG8_WAIT_V(6); PG8_BAR;
    } else {
        PG8_STAGE(PG8_SB(0, 0), cB, voffB); PG8_STAGE(PG8_SA(0, 0), cA, voffA); PG8_STAGE(PG8_SB(0, 1), cB + hstepB, voffB); PG8_STAGE(PG8_SA(0, 1), cA + hstepA, voffA);
        if (wr == 1) PG8_BAR;
        PG8_WAIT_V(4); PG8_BAR;
        PG8_STAGE(PG8_SB(1, 0), cB + kstep, voffB); PG8_STAGE(PG8_SA(1, 0), cA + kstep, voffA); PG8_STAGE(PG8_SB(1, 1), cB + hstepB + kstep, voffB);
        PG8_WAIT_V(6); PG8_BAR;
    }
    for (;;) {
        const bool has_next = S.next(ui + 1, nxt);
        const char* nA = has_next ? (const char*)g.A + nxt.aoff + (size_t)nxt.pm * tstepA : cA; const char* nB = has_next ? (const char*)g.Bt + nxt.boff + (size_t)nxt.pn * tstepB : cB;
        for (int t = 0; t < nt; t += 2) {
            const bool last = (t == nt - 2);
            const char* a1 = cA + (size_t)(t + 1) * kstep;
            const char* a2 = last ? nA : cA + (size_t)(t + 2) * kstep; const char* b2 = last ? nB : cB + (size_t)(t + 2) * kstep;
            const char* a3 = a2 + kstep; const char* b3 = b2 + kstep;
            if constexpr (SP2) {
            unsigned sA0[2], sA1[2];
            if constexpr (GATHER) {
#pragma unroll
                for (int i = 0; i < 2; ++i) { sA0[i] = last ? vn0[i] : vc0[i]; sA1[i] = last ? vn1[i] : vc1[i]; } }
            else { sA0[0] = sA1[0] = voffA[0]; sA0[1] = sA1[1] = voffA[1]; }
            PG8_LDB(B0, 0, 0); PG8_LDB(B1, 0, 1); PG8_SCHED; PG8_LDA(At, 0, 0); PG8_STAGE(PG8_SA(1, 1), a1 + hstepA, vc1);
            PG8_WAIT_V(8); PG8_WAIT_L(0); PG8_BAR; PG8_MMA(0, 0, At, B0); PG8_MMA(0, 1, At, B1); PG8_BAR; PG8_SCHED;
            PG8_LDA(At, 0, 1); PG8_STAGE(PG8_SB(0, 0), b2, voffB); PG8_STAGE(PG8_SB(0, 1), b2 + hstepB, voffB); PG8_STAGE(PG8_SA(0, 0), a2, sA0);
            PG8_WAIT_V(8); PG8_WAIT_L(0); PG8_BAR; PG8_MMA(1, 0, At, B0); PG8_MMA(1, 1, At, B1); PG8_BAR; PG8_SCHED;
            PG8_LDB(B0, 1, 0); PG8_LDB(B1, 1, 1); PG8_SCHED; PG8_LDA(At, 1, 0); PG8_STAGE(PG8_SA(0, 1), a2 + hstepA, sA1);
            PG8_WAIT_V(8); PG8_WAIT_L(0); PG8_BAR; PG8_MMA(0, 0, At, B0); PG8_MMA(0, 1, At, B1); PG8_BAR; PG8_SCHED;
            PG8_LDA(At, 1, 1); PG8_STAGE(PG8_SB(1, 0), b3, voffB); PG8_STAGE(PG8_SB(1, 1), b3 + hstepB, voffB); PG8_STAGE(PG8_SA(1, 0), a3, sA0);
            PG8_WAIT_V(8); PG8_WAIT_L(0); PG8_BAR; PG8_MMA(1, 0, At, B0); PG8_MMA(1, 1, At, B1); PG8_BAR; PG8_SCHED;
            } else {
            PG8_LDB(B0, 0, 0); PG8_SCHED; PG8_LDA(At, 0, 0); PG8_STAGE(PG8_SA(1, 1), a1 + hstepA, voffA);
            PG8_WAIT_L(8); PG8_BAR; PG8_WAIT_L(0); PG8_MMA(0, 0, At, B0); PG8_BAR; PG8_SCHED;
            PG8_LDB(B1, 0, 1); PG8_STAGE(PG8_SB(0, 0), b2, voffB);
            PG8_BAR; PG8_WAIT_L(0); PG8_MMA(0, 1, At, B1); PG8_BAR;
            PG8_LDA(At, 0, 1); PG8_STAGE(PG8_SA(0, 0), a2, voffA);
            PG8_BAR; PG8_WAIT_L(0); PG8_MMA(1, 0, At, B0); PG8_BAR; PG8_SCHED;
            PG8_STAGE(PG8_SB(0, 1), b2 + hstepB, voffB);
            PG8_WAIT_V(6); PG8_BAR; PG8_MMA(1, 1, At, B1); PG8_BAR;
            PG8_LDB(B0, 1, 0); PG8_SCHED; PG8_LDA(At, 1, 0); PG8_STAGE(PG8_SA(0, 1), a2 + hstepA, voffA);
            PG8_WAIT_L(8); PG8_BAR; PG8_WAIT_L(0); PG8_MMA(0, 0, At, B0); PG8_BAR; PG8_SCHED;
            PG8_LDB(B1, 1, 1); PG8_STAGE(PG8_SB(1, 0), b3, voffB);
            PG8_BAR; PG8_WAIT_L(0); PG8_MMA(0, 1, At, B1); PG8_BAR;
            PG8_LDA(At, 1, 1); PG8_STAGE(PG8_SA(1, 0), a3, voffA);
            PG8_BAR; PG8_WAIT_L(0); PG8_MMA(1, 0, At, B0); PG8_BAR; PG8_SCHED;
            PG8_STAGE(PG8_SB(1, 1), b3 + hstepB, voffB);
            PG8_WAIT_V(6); PG8_BAR; PG8_MMA(1, 1, At, B1); PG8_BAR;
            }
        }
        if constexpr (ALIGN_EPI) { if (wr == 0) PG8_BAR; }
        bool has_q = false;
        if constexpr (GATHER) { Unit t2; has_q = has_next && S.next(ui + 2, t2); if (has_q) PG8_GATH(t2, vq0, vq1); }
        E(acc, cur, wr, wc, fr, fq);
        if (!has_next) break;
        if constexpr (GATHER) {
#pragma unroll
            for (int i = 0; i < 2; ++i) { vc0[i] = vn0[i]; vc1[i] = vn1[i]; if (has_q) { vn0[i] = vq0[i]; vn1[i] = vq1[i]; } } }
#pragma unroll
        for (int a = 0; a < 2; ++a)
#pragma unroll
            for (int b = 0; b < 2; ++b)
#pragma unroll
                for (int m = 0; m < 4; ++m)
#pragma unroll
                    for (int n = 0; n < 2; ++n) acc[a][b][m][n] = acc_t{};
        cur = nxt; cA = nA; cB = nB; ++ui;
        if constexpr (ALIGN_EPI) { if (wr == 1) PG8_BAR; }
    }
    PG8_WAIT_V(0);
    if constexpr (!ALIGN_EPI) { if (wr == 0) PG8_BAR; }
    PG8_BAR;
#undef PG8_GATH
#undef PG8_SA
#undef PG8_SB
#undef PG8_STAGE
#undef PG8_LDA
#undef PG8_LDB
#undef PG8_MMA
#undef PG8_WAIT_V
#undef PG8_WAIT_L
#undef PG8_BAR
#undef PG8_SCHED
}
}

#define XB_TMO      128
#define XB_XCNT(j)  (256  + 64 * (j))
#define XB_XSUB(j)  (1280 + 64 * (j))
#define XB_XGEN(j)  (2304 + 64 * (j))
#define XB_TOP      3328
#define XB_TOPGEN   3392
#define XCD_BAR_WORDS 3456
#define XB_SPIN_CAP (1u << 22)
__device__ __forceinline__ unsigned xb_ld(unsigned* p)              { return __hip_atomic_load(p, __ATOMIC_RELAXED, __HIP_MEMORY_SCOPE_AGENT); }
__device__ __forceinline__ unsigned xb_add(unsigned* p, unsigned v) { return __hip_atomic_fetch_add(p, v, __ATOMIC_RELAXED, __HIP_MEMORY_SCOPE_AGENT); }
__device__ __forceinline__ unsigned xb_xcc_id() { return (unsigned)__builtin_amdgcn_s_getreg((3 << 11) | 20) & 0xFu; }
#define XB_SPIN(cond, bar) do { unsigned _sp = 0; while (cond) { __builtin_amdgcn_s_sleep(1); \
    if ((++_sp & 255u) == 0u) { if (xb_ld(&(bar)[XB_TMO])) break; if (_sp > XB_SPIN_CAP) { atomicAdd(&(bar)[XB_TMO], 1u); break; } } } } while (0)
struct XcdBarrier { unsigned* bar; unsigned x; volatile LAS unsigned* st; };
__device__ __forceinline__ XcdBarrier xcd_barrier_post(unsigned* bar, volatile LAS unsigned* st) {
    XcdBarrier b; b.bar = bar; b.x = xb_xcc_id(); b.st = st;
    if (threadIdx.x == 0) (void)xb_add(&bar[XB_XCNT(b.x)], 1u);
    return b;
}
__device__ __forceinline__ void xcd_barrier_complete(unsigned* bar, unsigned x, unsigned& nloc, unsigned& nx) {
    const unsigned G = gridDim.x * gridDim.y * gridDim.z;
    unsigned sum, cnt, mine, sp = 0u;
    for (;;) {
        sum = 0u; cnt = 0u; mine = 0u;
#pragma unroll
        for (unsigned j = 0; j < 16; ++j) { const unsigned c = xb_ld(&bar[XB_XCNT(j)]); sum += c; cnt += (c > 0u) ? 1u : 0u; mine = (j == x) ? c : mine; }
        if (sum == G) break;
        __builtin_amdgcn_s_sleep(1);
        if ((++sp & 255u) == 0u) { if (xb_ld(&bar[XB_TMO])) break; if (sp > XB_SPIN_CAP) { atomicAdd(&bar[XB_TMO], 1u); break; } }
    }
    nloc = mine > 0u ? mine : 1u; nx = cnt > 0u ? cnt : 1u;
}
__device__ __forceinline__ void xcd_barrier(const XcdBarrier& b) {
    asm volatile("s_waitcnt vmcnt(0)" ::: "memory");
    __syncthreads();
    if (threadIdx.x == 0) {
        unsigned* bar = b.bar;
        __builtin_amdgcn_s_waitcnt(0);
        unsigned nloc = b.st[0], nx = b.st[1];
        if (nloc == 0u) { xcd_barrier_complete(bar, b.x, nloc, nx); b.st[0] = nloc; b.st[1] = nx; }
        const unsigned old = xb_add(&bar[XB_XSUB(b.x)], 1u);
        const unsigned gen = old / nloc;
        if (old + 1u == (gen + 1u) * nloc) {
            __builtin_amdgcn_fence(__ATOMIC_RELEASE, "agent");
            asm volatile("s_waitcnt vmcnt(0)" ::: "memory");
            const unsigned og = xb_add(&bar[XB_TOP], 1u);
            const unsigned tg = og / nx;
            if (og + 1u == (tg + 1u) * nx) xb_add(&bar[XB_TOPGEN], 1u);
            else XB_SPIN(xb_ld(&bar[XB_TOPGEN]) == tg, bar);
            __builtin_amdgcn_fence(__ATOMIC_ACQUIRE, "agent");
            xb_add(&bar[XB_XGEN(b.x)], 1u);
            asm volatile("s_waitcnt vmcnt(0)" ::: "memory");
        } else {
            XB_SPIN(xb_ld(&bar[XB_XGEN(b.x)]) == gen, bar);
            __builtin_amdgcn_fence(__ATOMIC_ACQUIRE, "agent");
            asm volatile("s_waitcnt vmcnt(0)" ::: "memory");
        }
    }
    __syncthreads();
}

namespace att {
#define SBAR() __builtin_amdgcn_sched_barrier(0)
__device__ __forceinline__ int crow(int r, int hi) { return (r & 3) + 8 * (r >> 2) + 4 * hi; }
template <int KPB> __device__ __forceinline__ int kswz(int row, int colB) {
    if constexpr (KPB == 128) return row * 128 + (colB ^ (((row >> 1) & 7) << 4));
    else return row * 256 + (colB ^ ((row & 15) << 4));
}
template <int NCB> __device__ __forceinline__ int v_st(int k, int c) { const int kk = k; return ((kk >> 3) * NCB + (c >> 5)) * 512 + ((kk & 7) * 32 + (c & 31)) * 2; }
__device__ __forceinline__ int v_rd_base(int lane) { return ((lane & 3) << 3) | (((lane >> 2) & 3) << 6) | (((lane >> 4) & 1) << 5) | (((lane >> 5) & 1) << 8); }
template <int OFF> __device__ __forceinline__ s16x4 tr_read(int vb) { s16x4 r; asm volatile("ds_read_b64_tr_b16 %0, %1 offset:%2" : "=&v"(r) : "v"(vb), "i"(OFF) : "memory"); return r; }

constexpr float ATT_THR = 11.541560327111707f;
template <bool FIRST>
__device__ __forceinline__ void partialSM(f32x16& p0, f32x16& p1, float& mhat, float& alpha, const bool nomax) {
    alpha = 1.f;
    if (!nomax) {
        float pmax = fmaxf(p0[0], p1[0]);
#pragma unroll
        for (int r = 1; r < 16; ++r) pmax = fmaxf(fmaxf(pmax, p0[r]), p1[r]);
        { auto rr = __builtin_amdgcn_permlane32_swap(__float_as_uint(pmax), __float_as_uint(pmax), false, false);
          pmax = fmaxf(__uint_as_float(rr[0]), __uint_as_float(rr[1])); }
        const float d = pmax - mhat; const bool move = FIRST ? (d > ATT_THR || d < -ATT_THR) : (d > ATT_THR);
        if (__builtin_expect(__any(move), 0)) { const float mn = move ? pmax : mhat; alpha = FIRST ? 1.f : __builtin_amdgcn_exp2f(mhat - mn); mhat = mn; }
        if (__builtin_expect(__any(mhat != 0.f), 0)) {
#pragma unroll
            for (int r = 0; r < 16; ++r) { p0[r] -= mhat; p1[r] -= mhat; } }
    }
#pragma unroll
    for (int r = 0; r < 16; ++r) p0[r] = __builtin_amdgcn_exp2f(p0[r]);
}
template <bool LM>
__device__ __forceinline__ void finishSM(f32x16& p0, f32x16& p1, float alpha, float& l_reg, bf16x8& pa0, bf16x8& pa1, bf16x8& pa2, bf16x8& pa3) {
#pragma unroll
    for (int r = 0; r < 16; ++r) p1[r] = __builtin_amdgcn_exp2f(p1[r]);
    if constexpr (!LM) { float ps = 0;
#pragma unroll
        for (int r = 0; r < 16; ++r) ps += p0[r];
#pragma unroll
        for (int r = 0; r < 16; ++r) ps += p1[r];
        { auto rr = __builtin_amdgcn_permlane32_swap(__float_as_uint(ps), __float_as_uint(ps), false, false);
          ps = __uint_as_float(rr[0]) + __uint_as_float(rr[1]); }
        l_reg = l_reg * alpha + ps; }
#define PK4(P, BASE, OUT) do { const u32x4 w = {cvt_pk_bf16(P[BASE + 0], P[BASE + 1]), cvt_pk_bf16(P[BASE + 2], P[BASE + 3]), cvt_pk_bf16(P[BASE + 4], P[BASE + 5]), cvt_pk_bf16(P[BASE + 6], P[BASE + 7])}; \
    OUT = __builtin_bit_cast(bf16x8, w); } while (0)
    PK4(p0, 0, pa0); PK4(p0, 8, pa1); PK4(p1, 0, pa2); PK4(p1, 8, pa3);
#undef PK4
}
template <int DQK, int KPB> __device__ __forceinline__ void qkt(f32x16& p0, f32x16& p1, const char* Ks, const bf16x8* qr, int r32, int hi) {
    p0 = f32x16{}; p1 = f32x16{};
#pragma unroll
    for (int d0 = 0; d0 < DQK / 16; ++d0) { const int cb = (d0 * 16 + hi * 8) * 2;
        const bf16x8 b0 = *reinterpret_cast<const bf16x8*>(Ks + kswz<KPB>(r32, cb));
        const bf16x8 b1 = *reinterpret_cast<const bf16x8*>(Ks + kswz<KPB>(32 + r32, cb));
        p0 = __builtin_amdgcn_mfma_f32_32x32x16_bf16(b0, qr[d0], p0, 0, 0, 0);
        p1 = __builtin_amdgcn_mfma_f32_32x32x16_bf16(b1, qr[d0], p1, 0, 0, 0); }
}
template <int NCB, int D0> __device__ __forceinline__ void pv_one(f32x16& od, int vb, bf16x8 pa0, bf16x8 pa1, bf16x8 pa2, bf16x8 pa3) {
    constexpr int KS = 2 * NCB * 512, HF = NCB * 512, B0 = D0 * 512;
    const s16x4 l0 = tr_read<B0>(vb), h0 = tr_read<B0 + HF>(vb), l1 = tr_read<B0 + KS>(vb), h1 = tr_read<B0 + KS + HF>(vb);
    const s16x4 l2 = tr_read<B0 + 2 * KS>(vb), h2 = tr_read<B0 + 2 * KS + HF>(vb), l3 = tr_read<B0 + 3 * KS>(vb), h3 = tr_read<B0 + 3 * KS + HF>(vb);
    asm volatile("s_waitcnt lgkmcnt(0)" ::: "memory"); SBAR();
#define PKV(L, H) (bf16x8){L[0], L[1], L[2], L[3], H[0], H[1], H[2], H[3]}
    od = __builtin_amdgcn_mfma_f32_32x32x16_bf16(pa0, PKV(l0, h0), od, 0, 0, 0);
    od = __builtin_amdgcn_mfma_f32_32x32x16_bf16(pa1, PKV(l1, h1), od, 0, 0, 0);
    od = __builtin_amdgcn_mfma_f32_32x32x16_bf16(pa2, PKV(l2, h2), od, 0, 0, 0);
    od = __builtin_amdgcn_mfma_f32_32x32x16_bf16(pa3, PKV(l3, h3), od, 0, 0, 0);
#undef PKV
}
template <int NCB, bool LM> __device__ __forceinline__ void pv_all(f32x16* o, f32x16& ol, int vb, bf16x8 pa0, bf16x8 pa1, bf16x8 pa2, bf16x8 pa3) {
    pv_one<NCB, 0>(o[0], vb, pa0, pa1, pa2, pa3); pv_one<NCB, 1>(o[1], vb, pa0, pa1, pa2, pa3);
    if constexpr (NCB == 4) { pv_one<NCB, 2>(o[2], vb, pa0, pa1, pa2, pa3); pv_one<NCB, 3>(o[3], vb, pa0, pa1, pa2, pa3); }
    if constexpr (LM) { const bf16x8 ones = {0x3F80, 0x3F80, 0x3F80, 0x3F80, 0x3F80, 0x3F80, 0x3F80, 0x3F80};
        ol = __builtin_amdgcn_mfma_f32_32x32x16_bf16(pa0, ones, ol, 0, 0, 0); ol = __builtin_amdgcn_mfma_f32_32x32x16_bf16(pa1, ones, ol, 0, 0, 0);
        ol = __builtin_amdgcn_mfma_f32_32x32x16_bf16(pa2, ones, ol, 0, 0, 0); ol = __builtin_amdgcn_mfma_f32_32x32x16_bf16(pa3, ones, ol, 0, 0, 0); }
}

template <int DQK, int DV>
__device__ __forceinline__ void attn_unit(const bf16_t* __restrict__ Qb, int ldq, const bf16_t* __restrict__ Kh, int ldk, const bf16_t* __restrict__ Kpe,
                                          const bf16_t* __restrict__ Vh, int ldv, bf16_t* __restrict__ Ob, int ldo, int seq, char* lds, const int tid, const float* ropetab = nullptr, const int rope_t0 = -1, const float kmax2 = -1.f) {
    constexpr int KPB = (DQK == 64) ? 128 : 256, NCB = DV / 32, SHM_K = 64 * KPB, SHM_V = 64 * DV * 2, NV = DV / 64;
    constexpr bool KS = (DQK == 96), LM = false;
    const int wid = tid >> 6, lane = tid & 63, r32 = lane & 31, hi = lane >> 5;
    char* V_lds = lds; char* K_lds = lds + 3 * SHM_V;
    float* ws = (float*)(lds + 3 * SHM_V + 3 * SHM_K) + wid * 64; float* li_l = ws; float* al_l = ws + 32;
    float mhat = 0.f, l_reg = 0; f32x16 o[NCB], ol = f32x16{}; bf16x8 qr[DQK / 16];
#pragma unroll
    for (int d = 0; d < NCB; ++d) o[d] = f32x16{};
    const bf16_t* Qw = Qb + (long)(wid * 32 + r32) * ldq + hi * 8;
#pragma unroll
    for (int d0 = 0; d0 < DQK / 16; ++d0) qr[d0] = *reinterpret_cast<const bf16x8*>(Qw + d0 * 16);
    if constexpr (DQK == 96) { if (rope_t0 >= 0) {
        const int tl = rope_t0 + wid * 32 + r32;
#pragma unroll
        for (int d0 = 4; d0 < 6; ++d0) { const int pos = (d0 == 4) ? (tl >> 6) : (tl & 63); const float* tb = ropetab + pos * 8;
            const f32x4 c0 = *(const f32x4*)tb, c1 = *(const f32x4*)(tb + 4), s0 = *(const f32x4*)(tb + 1024), s1 = *(const f32x4*)(tb + 1028);
            const float cs[8] = {c0.x, c0.y, c0.z, c0.w, c1.x, c1.y, c1.z, c1.w}, sn[8] = {s0.x, s0.y, s0.z, s0.w, s1.x, s1.y, s1.z, s1.w};
            const u32x4 own = __builtin_bit_cast(u32x4, qr[d0]); u32x4 res;
#pragma unroll
            for (int w = 0; w < 4; ++w) { auto rr = __builtin_amdgcn_permlane32_swap(own[w], own[w], false, false); const unsigned oth = hi ? rr[0] : rr[1];
                const float a0 = bflo(own[w]), a1 = bfhi(own[w]), b0 = bflo(oth), b1 = bfhi(oth);
                const float r0 = hi ? (a0 * cs[2 * w] + b0 * sn[2 * w]) : (a0 * cs[2 * w] - b0 * sn[2 * w]);
                const float r1 = hi ? (a1 * cs[2 * w + 1] + b1 * sn[2 * w + 1]) : (a1 * cs[2 * w + 1] - b1 * sn[2 * w + 1]);
                res[w] = pk2(r0, r1); }
            qr[d0] = __builtin_bit_cast(bf16x8, res); } } }
    bool nomax = false;
    if (kmax2 >= 0.f) {
        float qn = 0.f;
#pragma unroll
        for (int d0 = 0; d0 < DQK / 16; ++d0) { const u32x4 w = __builtin_bit_cast(u32x4, qr[d0]);
#pragma unroll
            for (int e = 0; e < 4; ++e) { const float a = bflo(w[e]), b = bfhi(w[e]); qn += a * a + b * b; } }
        { auto rr = __builtin_amdgcn_permlane32_swap(__float_as_uint(qn), __float_as_uint(qn), false, false); qn = __uint_as_float(rr[0]) + __uint_as_float(rr[1]); }
        nomax = __all(qn * kmax2 * 1.1f < 3600.f);
    }
    const int krow = tid >> 3, kch = tid & 7, kst = kswz<KPB>(krow, kch * 16);
    const int k2row = (tid >> 2) & 63, k2ch = tid & 3, k2st = kswz<KPB>(k2row, 128 + k2ch * 16);
    const int vrow = (NV == 1) ? (tid >> 3) : (tid >> 4), vcol = (NV == 1) ? (tid & 7) * 8 : (tid & 15) * 8;
    const int vst0 = v_st<NCB>(vrow, vcol), vst1 = v_st<NCB>(32 + vrow, vcol);
    const int vb0 = (int)(uintptr_t)V_lds + v_rd_base(lane);
    struct { bf16x8 k0, k1, v0, v1; } sr_[2];
    const unsigned koff = (unsigned)(krow * ldk + kch * 8), k2off = (unsigned)(k2row * 32 + k2ch * 8), voff0 = (unsigned)(vrow * ldv + vcol), voff1 = (unsigned)((32 + vrow) * ldv + vcol);
#define SLOAD(i, k0_) do { const bf16_t* kt_ = Kh + (size_t)(k0_) * ldk; const bf16_t* vt_ = Vh + (size_t)(k0_) * ldv; sr_[i].k0 = *reinterpret_cast<const bf16x8*>(kt_ + koff); \
    if constexpr (KS) { if (tid < 256) sr_[i].k1 = *reinterpret_cast<const bf16x8*>(Kpe + (size_t)(k0_) * 32 + k2off); } \
    sr_[i].v0 = *reinterpret_cast<const bf16x8*>(vt_ + voff0); \
    if constexpr (NV == 2) sr_[i].v1 = *reinterpret_cast<const bf16x8*>(vt_ + voff1); } while (0)
#define SWRITE(slot, i) do { char* kd_ = K_lds + (slot) * SHM_K; char* vd_ = V_lds + (slot) * SHM_V; *(bf16x8*)(kd_ + kst) = sr_[i].k0; \
    if constexpr (KS) { if (tid < 256) *(bf16x8*)(kd_ + k2st) = sr_[i].k1; } \
    *(bf16x8*)(vd_ + vst0) = sr_[i].v0; \
    if constexpr (NV == 2) *(bf16x8*)(vd_ + vst1) = sr_[i].v1; } while (0)
    constexpr int NLD = 1 + (KS ? 1 : 0) + NV;
#define SWAIT() do { if constexpr (KS) asm volatile("s_waitcnt vmcnt(2)" ::: "memory"); else if constexpr (NLD == 2) asm volatile("s_waitcnt vmcnt(2)" ::: "memory"); else asm volatile("s_waitcnt vmcnt(3)" ::: "memory"); } while (0)
#define RESC(a) do { if (__any((a) < 1.f)) { if (hi == 0) al_l[r32] = (a); asm volatile("s_waitcnt lgkmcnt(0)" ::: "memory"); \
    _Pragma("unroll") for (int r = 0; r < 16; ++r) { const float f_ = al_l[crow(r, hi)]; _Pragma("unroll") for (int d = 0; d < NCB; ++d) o[d][r] *= f_; if constexpr (LM) ol[r] *= f_; } } } while (0)
    f32x16 pA0, pA1, pB0, pB1; float alA, alB; bf16x8 pa0, pa1, pa2, pa3; const int NT = seq / 64;
    SLOAD(0, 0); asm volatile("s_waitcnt vmcnt(0)" ::: "memory"); SWRITE(0, 0); __syncthreads();
    qkt<DQK, KPB>(pA0, pA1, K_lds, qr, r32, hi); partialSM<true>(pA0, pA1, mhat, alA, nomax);
    SLOAD(1, 64); if (2 < NT) SLOAD(0, 128);
    SWAIT(); SWRITE(1, 1); __syncthreads();
    int sp = 0, sc = 1, sn = 2;
#define ROT() do { const int t_ = sp; sp = sc; sc = sn; sn = t_; } while (0)
    for (int j = 1; j + 1 < NT; j += 2) {
        SBAR(); qkt<DQK, KPB>(pB0, pB1, K_lds + sc * SHM_K, qr, r32, hi);
        finishSM<LM>(pA0, pA1, alA, l_reg, pa0, pa1, pa2, pa3); SBAR();
        SLOAD(1, (j + 2) * 64); SBAR();
        pv_all<NCB, LM>(o, ol, vb0 + sp * SHM_V, pa0, pa1, pa2, pa3); partialSM<false>(pB0, pB1, mhat, alB, nomax);
        SWAIT(); SWRITE(sn, 0);
        RESC(alB); __syncthreads(); ROT();
        SBAR(); qkt<DQK, KPB>(pA0, pA1, K_lds + sc * SHM_K, qr, r32, hi);
        finishSM<LM>(pB0, pB1, alB, l_reg, pa0, pa1, pa2, pa3); SBAR();
        if (j + 3 < NT) SLOAD(0, (j + 3) * 64); SBAR();
        pv_all<NCB, LM>(o, ol, vb0 + sp * SHM_V, pa0, pa1, pa2, pa3); partialSM<false>(pA0, pA1, mhat, alA, nomax);
        SWAIT(); SWRITE(sn, 1);
        RESC(alA); __syncthreads(); ROT();
    }
    SBAR(); qkt<DQK, KPB>(pB0, pB1, K_lds + sc * SHM_K, qr, r32, hi);
    finishSM<LM>(pA0, pA1, alA, l_reg, pa0, pa1, pa2, pa3); SBAR();
    pv_all<NCB, LM>(o, ol, vb0 + sp * SHM_V, pa0, pa1, pa2, pa3); partialSM<false>(pB0, pB1, mhat, alB, nomax);
    RESC(alB);
    finishSM<LM>(pB0, pB1, alB, l_reg, pa0, pa1, pa2, pa3); SBAR();
    pv_all<NCB, LM>(o, ol, vb0 + sc * SHM_V, pa0, pa1, pa2, pa3);
#undef ROT
    float rli[16];
    if constexpr (LM) {
#pragma unroll
        for (int r = 0; r < 16; ++r) rli[r] = __builtin_amdgcn_rcpf(ol[r]);
    } else { if (hi == 0) li_l[r32] = l_reg; asm volatile("s_waitcnt lgkmcnt(0)" ::: "memory");
#pragma unroll
        for (int r = 0; r < 16; ++r) rli[r] = __builtin_amdgcn_rcpf(li_l[crow(r, hi)]); }
    bf16_t* Ow = Ob + (long)(wid * 32) * ldo;
    { char* stg = lds + 3 * SHM_V + 3 * SHM_K + 8 * 256 + wid * (32 * DV * 2);
#pragma unroll
      for (int r = 0; r < 16; ++r) { const int orow = crow(r, hi);
#pragma unroll
          for (int d0 = 0; d0 < NCB; ++d0) *(bf16_t*)(stg + (orow * DV + d0 * 32 + r32) * 2) = (bf16_t)f2bf(o[d0][r] * rli[r]); }
      asm volatile("s_waitcnt lgkmcnt(0)" ::: "memory");
      constexpr int LPR = DV / 8, RPI = 64 / LPR;
#pragma unroll
      for (int i = 0; i < 32 / RPI; ++i) { const int row = i * RPI + lane / LPR, ch = lane % LPR; const u32x4 v = *(const u32x4*)(stg + (row * DV + ch * 8) * 2); *(u32x4*)(Ow + (long)row * ldo + ch * 8) = v; } }
    __syncthreads();
#undef SLOAD
#undef SWRITE
#undef SWAIT
#undef RESC
}
#undef SBAR
}

struct Frame {
    LAS unsigned char* lds; char* ldsg;
    volatile LAS unsigned* MISC;
    unsigned* ctl;
    int tid, lane, wave, G, gw, NGW;
    float* X; unsigned char* ws;
#define WSP(T, name, off) __device__ __forceinline__ T* name() const { return (T*)(ws + (off)); }
    WSP(float, CX, WS_CX) WSP(float, MOD, WS_MOD) WSP(float, TAB8, WS_TAB8) WSP(float, TAB16, WS_TAB16)
    WSP(bf16_t, HB, WS_HB) WSP(bf16_t, PB, WS_PB) WSP(bf16_t, QR, WS_QR) WSP(bf16_t, KV, WS_KV) WSP(bf16_t, KPE, WS_KPE)
    WSP(bf16_t, GQ, WS_GQ) WSP(bf16_t, GK, WS_GK) WSP(bf16_t, GV, WS_GV) WSP(bf16_t, OF, WS_OF) WSP(bf16_t, OB, WS_OB)
    WSP(bf16_t, ACT1, WS_ACT1) WSP(bf16_t, XG, WS_XG) WSP(float, GG, WS_GG) WSP(float, GBT, WS_GBT) WSP(unsigned char, GPRE, WS_GPRE)
    WSP(float, GCB, WS_GCB) WSP(float, SWD, WS_SWD) WSP(float, SATOK, WS_SATOK) WSP(float, SWD2, WS_SWD2) WSP(bf16_t, X16, WS_X16) WSP(float, PART, WS_PART) WSP(int, TOPE, WS_TOPE) WSP(int, SLOT, WS_SLOT) WSP(float, TOPW, WS_TOPW)
#undef WSP
};
struct ProIn { const float *w_in0, *w_uq, *w_ukv, *w_out0, *w_gu0, *w_d0, *w_in1, *w_out1, *w_gu1, *w_d1, *c, *c_ctx, *mod_w, *mod_b; };
__device__ __forceinline__ void row_bt(int r, int& bl, int& t) { bl = r / TT; t = r - bl * TT; }

__device__ __forceinline__ void p0_transpose_block(const float* W, int K, int N, bf16_t* WT, int ldt, int k0, int n0, int drow, LAS float* scr, int lane, const float sc) {
    float tv[32];
#pragma unroll
    for (int i = 0; i < 32; ++i) { const int kk = 2 * i + (lane >> 5); tv[i] = W[(size_t)(k0 + kk) * N + n0 + (lane & 31)]; }
#pragma unroll
    for (int i = 0; i < 32; ++i) { const int kk = 2 * i + (lane >> 5); scr[kk * 33 + (lane & 31)] = sc * tv[i]; }
    asm volatile("s_waitcnt lgkmcnt(0)" ::: "memory");
    const int c = lane & 7;
#pragma unroll
    for (int j = 0; j < 4; ++j) { const int n = (lane >> 3) + 8 * j; const LAS float* s = scr + (8 * c) * 33 + n;
        u32x4 o; o.x = pk2(s[0 * 33], s[1 * 33]); o.y = pk2(s[2 * 33], s[3 * 33]); o.z = pk2(s[4 * 33], s[5 * 33]); o.w = pk2(s[6 * 33], s[7 * 33]);
        *(u32x4*)(WT + (size_t)(drow + n) * ldt + k0 + 8 * c) = o; }
    asm volatile("s_waitcnt lgkmcnt(0)" ::: "memory");
}
__device__ __forceinline__ void p0_transpose_block_i8(const float* W, int K, int N, signed char* WT, int k0, int n0, int drow, LAS float* scr, int lane, const unsigned* smax, float* swd, const float presc) {
    float tv[32];
#pragma unroll
    for (int i = 0; i < 32; ++i) { const int kk = 2 * i + (lane >> 5); tv[i] = W[(size_t)(k0 + kk) * N + n0 + (lane & 31)]; }
    const float mx = __builtin_bit_cast(float, smax[n0 + (lane & 31)]); const float inv = mx > 0.f ? 127.0f / mx : 0.f;
#pragma unroll
    for (int i = 0; i < 32; ++i) { const int kk = 2 * i + (lane >> 5); scr[kk * 33 + (lane & 31)] = rintf(tv[i] * inv); }
    if (lane < 32 && k0 == 0) swd[drow + lane] = mx * presc * (1.0f / 127.0f);
    asm volatile("s_waitcnt lgkmcnt(0)" ::: "memory");
    const int c = lane & 3;
#pragma unroll
    for (int j = 0; j < 2; ++j) { const int n = (lane >> 2) + 16 * j; const LAS float* sp = scr + (16 * c) * 33 + n; u32x4 o;
#pragma unroll
        for (int q = 0; q < 4; ++q) { const int b0 = (int)sp[(4 * q + 0) * 33], b1 = (int)sp[(4 * q + 1) * 33], b2 = (int)sp[(4 * q + 2) * 33], b3 = (int)sp[(4 * q + 3) * 33];
            o[q] = (unsigned)(b0 & 0xff) | ((unsigned)(b1 & 0xff) << 8) | ((unsigned)(b2 & 0xff) << 16) | ((unsigned)(b3 & 0xff) << 24); }
        *(u32x4*)(WT + (size_t)(drow + n) * K + k0 + 16 * c) = o; }
    asm volatile("s_waitcnt lgkmcnt(0)" ::: "memory");
}
__device__ __forceinline__ int p0_matrix_i8(Frame& F, const float* W, int K, int N, signed char* WT, int F_gu, int base, LAS float* scr, const unsigned* smax, float* swd, int gw = -1, int ngw = 0, const float scale = 1.f, const int nscale = 0) {
    const int nblk = N / 32, items = (K / 64) * nblk; if (gw < 0) { gw = F.gw; ngw = F.NGW; }
    int first = (gw - base) % ngw; if (first < 0) first += ngw;
    for (int it = first; it < items; it += ngw) {
        const int kb = it / nblk, nb = it % nblk, n0 = 32 * nb;
        int drow = n0; if (F_gu) { const int up = n0 >= F_gu ? 1 : 0, f = n0 - up * F_gu; drow = (f >> 7) * 256 + up * 128 + (f & 127); }
        p0_transpose_block_i8(W, K, N, WT, 64 * kb, n0, drow, scr, F.lane, smax, swd, n0 < nscale ? scale : 1.f);
    }
    return base + items;
}
__device__ __forceinline__ int p0_absmax(Frame& F, const float* W, int K, int N, unsigned* smax, int base) {
    const int ncb = N / 64, nkh = K / 512, items = ncb * nkh;
    int first = (F.gw - base) % F.NGW; if (first < 0) first += F.NGW;
    for (int it = first; it < items; it += F.NGW) { const int kh = it % nkh, cb = it / nkh;
        const float* w = W + (size_t)(kh * 512) * N + cb * 64 + F.lane; float m = 0.f;
#pragma unroll 16
        for (int k = 0; k < 512; ++k) m = fmaxf(m, fabsf(w[(size_t)k * N]));
        atomicMax(smax + cb * 64 + F.lane, __builtin_bit_cast(unsigned, m)); }
    return base + items;
}
__device__ __forceinline__ int p0_matrix(Frame& F, const float* W, int K, int N, bf16_t* WT, int F_gu, int base, LAS float* scr, const float scale = 1.f, const int nscale = 0, int gw = -1, int ngw = 0) {
    const int nblk = N / 32, items = (K / 64) * nblk; if (gw < 0) { gw = F.gw; ngw = F.NGW; }
    int first = (gw - base) % ngw; if (first < 0) first += ngw;
    for (int it = first; it < items; it += ngw) {
        const int kb = it / nblk, nb = it % nblk, n0 = 32 * nb;
        int drow = n0;
        if (F_gu) { const int up = n0 >= F_gu ? 1 : 0, f = n0 - up * F_gu; drow = (f >> 7) * 256 + up * 128 + (f & 127); }
        p0_transpose_block(W, K, N, WT, K, 64 * kb, n0, drow, scr, F.lane, n0 < nscale ? scale : 1.f);
    }
    return base + items;
}
__device__ __forceinline__ void p0_strip_i8(Frame& F, const float* W, int N, signed char* WT, int n0, int drow, float* swd, const float presc, int par) {
    LAS float* scr = (LAS float*)(F.lds + F.wave * 16384);
    LAS float* red = (LAS float*)(F.lds + 131072 + par * 2048);
    const int lane = F.lane, kb = F.wave * 128;
    float tv[64];
#pragma unroll
    for (int i = 0; i < 64; ++i) { const int kk = 64 * (i >> 5) + 2 * (i & 31) + (lane >> 5); tv[i] = W[(size_t)(kb + kk) * N + n0 + (lane & 31)]; }
    float m = 0.f;
#pragma unroll
    for (int i = 0; i < 64; ++i) m = fmaxf(m, fabsf(tv[i]));
    red[(F.wave * 2 + (lane >> 5)) * 32 + (lane & 31)] = m;
    __syncthreads();
    float mx = 0.f;
#pragma unroll
    for (int j = 0; j < 16; ++j) mx = fmaxf(mx, red[j * 32 + (lane & 31)]);
    const float inv = mx > 0.f ? 127.0f / mx : 0.f;
    if (F.wave == 0 && lane < 32) swd[drow + lane] = mx * presc * (1.0f / 127.0f);
    const int c = lane & 3;
#pragma unroll
    for (int h = 0; h < 2; ++h) {
#pragma unroll
        for (int i = 0; i < 32; ++i) { const int kk = 2 * i + (lane >> 5); scr[kk * 33 + (lane & 31)] = rintf(tv[32 * h + i] * inv); }
        asm volatile("s_waitcnt lgkmcnt(0)" ::: "memory");
#pragma unroll
        for (int j = 0; j < 2; ++j) { const int n = (lane >> 2) + 16 * j; const LAS float* sp = scr + (16 * c) * 33 + n; u32x4 o;
#pragma unroll
            for (int q = 0; q < 4; ++q) { const int b0 = (int)sp[(4 * q + 0) * 33], b1 = (int)sp[(4 * q + 1) * 33], b2 = (int)sp[(4 * q + 2) * 33], b3 = (int)sp[(4 * q + 3) * 33];
                o[q] = (unsigned)(b0 & 0xff) | ((unsigned)(b1 & 0xff) << 8) | ((unsigned)(b2 & 0xff) << 16) | ((unsigned)(b3 & 0xff) << 24); }
            *(u32x4*)(WT + (size_t)(drow + n) * 1024 + kb + 64 * h + 16 * c) = o; }
        asm volatile("s_waitcnt lgkmcnt(0)" ::: "memory");
    }
}
__device__ __forceinline__ void p0_strips(Frame& F, int wg, int nwg, const float* w_in0, const float* w_gu0, const float* w_in1, const float* w_gu1, int e0, int e1) {
    constexpr int S0 = EV_IN / 32, S1 = 2 * FFN / 32, S2 = OD_IN / 32, SE = 2 * EXD / 32;
    const int nd = w_in0 ? S0 + S1 + S2 : 0, total = nd + (e1 - e0) * SE;
    int par = 0;
    __syncthreads();
    for (int it = wg; it < total; it += nwg, par ^= 1) {
        const float* W; int N, n0, drow, fgu = 0; signed char* WT; float* sd; float presc = 1.f;
        if (it < nd) {
            if (it < S0) { W = w_in0; N = EV_IN; n0 = 32 * it; WT = (signed char*)(F.ws + WS_WI0); sd = F.SWD2(); }
            else if (it < S0 + S1) { W = w_gu0; N = 2 * FFN; n0 = 32 * (it - S0); WT = (signed char*)(F.ws + WS_WGU0); sd = F.SWD2() + EV_INP; fgu = FFN; }
            else { W = w_in1; N = OD_IN; n0 = 32 * (it - S0 - S1); WT = (signed char*)(F.ws + WS_WI1); sd = F.SWD2() + EV_INP + 2 * FFN; if (n0 < 512) presc = ATT_C64; }
        } else { const int j = it - nd, e = e0 + j / SE; n0 = 32 * (j % SE); W = w_gu1 + (size_t)e * 1024 * 2 * EXD; N = 2 * EXD; WT = (signed char*)(F.ws + WS_WGU1) + (size_t)e * 2 * EXD * 1024; sd = F.SWD() + e * (2 * EXD); fgu = EXD; }
        drow = n0; if (fgu) { const int up = n0 >= fgu ? 1 : 0, f = n0 - up * fgu; drow = (f >> 7) * 256 + up * 128 + (f & 127); }
        p0_strip_i8(F, W, N, WT, n0, drow, sd, presc, par);
    }
    if (w_in0) { u32x4 z = {0u, 0u, 0u, 0u}; u32x4* p = (u32x4*)((signed char*)(F.ws + WS_WI0) + (size_t)EV_IN * 1024); const int gw = wg * NWAVES + F.wave, ngw = nwg * NWAVES;
        for (int i = gw * 64 + F.lane; i < (EV_INP - EV_IN) * 1024 / 16; i += ngw * 64) p[i] = z;
        if (gw == 0) F.SWD2()[EV_IN + F.lane] = 0.f; }
    __syncthreads();
}
constexpr int MOE_DEFER_GU = 3;
constexpr int MOE_DEFER_GU_OLD = 8;
__device__ __forceinline__ void p0_deferred(Frame& F, const float* w_gu1, const float* w_d1, int wg, int nwg) {
    LAS float* scr = (LAS float*)(F.lds + F.wave * 16384);
    const int gw = wg * NWAVES + F.wave, ngw = nwg * NWAVES; int base = 0;
    for (int e = 0; e < NEXP; ++e) base = p0_matrix(F, w_d1 + (size_t)e * EXD * 1024, EXD, 1024, (bf16_t*)(F.ws + WS_WD1) + (size_t)e * 1024 * EXD, 0, base, scr, 1.f, 0, gw, ngw);
    __syncthreads();
}
__device__ __forceinline__ void p0_deferred_gu(Frame& F, const float* w_gu1, int e0, int e1, int wg, int nwg, const float* w_in0 = nullptr, const float* w_gu0 = nullptr, const float* w_in1 = nullptr) {
    if (I8_STRIP) { p0_strips(F, wg, nwg, w_in0, w_gu0, w_in1, w_gu1, e0, e1); return; }
    LAS float* scr = (LAS float*)(F.lds + F.wave * 16384);
    const int gw = wg * NWAVES + F.wave, ngw = nwg * NWAVES; int base = 0;
    if (w_in0) {
        unsigned* sm = F.ctl + CW_SWMAX2; float* sd = F.SWD2();
        if (I8_WIN0) base = p0_matrix_i8(F, w_in0, 1024, EV_IN, (signed char*)(F.ws + WS_WI0), 0, base, scr, sm, sd, gw, ngw);
        if (I8_GU0) base = p0_matrix_i8(F, w_gu0, 1024, 2 * FFN, (signed char*)(F.ws + WS_WGU0), FFN, base, scr, sm + EV_IN, sd + EV_INP, gw, ngw);
        if (I8_WIN1) base = p0_matrix_i8(F, w_in1, 1024, OD_IN, (signed char*)(F.ws + WS_WI1), 0, base, scr, sm + EV_IN + 2 * FFN, sd + EV_INP + 2 * FFN, gw, ngw, ATT_C64, 512);
        if (I8_WIN0) { u32x4 z = {0u, 0u, 0u, 0u}; u32x4* p = (u32x4*)((signed char*)(F.ws + WS_WI0) + (size_t)EV_IN * 1024);
          for (int i = gw * 64 + F.lane; i < (EV_INP - EV_IN) * 1024 / 16; i += ngw * 64) p[i] = z;
          if (gw == 0) sd[EV_IN + F.lane] = 0.f; } }
    for (int e = e0; e < e1; ++e) base = p0_matrix_i8(F, w_gu1 + (size_t)e * 1024 * 2 * EXD, 1024, 2 * EXD, (signed char*)(F.ws + WS_WGU1) + (size_t)e * 2 * EXD * 1024, EXD, base, scr, F.ctl + CW_SWMAX + e * (2 * EXD), F.SWD() + e * (2 * EXD), gw, ngw);
    __syncthreads();
}
__device__ __forceinline__ void p0_prologue(Frame& F, const ProIn I) {
    LAS float* scr = (LAS float*)(F.lds + F.wave * 16384);
    unsigned char* ws = F.ws;
    int base = 0;
    if (I8_STRIP) p0_strips(F, (int)blockIdx.x, F.G, I.w_in0, I.w_gu0, I.w_in1, I.w_gu1, 0, MOE_DEFER_GU);
    if (!I8_WIN0) base = p0_matrix(F, I.w_in0, 1024, EV_IN, (bf16_t*)(ws + WS_WI0), 0, base, scr);
    if (!I8_GU0) base = p0_matrix(F, I.w_gu0, 1024, 2 * FFN, (bf16_t*)(ws + WS_WGU0), FFN, base, scr);
    if (!I8_WIN1) base = p0_matrix(F, I.w_in1, 1024, OD_IN, (bf16_t*)(ws + WS_WI1), 0, base, scr, ATT_C64, 512);
    if (!I8_WIN0) { u32x4 z = {0u, 0u, 0u, 0u}; u32x4* p = (u32x4*)((bf16_t*)(ws + WS_WI0) + (size_t)EV_IN * 1024); for (int i = F.gw * 64 + F.lane; i < (EV_INP - EV_IN) * 1024 / 8; i += F.NGW * 64) p[i] = z; }
    base = p0_matrix(F, I.w_uq, 384, 768, (bf16_t*)(ws + WS_WUQ), 0, base, scr, ATT_C96, 768);
    base = p0_matrix(F, I.w_ukv, 256, 1024, (bf16_t*)(ws + WS_WUKV), 0, base, scr);
    base = p0_matrix(F, I.w_out0, 1024, 1024, (bf16_t*)(ws + WS_WO0), 0, base, scr);
    base = p0_matrix(F, I.w_d0, FFN, 1024, (bf16_t*)(ws + WS_WD0), 0, base, scr);
    base = p0_matrix(F, I.w_out1, 1024, 1024, (bf16_t*)(ws + WS_WO1), 0, base, scr);
    if (!I8_STRIP) for (int e = 0; e < NEXP; ++e) base = p0_absmax(F, I.w_gu1 + (size_t)e * 1024 * 2 * EXD, 1024, 2 * EXD, F.ctl + CW_SWMAX + e * (2 * EXD), base);
    if (!I8_STRIP) { base = p0_absmax(F, I.w_in0, 1024, EV_IN, F.ctl + CW_SWMAX2, base); } if (!I8_STRIP) base = p0_absmax(F, I.w_gu0, 1024, 2 * FFN, F.ctl + CW_SWMAX2 + EV_IN, base); if (!I8_STRIP) base = p0_absmax(F, I.w_in1, 1024, OD_IN, F.ctl + CW_SWMAX2 + EV_IN + 2 * FFN, base);
    if (blockIdx.x == F.G - 1) {
        for (int i = F.tid; i < 128 * 8; i += NTHREADS) { const int pos = i >> 3, f = i & 7; const float inv = 1.0f / powf(10000.0f, (float)f / 8.0f); const float a = (float)pos * inv; F.TAB8()[i] = cosf(a); F.TAB8()[1024 + i] = sinf(a); }
        for (int i = F.tid; i < 128 * 16; i += NTHREADS) { const int pos = i >> 4, f = i & 15; const float inv = 1.0f / powf(10000.0f, (float)f / 16.0f); const float a = (float)pos * inv; F.TAB16()[i] = cosf(a); F.TAB16()[2048 + i] = sinf(a); }
    }
    __syncthreads();
    if ((int)blockIdx.x < 192) {
        LAS float* sc = (LAS float*)F.lds;
        LAS float* red = (LAS float*)(F.lds + 40960);
        for (int i = F.tid; i < 9 * 1024; i += NTHREADS) { const int r = i >> 10, k = i & 1023; const float v = (r < 8) ? I.c[r * 1024 + k] : I.c_ctx[k]; sc[i] = silu_f(v); }
        __syncthreads();
        const int layer = blockIdx.x / 96, n0 = (blockIdx.x % 96) * 64;
        const float* w = I.mod_w + (size_t)layer * 1024 * MOD_ROW + n0 + F.lane;
        float acc[9];
#pragma unroll
        for (int r = 0; r < 9; ++r) acc[r] = 0.f;
        const int kb = F.wave * 128;
#pragma unroll 8
        for (int k = 0; k < 128; ++k) { const float wv = w[(size_t)(kb + k) * MOD_ROW];
#pragma unroll
            for (int r = 0; r < 9; ++r) acc[r] += sc[r * 1024 + kb + k] * wv; }
#pragma unroll
        for (int r = 0; r < 9; ++r) red[(F.wave * 9 + r) * 64 + F.lane] = acc[r];
        __syncthreads();
        for (int i = F.tid; i < 9 * 64; i += NTHREADS) { const int r = i >> 6, l = i & 63; float s = I.mod_b[layer * MOD_ROW + n0 + l];
#pragma unroll
            for (int wv = 0; wv < 8; ++wv) s += red[(wv * 9 + r) * 64 + l];
            F.MOD()[((size_t)layer * 9 + r) * MOD_ROW + n0 + l] = s; }
    }
}

template <bool SRC_IN, bool ROUTER, bool OUT8 = true>
__device__ __forceinline__ void norm_pass(Frame& F, int grp, int layer, int which, const float* norm_g, const float* xin, const float* ctxin, const float* router_w, const float* part = nullptr, const int nslice = 0, const int gidx = 0, const float* gmod = nullptr, const bool dry = false) {
    const float* gain = norm_g + (size_t)(layer * 2 + which) * DM;
    const float* mod = F.MOD() + (size_t)layer * 9 * MOD_ROW;
    LAS float* rw = (LAS float*)F.lds;
    LAS unsigned* lcnt = (LAS unsigned*)(F.lds + 32768);
    if constexpr (ROUTER) { for (int i = F.tid; i < 1024 * 8; i += NTHREADS) rw[i] = router_w[i]; if (F.tid < 8) lcnt[F.tid] = 0u; __syncthreads(); }
    constexpr int RPW = (RROWS + 2047) / 2048;
    const int rpw = (RROWS + F.NGW - 1) / F.NGW; (void)RPW;
    const int r0 = F.gw * rpw, r1 = (r0 + rpw < RROWS) ? r0 + rpw : RROWS;
    f32x4 pg[4], psc[4], psh[4]; int cur = -1;
#pragma unroll
    for (int j = 0; j < 4; ++j) pg[j] = *(const f32x4*)(gain + 4 * F.lane + 256 * j);
    f32x4 nf[4]; u32x2 nb[4]; bool have = false;
#define NP_ISSUE(rr) do { int bl_, t_; row_bt((rr), bl_, t_); if (t_ >= CTXL) { have = true; \
        if constexpr (SRC_IN) { const float* s_ = xin + ((size_t)(grp * GB + bl_) * SEQ + (t_ - CTXL)) * DM + 4 * F.lane; _Pragma("unroll") for (int j = 0; j < 4; ++j) nf[j] = *(const f32x4*)(s_ + 256 * j); } \
        else { const bf16_t* s_ = F.X16() + ((size_t)bl_ * SEQ + (t_ - CTXL)) * DM + 4 * F.lane; _Pragma("unroll") for (int j = 0; j < 4; ++j) nb[j] = *(const u32x2*)(s_ + 256 * j); } } } while (0)
    if (r0 < r1) NP_ISSUE(r0);
    for (int r = r0; r < r1; ++r) {
        int bl, t; row_bt(r, bl, t); const int b = grp * GB + bl; const bool isctx = t < CTXL;
        f32x4 v[4]; const bool pre = have;
        if (pre) {
#pragma unroll
            for (int j = 0; j < 4; ++j) { if constexpr (SRC_IN) v[j] = nf[j]; else v[j] = (f32x4){bflo(nb[j].x), bfhi(nb[j].x), bflo(nb[j].y), bfhi(nb[j].y)}; } }
        have = false; if (r + 1 < r1) NP_ISSUE(r + 1);
        if (ROUTER && isctx) continue;
        const int mrow = isctx ? 8 : b;
        if (mrow != cur) { cur = mrow;
#pragma unroll
            for (int j = 0; j < 4; ++j) { psh[j] = *(const f32x4*)(mod + mrow * MOD_ROW + (which ? 3 : 0) * DM + 4 * F.lane + 256 * j); psc[j] = *(const f32x4*)(mod + mrow * MOD_ROW + (which ? 4 : 1) * DM + 4 * F.lane + 256 * j); } }
        const float* src = nullptr; float* dst = nullptr; bf16_t* x16 = F.X16() + ((size_t)bl * SEQ + (t - CTXL)) * DM;
        if (isctx) { dst = F.CX() + ((size_t)b * CTXL + t) * DM; src = SRC_IN ? ctxin + ((size_t)b * CTXL + t) * DM : dst; }
        else if (SRC_IN) src = xin + ((size_t)b * SEQ + (t - CTXL)) * DM;
        float s = 0.f;
        if (!pre) {
#pragma unroll
            for (int j = 0; j < 4; ++j) v[j] = *(const f32x4*)(src + 4 * F.lane + 256 * j); }
        if (part != nullptr && isctx) {
            const float* pr = part + ((size_t)bl * CTXL + t) * DM + 4 * F.lane;
#pragma unroll
            for (int j = 0; j < 4; ++j) { f32x4 a = *(const f32x4*)(pr + 256 * j);
                for (int sl = 1; sl < nslice; ++sl) a = a + *(const f32x4*)(pr + (size_t)sl * (GB * CTXL) * DM + 256 * j);
                v[j] = v[j] + a * *(const f32x4*)(gmod + 8 * MOD_ROW + gidx * DM + 4 * F.lane + 256 * j); *(f32x4*)(dst + 4 * F.lane + 256 * j) = v[j]; } }
#pragma unroll
        for (int j = 0; j < 4; ++j) s += (v[j].x * v[j].x + v[j].y * v[j].y) + (v[j].z * v[j].z + v[j].w * v[j].w);
        if constexpr (SRC_IN) {
            if (isctx) {
#pragma unroll
                for (int j = 0; j < 4; ++j) *(f32x4*)(dst + 4 * F.lane + 256 * j) = v[j];
            } else {
#pragma unroll
                for (int j = 0; j < 4; ++j) { u32x2 w; w.x = pk2(v[j].x, v[j].y); w.y = pk2(v[j].z, v[j].w); *(u32x2*)(x16 + 4 * F.lane + 256 * j) = w; } } }
        const float rstd = rsq_f(wave_sum(s, F.lane) * (1.0f / DM) + NORM_EPS);
#pragma unroll
        for (int j = 0; j < 4; ++j) v[j] = (v[j] * rstd) * pg[j] * (psc[j] + 1.0f) + psh[j];
        if constexpr (!OUT8) {
#pragma unroll
            for (int j = 0; j < 4; ++j) { u32x2 w; w.x = pk2(v[j].x, v[j].y); w.y = pk2(v[j].z, v[j].w); *(u32x2*)(F.HB() + (size_t)r * DM + 4 * F.lane + 256 * j) = w; }
        } else {
            float mx = 0.f;
#pragma unroll
            for (int j = 0; j < 4; ++j) mx = fmaxf(fmaxf(fmaxf(mx, fabsf(v[j].x)), fabsf(v[j].y)), fmaxf(fabsf(v[j].z), fabsf(v[j].w)));
            mx = red_max<64>(mx);
            const float inv = mx > 0.f ? 127.0f / mx : 0.f; signed char* h8 = (signed char*)F.HB() + (size_t)r * DM;
#pragma unroll
            for (int j = 0; j < 4; ++j) { const int b0 = (int)rintf(v[j].x * inv), b1 = (int)rintf(v[j].y * inv), b2 = (int)rintf(v[j].z * inv), b3 = (int)rintf(v[j].w * inv);
                *(unsigned*)(h8 + 4 * F.lane + 256 * j) = (unsigned)(b0 & 0xff) | ((unsigned)(b1 & 0xff) << 8) | ((unsigned)(b2 & 0xff) << 16) | ((unsigned)(b3 & 0xff) << 24); }
            if (F.lane == 0 && !dry) F.SATOK()[r] = mx * (1.0f / 127.0f); }
        if constexpr (ROUTER) {
            float lg[8];
#pragma unroll
            for (int e = 0; e < 8; ++e) lg[e] = 0.f;
#pragma unroll
            for (int j = 0; j < 4; ++j)
#pragma unroll
                for (int q = 0; q < 4; ++q) { const int col = 4 * F.lane + 256 * j + q; const f32x4 wa = *(const LAS f32x4*)(rw + col * 8), wb = *(const LAS f32x4*)(rw + col * 8 + 4); const float hv = v[j][q];
                    lg[0] += hv * wa.x; lg[1] += hv * wa.y; lg[2] += hv * wa.z; lg[3] += hv * wa.w; lg[4] += hv * wb.x; lg[5] += hv * wb.y; lg[6] += hv * wb.z; lg[7] += hv * wb.w; }
#pragma unroll
            for (int e = 0; e < 8; ++e) lg[e] = wave_sum(lg[e], F.lane);
            int e0 = 0; float l0 = lg[0];
#pragma unroll
            for (int e = 1; e < 8; ++e) if (lg[e] > l0) { l0 = lg[e]; e0 = e; }
            int e1 = -1; float l1 = -3.0e38f;
#pragma unroll
            for (int e = 0; e < 8; ++e) if (e != e0 && lg[e] > l1) { l1 = lg[e]; e1 = e; }
            if (F.lane == 0 && !dry) { const int tok = bl * SEQ + (t - CTXL); const float w1 = 1.0f / (1.0f + __expf(l0 - l1)), w0 = 1.0f - w1;
                F.TOPE()[tok * 2] = e0; F.TOPE()[tok * 2 + 1] = e1; F.TOPW()[tok * 2] = w0; F.TOPW()[tok * 2 + 1] = w1;
                F.SLOT()[tok * 2] = (int)__hip_atomic_fetch_add(lcnt + e0, 1u, __ATOMIC_RELAXED, __HIP_MEMORY_SCOPE_WORKGROUP); F.SLOT()[tok * 2 + 1] = (int)__hip_atomic_fetch_add(lcnt + e1, 1u, __ATOMIC_RELAXED, __HIP_MEMORY_SCOPE_WORKGROUP); }
        }
    }
#undef NP_ISSUE
    if constexpr (ROUTER) if (!dry) { __syncthreads();
        if (F.tid < 8) { const unsigned c = lcnt[F.tid]; const unsigned base = __hip_atomic_fetch_add(F.ctl + CW_CNT + grp * 64 + F.tid, c, RLX_AGENT); F.ctl[CW_WGB + (grp * 256 + (F.gw >> 3)) * 8 + F.tid] = base; } }
}

__device__ __forceinline__ void fix_even(Frame& F, const float* qn, const float* kvn, const float* cw, const float* alog, const float* dtb, const int conv_reps, const bool dry = false) {
    LAS float* cwl = (LAS float*)F.lds;
    for (int i = F.tid; i < 5 * 1536; i += NTHREADS) cwl[i] = cw[i];
    __syncthreads();
    const int rpw = (RROWS + F.NGW - 1) / F.NGW, r0w = F.gw * rpw, r1w = (r0w + rpw < RROWS) ? r0w + rpw : RROWS;
    unsigned win[5][12];
    for (int r = r0w; r < r1w; ++r) {
        int bl, t; row_bt(r, bl, t); const bool isctx = t < CTXL;
        bf16_t* prow = F.PB() + (size_t)r * EV_INP;
        { unsigned w[3]; float s = 0.f;
#pragma unroll
          for (int j = 0; j < 3; ++j) { w[j] = *(const unsigned*)(prow + PC_CQ + 2 * (F.lane + 64 * j)); const float a = bflo(w[j]), b2 = bfhi(w[j]); s += a * a + b2 * b2; }
          const float rstd = rsq_f(wave_sum(s, F.lane) * (1.0f / 384.0f) + NORM_EPS);
#pragma unroll
          for (int j = 0; j < 3; ++j) { const int c = 2 * (F.lane + 64 * j); if (!dry) *(unsigned*)(prow + PC_CQ + c) = pk2(bflo(w[j]) * rstd * qn[c], bfhi(w[j]) * rstd * qn[c + 1]); } }
        { unsigned w[2]; float s = 0.f;
#pragma unroll
          for (int j = 0; j < 2; ++j) { w[j] = *(const unsigned*)(prow + PC_CKV + 2 * (F.lane + 64 * j)); const float a = bflo(w[j]), b2 = bfhi(w[j]); s += a * a + b2 * b2; }
          const float rstd = rsq_f(wave_sum(s, F.lane) * (1.0f / 256.0f) + NORM_EPS);
#pragma unroll
          for (int j = 0; j < 2; ++j) { const int c = 2 * (F.lane + 64 * j); if (!dry) *(unsigned*)(prow + PC_CKV + c) = pk2(bflo(w[j]) * rstd * kvn[c], bfhi(w[j]) * rstd * kvn[c + 1]); } }
        { const int i = F.lane & 31; const float v = bf2f(prow[PC_KPE + i]); const float pv = sx(v, 8, F.lane); float o = v;
          if (!isctx) { const int tl = t - CTXL; const int pos = (i >> 4) ? (tl & 63) : (tl >> 6); const int f = i & 7; const float cs = F.TAB8()[pos * 8 + f], sn = F.TAB8()[1024 + pos * 8 + f];
              o = (i & 8) ? (v * cs + pv * sn) : (v * cs - pv * sn); }
          if (F.lane < 32) F.KPE()[(size_t)r * 32 + i] = (bf16_t)f2bf(o); }
        if (F.lane < 16) { const float a = bf2f(prow[PC_A + F.lane]), bb = bf2f(prow[PC_B + F.lane]); const float xx = a + dtb[F.lane];
            const float sp = (xx > 20.f) ? xx : __logf(1.0f + __expf(xx)); F.GG()[(size_t)r * 16 + F.lane] = -__expf(alog[F.lane]) * sp; F.GBT()[(size_t)r * 16 + F.lane] = __builtin_amdgcn_rcpf(1.0f + __expf(-bb)); }
        for (int crep = 0; crep < conv_reps; ++crep) { const int tlo = isctx ? 0 : CTXL, thi = isctx ? CTXL : TT;
          unsigned cwa = (unsigned)(uintptr_t)(const void*)cwl; asm volatile("" : "+v"(cwa)); const LAS float* cwr = (const LAS float*)(uintptr_t)cwa;
          float va[12], vb[12];
#pragma unroll
          for (int j = 0; j < 12; ++j) { va[j] = 0.f; vb[j] = 0.f; }
          if (r == r0w && crep == 0) {
#pragma unroll
              for (int k = 0; k < 4; ++k) { int rr = r + k - 2; rr = rr < 0 ? 0 : (rr >= RROWS ? RROWS - 1 : rr); const bf16_t* nrow = F.PB() + (size_t)rr * EV_INP + PC_GQKV;
#pragma unroll
                  for (int j = 0; j < 12; ++j) win[k][j] = *(const unsigned*)(nrow + 2 * (F.lane + 64 * j)); } }
          if (crep == 0) { int rr = r + 2; rr = rr >= RROWS ? RROWS - 1 : rr; const bf16_t* nrow = F.PB() + (size_t)rr * EV_INP + PC_GQKV;
#pragma unroll
              for (int j = 0; j < 12; ++j) win[4][j] = *(const unsigned*)(nrow + 2 * (F.lane + 64 * j)); }
#pragma unroll
          for (int k = 0; k < 5; ++k) { const int tk = t + k - 2; const float msk = (tk < tlo || tk >= thi) ? 0.f : 1.f;
#pragma unroll
              for (int j = 0; j < 12; ++j) { const int c = 2 * (F.lane + 64 * j); const unsigned w = win[k][j]; const f32x2 wk = *(const LAS f32x2*)(cwr + k * 1536 + c);
                  va[j] += bflo(w) * (wk.x * msk); vb[j] += bfhi(w) * (wk.y * msk); } }
#pragma unroll
          for (int j = 0; j < 12; ++j) { float a = silu_f(va[j]), b2 = silu_f(vb[j]);
              if (j < 8) { float s = a * a + b2 * b2;
                  s = red_sum<32>(s);
                  const float sc = (j < 4 ? 0.125f : 1.0f) * rsq_f(s + NORM_EPS); a *= sc; b2 *= sc; }
              bf16_t* dst = (j < 4) ? F.GQ() : (j < 8) ? F.GK() : F.GV();
              *(unsigned*)(dst + (size_t)r * 512 + (j & 3) * 128 + 2 * F.lane) = pk2(a, b2); } }
#pragma unroll
        for (int k = 0; k < 4; ++k)
#pragma unroll
            for (int j = 0; j < 12; ++j) win[k][j] = win[k + 1][j];
    }
}

__device__ __forceinline__ void q_rope(Frame& F, const bool dry = false) {
    for (int r = F.gw; r < RROWS; r += F.NGW) {
        int bl, t; row_bt(r, bl, t); if (t < CTXL) continue;
        const int tl = t - CTXL; const int h = F.lane >> 3, gq = F.lane & 7;
        bf16_t* p = F.QR() + (size_t)r * 768 + h * 96 + 64 + 4 * gq;
        const u32x2 w = *(const u32x2*)p; float v[4] = {bflo(w.x), bfhi(w.x), bflo(w.y), bfhi(w.y)}, o[4];
        const int pos = (gq & 4) ? (tl & 63) : (tl >> 6);
#pragma unroll
        for (int e = 0; e < 4; ++e) { const float pv = sx(v[e], 2, F.lane); const int f = 4 * (gq & 1) + e; const float cs = F.TAB8()[pos * 8 + f], sn = F.TAB8()[1024 + pos * 8 + f];
            o[e] = (gq & 2) ? (v[e] * cs + pv * sn) : (v[e] * cs - pv * sn); }
        u32x2 ow; ow.x = pk2(o[0], o[1]); ow.y = pk2(o[2], o[3]); *(u32x2*)p = dry ? w : ow;
    }
}

__device__ __forceinline__ void fix_odd(Frame& F, const float* gqn, const float* gkn, const int grp, const bool dry = false) {
    float kmx[2] = {0.f, 0.f};
    for (int r = F.gw; r < RROWS; r += F.NGW) {
        int bl, t; row_bt(r, bl, t); const bool isctx = t < CTXL; const int tl = t - CTXL;
        bf16_t* prow = F.PB() + (size_t)r * OD_IN;
        const int s16 = F.lane & 15, vq = F.lane >> 4;
        const int pos = (s16 & 8) ? (tl & 63) : (tl >> 6);
        u32x2 wv[7];
#pragma unroll
        for (int it = 0; it < 7; ++it) { const int v = it * 4 + vq; const bool act = v < 26;
            const int col = (v < 8) ? (P1_DQ + 64 * v) : (v < 16) ? (P1_DK + 64 * (v - 8)) : (v < 24) ? (P1_GQ + 64 * (v - 16)) : (P1_GK + 64 * (v - 24));
            wv[it] = *(const u32x2*)(prow + (act ? col : 0) + 4 * s16); }
#pragma unroll
        for (int it = 0; it < 7; ++it) { const int v = it * 4 + vq; const bool act = v < 26;
            const int col = (v < 8) ? (P1_DQ + 64 * v) : (v < 16) ? (P1_DK + 64 * (v - 8)) : (v < 24) ? (P1_GQ + 64 * (v - 16)) : (P1_GK + 64 * (v - 24));
            bf16_t* p = prow + (act ? col : 0) + 4 * s16;
            const u32x2 w = wv[it]; float x[4] = {bflo(w.x), bfhi(w.x), bflo(w.y), bfhi(w.y)};
            if (it == 2 || it == 3) { float s = x[0] * x[0] + x[1] * x[1] + x[2] * x[2] + x[3] * x[3];
                s = red_sum<16>(s);
                kmx[it - 2] = fmaxf(kmx[it - 2], s); }
            if (v >= 16) { float s = x[0] * x[0] + x[1] * x[1] + x[2] * x[2] + x[3] * x[3];
                s = red_sum<16>(s);
                const float rstd = rsq_f(s * (1.0f / 64.0f) + NORM_EPS); const float* gn = (v < 24) ? gqn : gkn;
#pragma unroll
                for (int e = 0; e < 4; ++e) x[e] = x[e] * (v < 24 ? rstd * ATT_C64 : rstd) * gn[4 * s16 + e]; }
            float o4[4];
#pragma unroll
            for (int e = 0; e < 4; ++e) { const float pv = sx(x[e], 4, F.lane); o4[e] = x[e];
                if (!isctx) { const int f = 4 * (s16 & 3) + e; const float cs = F.TAB16()[pos * 16 + f], sn = F.TAB16()[2048 + pos * 16 + f]; o4[e] = (s16 & 4) ? (x[e] * cs + pv * sn) : (x[e] * cs - pv * sn); } }
            if (act) { u32x2 ow; ow.x = pk2(o4[0], o4[1]); ow.y = pk2(o4[2], o4[3]); *(u32x2*)p = dry ? w : ow; }
        }
    }
    { LAS float* red = (LAS float*)F.lds; const int vq = F.lane >> 4;
      if ((F.lane & 15) == 0) { red[F.wave * 8 + vq] = kmx[0]; red[F.wave * 8 + 4 + vq] = kmx[1]; }
      __syncthreads();
      if (F.tid < 8 && !dry) { float m = 0.f;
#pragma unroll
          for (int w = 0; w < 8; ++w) m = fmaxf(m, red[w * 8 + F.tid]);
          ((float*)(F.ctl + CW_KMAX))[(grp * 256 + (F.gw >> 3)) * 8 + F.tid] = m; }
      __syncthreads(); }
}

__device__ __forceinline__ void gdn_out(Frame& F, const float* on) {
    const int c0 = 8 * F.lane;
    float onv[8];
#pragma unroll
    for (int q = 0; q < 8; ++q) onv[q] = on[(c0 & 63) + q];
    for (int rb = F.gw; rb < RROWS; rb += 4 * F.NGW) {
        u32x4 a[4], b[4], z[4];
#pragma unroll
        for (int u = 0; u < 4; ++u) { const int r = rb + u * F.NGW; const size_t rr = r < RROWS ? r : 0;
            a[u] = *(const u32x4*)(F.OF() + rr * 512 + c0); b[u] = *(const u32x4*)(F.OB() + rr * 512 + c0); z[u] = *(const u32x4*)(F.PB() + rr * EV_INP + PC_Z + c0); }
#pragma unroll
        for (int u = 0; u < 4; ++u) { const int r = rb + u * F.NGW;
            float o[8]; float s = 0.f;
#pragma unroll
            for (int q = 0; q < 4; ++q) { o[2 * q] = bflo(a[u][q]) + bflo(b[u][q]); o[2 * q + 1] = bfhi(a[u][q]) + bfhi(b[u][q]); s += o[2 * q] * o[2 * q] + o[2 * q + 1] * o[2 * q + 1]; }
            s = red_sum<8>(s);
            const float rstd = rsq_f(s * (1.0f / 64.0f) + NORM_EPS);
            u32x4 w;
#pragma unroll
            for (int q = 0; q < 4; ++q) { const float y0 = o[2 * q] * rstd * onv[2 * q] * silu_f(bflo(z[u][q])), y1 = o[2 * q + 1] * rstd * onv[2 * q + 1] * silu_f(bfhi(z[u][q])); w[q] = pk2(y0, y1); }
            if (r < RROWS) *(u32x4*)(F.HB() + (size_t)r * DM + 512 + c0) = w; }
    }
}

__device__ __forceinline__ void diff_post(Frame& F, const float* lp, const float* dn) {
    const float lambda_init = 0.8f - 0.6f * expf(-0.3f);
    const float s1 = red_sum<64>(lp[F.lane] * lp[64 + F.lane]), s2 = red_sum<64>(lp[128 + F.lane] * lp[192 + F.lane]);
    const float lam = __expf(s1) - __expf(s2) + lambda_init;
    const int h = F.lane >> 4, j0 = 8 * (F.lane & 15);
    float dnv[8];
#pragma unroll
    for (int q = 0; q < 8; ++q) dnv[q] = dn[j0 + q];
    for (int rb = F.gw; rb < RROWS; rb += 4 * F.NGW) {
        u32x4 a[4], b[4]; bool ok[4];
#pragma unroll
        for (int u = 0; u < 4; ++u) { const int r = rb + u * F.NGW; int bl = 0, t = 0; ok[u] = r < RROWS; if (ok[u]) { row_bt(r, bl, t); ok[u] = t >= CTXL; }
            const bf16_t* od = F.KV() + (size_t)(ok[u] ? r : 0) * DM + h * 256 + j0; a[u] = *(const u32x4*)od; b[u] = *(const u32x4*)(od + 128); }
#pragma unroll
        for (int u = 0; u < 4; ++u) { const int r = rb + u * F.NGW;
            float d[8]; float s = 0.f;
#pragma unroll
            for (int q = 0; q < 4; ++q) { d[2 * q] = bflo(a[u][q]) - lam * bflo(b[u][q]); d[2 * q + 1] = bfhi(a[u][q]) - lam * bfhi(b[u][q]); s += d[2 * q] * d[2 * q] + d[2 * q + 1] * d[2 * q + 1]; }
            s = red_sum<16>(s);
            const float rstd = (1.0f - lambda_init) * rsq_f(s * (1.0f / 128.0f) + NORM_EPS);
            u32x4 w;
#pragma unroll
            for (int q = 0; q < 4; ++q) w[q] = pk2(d[2 * q] * rstd * dnv[2 * q], d[2 * q + 1] * rstd * dnv[2 * q + 1]);
            if (ok[u]) *(u32x4*)(F.HB() + (size_t)r * DM + h * 128 + j0) = w; }
    }
}

__device__ __forceinline__ void moe_tends(Frame& F, int grp) {
    if (F.tid == 0) { int acc = 0;
        for (int e = 0; e < 8; ++e) { const int c = (int)__hip_atomic_load(F.ctl + CW_CNT + grp * 64 + e, RLX_AGENT); F.MISC[24 + e] = (unsigned)(acc * 256); acc += (c + 255) >> 8; F.MISC[16 + e] = (unsigned)acc; } }
    __syncthreads();
}
__device__ __forceinline__ void moe_gather(Frame& F, int grp, const bool dry = false) {
    if (dry) return;
    const int rpw = (RROWS + F.NGW - 1) / F.NGW; const int r0 = F.gw * rpw, r1 = (r0 + rpw < RROWS) ? r0 + rpw : RROWS;
    const unsigned* wgb = F.ctl + CW_WGB + (grp * 256 + (F.gw >> 3)) * 8;
    float* ssc = (float*)((signed char*)F.XG() + (size_t)MOE_ROWS * DM); int* s2t = (int*)(ssc + MOE_ROWS);
    for (int rb = r0; rb < r1; rb += 64) { const int r = rb + F.lane;
        if (r < r1) { int bl, t; row_bt(r, bl, t);
            if (t >= CTXL) { const int tok = bl * SEQ + (t - CTXL); const float sat = F.SATOK()[r];
#pragma unroll
                for (int k = 0; k < 2; ++k) { const int e = F.TOPE()[tok * 2 + k]; const int row = (int)F.MISC[24 + e] + (int)wgb[e] + F.SLOT()[tok * 2 + k];
                    s2t[row] = r; ssc[row] = sat; F.SLOT()[tok * 2 + k] = row; } } } }
    if (F.gw < 64) { const int e = F.gw >> 3;
        const int start = (int)F.MISC[24 + e], cnt = (int)__hip_atomic_load(F.ctl + CW_CNT + grp * 64 + e, RLX_AGENT), end = (int)F.MISC[16 + e] * 256;
        for (int sidx = start + cnt + F.tid; sidx < end; sidx += NTHREADS) { s2t[sidx] = 0; ssc[sidx] = 0.f; } }
}
__device__ __forceinline__ void final_pass(Frame& F, int grp, const float* fn, const bool dry = false) {
    const float* mod = F.MOD() + (size_t)1 * 9 * MOD_ROW;
    f32x4 pf[4];
#pragma unroll
    for (int j = 0; j < 4; ++j) pf[j] = *(const f32x4*)(fn + 4 * F.lane + 256 * j);
    for (int tokb = F.gw; tokb < NTOK_G; tokb += 2 * F.NGW) {
        int s0[2], s1[2]; float w0[2], w1[2];
#pragma unroll
        for (int u = 0; u < 2; ++u) { const int tok = (tokb + u * F.NGW < NTOK_G) ? tokb + u * F.NGW : tokb;
            s0[u] = F.SLOT()[tok * 2]; s1[u] = F.SLOT()[tok * 2 + 1]; w0[u] = F.TOPW()[tok * 2]; w1[u] = F.TOPW()[tok * 2 + 1]; }
        u32x2 xr[2][4], ya[2][4], yb[2][4];
#pragma unroll
        for (int u = 0; u < 2; ++u) { const int tok = (tokb + u * F.NGW < NTOK_G) ? tokb + u * F.NGW : tokb; const int bl = tok / SEQ, tl = tok - bl * SEQ;
            const bf16_t* x16 = F.X16() + ((size_t)bl * SEQ + tl) * DM + 4 * F.lane; const bf16_t* y0 = F.XG() + (size_t)s0[u] * DM + 4 * F.lane; const bf16_t* y1 = F.XG() + (size_t)s1[u] * DM + 4 * F.lane;
#pragma unroll
            for (int j = 0; j < 4; ++j) { xr[u][j] = *(const u32x2*)(x16 + 256 * j); ya[u][j] = *(const u32x2*)(y0 + 256 * j); yb[u][j] = *(const u32x2*)(y1 + 256 * j); } }
#pragma unroll
        for (int u = 0; u < 2; ++u) { const int tok = tokb + u * F.NGW; const bool okt = tok < NTOK_G; const int tk = okt ? tok : tokb;
            const int bl = tk / SEQ, tl = tk - bl * SEQ, b = grp * GB + bl;
            float* xrow = F.X + ((size_t)b * SEQ + tl) * DM; const float* gt = mod + b * MOD_ROW + 5 * DM;
            f32x4 v[4]; float s = 0.f;
#pragma unroll
            for (int j = 0; j < 4; ++j) { const int c = 4 * F.lane + 256 * j; const u32x2 xw = xr[u][j]; v[j] = (f32x4){bflo(xw.x), bfhi(xw.x), bflo(xw.y), bfhi(xw.y)}; const f32x4 g4 = *(const f32x4*)(gt + c);
                const u32x2 a = ya[u][j], bb = yb[u][j];
                v[j].x += g4.x * (w0[u] * bflo(a.x) + w1[u] * bflo(bb.x)); v[j].y += g4.y * (w0[u] * bfhi(a.x) + w1[u] * bfhi(bb.x));
                v[j].z += g4.z * (w0[u] * bflo(a.y) + w1[u] * bflo(bb.y)); v[j].w += g4.w * (w0[u] * bfhi(a.y) + w1[u] * bfhi(bb.y));
                s += (v[j].x * v[j].x + v[j].y * v[j].y) + (v[j].z * v[j].z + v[j].w * v[j].w); }
            const float rstd = rsq_f(wave_sum(s, F.lane) * (1.0f / DM) + NORM_EPS);
            if (okt && !dry) {
#pragma unroll
                for (int j = 0; j < 4; ++j) { const int c = 4 * F.lane + 256 * j; *(f32x4*)(xrow + c) = v[j] * rstd * pf[j]; } } }
    }
}

__device__ __forceinline__ void gdn_rows(int bl, int dir, int ci, int& row0, int& step) {
    int T, base, ip; if (ci < 4) { T = CTXL; base = 0; ip = ci; } else { T = SEQ; base = CTXL; ip = ci - 4; }
    row0 = bl * TT + (dir ? base + T - 1 - 64 * ip : base + 64 * ip); step = dir ? -1 : 1;
}
__device__ __forceinline__ float wave_incl_scan(float v, int lane) {
#pragma unroll
    for (int o = 1; o < 64; o <<= 1) { const float t = __builtin_bit_cast(float, __builtin_amdgcn_ds_bpermute((lane - o) << 2, __builtin_bit_cast(int, v))); if (lane >= o) v += t; }
    return v;
}
__device__ __forceinline__ void gdn_pre(Frame& F, const int bx) {
    const int team = F.wave >> 1, w2 = F.wave & 1, lane = F.lane, r32 = lane & 31, hi = lane >> 5, tt = F.tid & 127;
    LAS float* Lm = (LAS float*)(F.lds + team * 17408);
    LAS unsigned char* Kt = F.lds + 69632 + team * 16384; LAS unsigned char* Vt = Kt + 8192;
    LAS float* gcs = (LAS float*)(F.lds + LDSCTL_OFF + 1024 + F.wave * 512);
    int zv; asm volatile("v_mov_b32 %0, 0" : "=v"(zv));
    const LAS float* gcz = gcs + zv; const LAS float* Lz = Lm + zv;
    constexpr int NC = GB * 8 * 2 * NCHUNK;
    const int per_pass = F.G * 4, npass = (NC + per_pass - 1) / per_pass;
    for (int pass = 0; pass < npass; ++pass) {
        const int q = pass * per_pass + bx * 4 + team; const bool active = q < NC;
        const int qq = active ? q : 0; const int ci = qq % NCHUNK, rest = qq / NCHUNK, dir = rest & 1, h = (rest >> 1) & 7, bl = rest >> 4;
        int row0, step; gdn_rows(bl, dir, ci, row0, step);
        unsigned char* out = F.GPRE() + (size_t)qq * GPRE_CHUNK;
        { u32x4 tk[4], tv[4];
#pragma unroll
          for (int i = 0; i < 4; ++i) { const int p = tt + 128 * i, row = p >> 3, ch = p & 7; const size_t rr = (size_t)(row0 + step * row) * 512 + h * 64 + ch * 8; tk[i] = *(const u32x4*)(F.GK() + rr); tv[i] = *(const u32x4*)(F.GV() + rr); }
#pragma unroll
          for (int i = 0; i < 4; ++i) { const int p = tt + 128 * i, row = p >> 3, ch = p & 7; *(LAS u32x4*)(Kt + att::kswz<128>(row, ch * 16)) = tk[i]; *(LAS u32x4*)(Vt + row * 128 + ch * 16) = tv[i]; } }
        { const size_t rr = (size_t)(row0 + step * lane) * 16 + dir * 8 + h; const float g = F.GG()[rr], bt = F.GBT()[rr]; const float gc = wave_incl_scan(g, lane); gcs[lane] = gc; gcs[64 + lane] = bt; if (w2 == 0 && active) F.GCB()[(size_t)qq * 64 + lane] = gc; }
        __syncthreads();
        { bf16x8 Af[2][4], Bf[2][4];
#pragma unroll
          for (int bi = 0; bi < 2; ++bi)
#pragma unroll
              for (int ks = 0; ks < 4; ++ks) { Bf[bi][ks] = *(const LAS bf16x8*)(Kt + att::kswz<128>(32 * bi + r32, (16 * ks + 8 * hi) * 2));
                  if (w2) Af[bi][ks] = *(const bf16x8*)(F.GQ() + (size_t)(row0 + step * (32 * bi + r32)) * 512 + h * 64 + 8 * hi + 16 * ks); else Af[bi][ks] = Bf[bi][ks]; }
          f32x16 acc[2][2];
#pragma unroll
          for (int bi = 0; bi < 2; ++bi)
#pragma unroll
              for (int bj = 0; bj < 2; ++bj) { acc[bi][bj] = f32x16{};
#pragma unroll
                  for (int ks = 0; ks < 4; ++ks) acc[bi][bj] = __builtin_amdgcn_mfma_f32_32x32x16_bf16(Af[bi][ks], Bf[bj][ks], acc[bi][bj], 0, 0, 0); }
          const int thr = w2 ? 0 : 1; int r32p = r32, hip = hi; asm volatile("" : "+v"(r32p), "+v"(hip));
#pragma unroll
          for (int bi = 0; bi < 2; ++bi)
#pragma unroll
              for (int bj = 0; bj < 2; ++bj) { const int s = 32 * bj + r32p; const float gs = gcs[s];
#pragma unroll
                  for (int r = 0; r < 16; ++r) { const int c = 32 * bi + (r & 3) + 8 * (r >> 2) + 4 * hip; const float gcc = gcs[c];
                      const float v = acc[bi][bj][r] * __expf(fminf(gcc - gs, 0.f)); const int keep = ~((c - s - thr) >> 31);
                      acc[bi][bj][r] = __builtin_bit_cast(float, __builtin_bit_cast(int, v) & keep); } }
          if (w2 == 0) {
#pragma unroll
              for (int bi = 0; bi < 2; ++bi)
#pragma unroll
                  for (int bj = 0; bj < 2; ++bj)
#pragma unroll
                      for (int r = 0; r < 16; ++r) { const int c = 32 * bi + (r & 3) + 8 * (r >> 2) + 4 * hi; Lm[(32 * bj + r32) * 68 + c] = acc[bi][bj][r] * gcs[64 + c]; }
          } else if (active) {
              bf16_t* qo = (bf16_t*)(out + 8192) + (4 * hi) * 64 + r32;
#pragma unroll
              for (int bi = 0; bi < 2; ++bi)
#pragma unroll
                  for (int bj = 0; bj < 2; ++bj)
#pragma unroll
                      for (int r = 0; r < 16; ++r) qo[(32 * bi + (r & 3) + 8 * (r >> 2)) * 64 + 32 * bj] = (bf16_t)f2bf(acc[bi][bj][r]);
          } }
        __syncthreads();
        { float x[64];
#pragma unroll
          for (int c = 0; c < 64; ++c) x[c] = gcz[64 + c];
          if (w2) {
#pragma unroll
              for (int c = 0; c < 64; ++c) x[c] *= bf2f(*(const LAS bf16_t*)(Kt + c * 128 + ((lane * 2) ^ (((c >> 1) & 7) << 4)))) * __expf(gcz[c]);
          } else {
#pragma unroll
              for (int c = 0; c < 64; ++c) x[c] *= bf2f(*(const LAS bf16_t*)(Vt + c * 128 + lane * 2));
          }
          const unsigned lza = (unsigned)(uintptr_t)(const void*)Lm + (unsigned)zv;
#define PRE_LD(dst, off) asm volatile("ds_read_b128 %0, %1 offset:%2" : "=v"(dst) : "v"(lza), "i"(off))
#define PRE_PIN(i) asm volatile("" : "+v"(x[(i)]), "+v"(x[(i) + 1]), "+v"(x[(i) + 2]), "+v"(x[(i) + 3]))
#define PRE_W4(n, a0, a1, a2, a3) asm volatile("s_waitcnt lgkmcnt(" #n ")" : "+v"(a0), "+v"(a1), "+v"(a2), "+v"(a3))
#pragma unroll
          for (int s4 = 0; s4 < 16; ++s4) { const int s0 = 4 * s4;
              f32x4 A0, A1, A2, A3, B0, B1, B2, B3;
              { f32x4 t0, t1, t2, t3; PRE_LD(t0, ((s0 + 0) * 68 + s0) * 4); PRE_LD(t1, ((s0 + 1) * 68 + s0) * 4); PRE_LD(t2, ((s0 + 2) * 68 + s0) * 4); t3 = t2;
                if (s4 + 1 < 16) { PRE_LD(A0, ((s0 + 0) * 68 + s0 + 4) * 4); PRE_LD(A1, ((s0 + 1) * 68 + s0 + 4) * 4); PRE_LD(A2, ((s0 + 2) * 68 + s0 + 4) * 4); PRE_LD(A3, ((s0 + 3) * 68 + s0 + 4) * 4); PRE_W4(4, t0, t1, t2, t3); }
                else PRE_W4(0, t0, t1, t2, t3);
                x[s0 + 1] -= t0.y * x[s0];
                x[s0 + 2] -= t0.z * x[s0]; x[s0 + 2] -= t1.z * x[s0 + 1];
                x[s0 + 3] -= t0.w * x[s0]; x[s0 + 3] -= t1.w * x[s0 + 1]; x[s0 + 3] -= t2.w * x[s0 + 2]; PRE_PIN(s0); }
#pragma unroll
              for (int r4 = s4 + 1; r4 < 16; ++r4) { const int r0 = 4 * r4; const bool useA = ((r4 - s4) & 1) != 0, more = r4 + 1 < 16;
                  if (useA) { if (more) { PRE_LD(B0, ((s0 + 0) * 68 + r0 + 4) * 4); PRE_LD(B1, ((s0 + 1) * 68 + r0 + 4) * 4); PRE_LD(B2, ((s0 + 2) * 68 + r0 + 4) * 4); PRE_LD(B3, ((s0 + 3) * 68 + r0 + 4) * 4); PRE_W4(4, A0, A1, A2, A3); } else PRE_W4(0, A0, A1, A2, A3);
#pragma unroll
                      for (int e = 0; e < 4; ++e) { float a = x[r0 + e]; a -= A0[e] * x[s0]; a -= A1[e] * x[s0 + 1]; a -= A2[e] * x[s0 + 2]; a -= A3[e] * x[s0 + 3]; x[r0 + e] = a; } PRE_PIN(r0); }
                  else { if (more) { PRE_LD(A0, ((s0 + 0) * 68 + r0 + 4) * 4); PRE_LD(A1, ((s0 + 1) * 68 + r0 + 4) * 4); PRE_LD(A2, ((s0 + 2) * 68 + r0 + 4) * 4); PRE_LD(A3, ((s0 + 3) * 68 + r0 + 4) * 4); PRE_W4(4, B0, B1, B2, B3); } else PRE_W4(0, B0, B1, B2, B3);
#pragma unroll
                      for (int e = 0; e < 4; ++e) { float a = x[r0 + e]; a -= B0[e] * x[s0]; a -= B1[e] * x[s0 + 1]; a -= B2[e] * x[s0 + 2]; a -= B3[e] * x[s0 + 3]; x[r0 + e] = a; } PRE_PIN(r0); } } }
#undef PRE_LD
#undef PRE_W4
#undef PRE_PIN
          if (active) { bf16_t* dst = (bf16_t*)(out + (w2 ? 0 : 16384)) + lane; const float sg = w2 ? -1.f : 1.f;
#pragma unroll
              for (int c = 0; c < 64; ++c) dst[c * 64] = (bf16_t)f2bf(sg * x[c]); } }
        __syncthreads();
    }
}

constexpr int GS_WM = 0, GS_QK = 9216, GS_Q = 18432, GS_K = 27648, GS_U = 36864, GS_GC = 45056, GS_EG = 45312, GS_ED = 45568, GS_BUF = 46080, GS_OUT = 2 * 46080;
typedef short v4i16_t __attribute__((ext_vector_type(4)));
__device__ __forceinline__ bf16x8 gs_ldA(const LAS unsigned char* m, int row, int ks, int g) {
    return *(const LAS bf16x8*)(m + row * 144 + (32 * ks + 8 * g) * 2);
}
__device__ __forceinline__ bf16x8 gs_ldKT(const LAS unsigned char* km, int mt, int ks, int g, int i16) {
    const int q = i16 >> 2, p = i16 & 3;
    const LAS unsigned char* a0 = km + (32 * ks + 4 * g + q) * 144 + (16 * mt + 4 * p) * 2;
    const s16x4 lo = __builtin_bit_cast(s16x4, __builtin_amdgcn_ds_read_tr16_b64_v4i16((LAS v4i16_t*)a0));
    const s16x4 hi = __builtin_bit_cast(s16x4, __builtin_amdgcn_ds_read_tr16_b64_v4i16((LAS v4i16_t*)(a0 + 16 * 144)));
    return (bf16x8){lo[0], lo[1], lo[2], lo[3], hi[0], hi[1], hi[2], hi[3]};
}
__device__ __forceinline__ bf16x8 gs_pack(const f32x4 a, const f32x4 b) { const u32x4 w = {cvt_pk_bf16(a[0], a[1]), cvt_pk_bf16(a[2], a[3]), cvt_pk_bf16(b[0], b[1]), cvt_pk_bf16(b[2], b[3])}; return __builtin_bit_cast(bf16x8, w); }
__device__ __forceinline__ void gdn_scan(Frame& F, int chain) {
    const int dir = chain & 1, h = (chain >> 1) & 7, bl = chain >> 4;
    const int lane = F.lane, n = lane & 15, g = lane >> 4, wq = F.wave;
    if (F.wave >= 4) {
        const int lt = F.tid - 256;
        struct LSet { u32x4 t[10]; float graw; } A, B;
#define GS_ISSUE(X, ci_) do { const int ci2 = (ci_); if (ci2 < NCHUNK) { int row0, step; gdn_rows(bl, dir, ci2, row0, step); \
        const unsigned char* gp = F.GPRE() + (size_t)(chain * NCHUNK + ci2) * GPRE_CHUNK; \
        _Pragma("unroll") for (int i = 0; i < 2; ++i) { const int p = lt + 256 * i, row = p >> 3, pc = p & 7; \
            X.t[i] = *(const u32x4*)(gp + row * 128 + pc * 16); X.t[2 + i] = *(const u32x4*)(gp + 8192 + row * 128 + pc * 16); X.t[4 + i] = *(const u32x4*)(gp + 16384 + row * 128 + pc * 16); \
            const size_t rr = (size_t)(row0 + step * row) * 512 + h * 64 + pc * 8; X.t[6 + i] = *(const u32x4*)(F.GQ() + rr); X.t[8 + i] = *(const u32x4*)(F.GK() + rr); } \
        X.graw = (lt < 64) ? F.GCB()[(size_t)(chain * NCHUNK + ci2) * 64 + lt] : 0.f; } } while (0)
#define GS_PERM(base, row, pc, v) do { const int pos_ = ((pc) >> 2) * 32 + ((pc) & 1) * 16 + (((pc) & 2) ? 4 : 0); LAS unsigned char* d_ = (base) + (row) * 144 + pos_ * 2; \
        *(LAS u32x2*)d_ = (u32x2){(v).x, (v).y}; *(LAS u32x2*)(d_ + 16) = (u32x2){(v).z, (v).w}; } while (0)
#define GS_WRITE(X, ci_) do { const int ci2 = (ci_); if (ci2 < NCHUNK) { LAS unsigned char* buf = F.lds + (ci2 & 1) * GS_BUF; \
        _Pragma("unroll") for (int i = 0; i < 2; ++i) { const int p = lt + 256 * i, row = p >> 3, pc = p & 7; \
            GS_PERM(buf + GS_WM, row, pc, X.t[i]); GS_PERM(buf + GS_QK, row, pc, X.t[2 + i]); *(LAS u32x4*)(buf + GS_U + row * 128 + pc * 16) = X.t[4 + i]; \
            GS_PERM(buf + GS_Q, row, pc, X.t[6 + i]); *(LAS u32x4*)(buf + GS_K + row * 144 + pc * 16) = X.t[8 + i]; } \
        if (lt < 64) { const float gcv = X.graw; const float gl = __builtin_bit_cast(float, __builtin_amdgcn_readlane(__builtin_bit_cast(int, gcv), 63)); \
            ((LAS float*)(buf + GS_GC))[lt] = gcv; ((LAS float*)(buf + GS_EG))[lt] = __expf(gcv); ((LAS float*)(buf + GS_ED))[lt] = __expf(gl - gcv); } } } while (0)
#define GS_FLUSH(ci_) do { const int ci2 = (ci_); if (ci2 >= 0) { const LAS unsigned char* ob = F.lds + GS_OUT + (ci2 & 1) * 8192; int row0, step; gdn_rows(bl, dir, ci2, row0, step); \
        _Pragma("unroll") for (int i = 0; i < 2; ++i) { const int p = lt + 256 * i, row = p >> 3, pc = p & 7; \
            *(u32x4*)(Od + (size_t)(row0 + step * row) * 512 + h * 64 + pc * 8) = *(const LAS u32x4*)(ob + row * 128 + pc * 16); } } } while (0)
        bf16_t* Od = dir ? F.OB() : F.OF();
        GS_ISSUE(A, 0); GS_ISSUE(B, 1); GS_WRITE(A, 0); GS_ISSUE(A, 2);
        asm volatile("s_waitcnt lgkmcnt(0)" ::: "memory"); __builtin_amdgcn_s_barrier();
        for (int ci = 0; ci < NCHUNK; ci += 2) {
            GS_FLUSH(ci - 1); GS_WRITE(B, ci + 1); GS_ISSUE(B, ci + 3); asm volatile("s_waitcnt lgkmcnt(0)" ::: "memory"); __builtin_amdgcn_s_barrier();
            GS_FLUSH(ci); GS_WRITE(A, ci + 2); GS_ISSUE(A, ci + 4); asm volatile("s_waitcnt lgkmcnt(0)" ::: "memory"); __builtin_amdgcn_s_barrier();
        }
        GS_FLUSH(NCHUNK - 1);
#undef GS_ISSUE
#undef GS_WRITE
#undef GS_PERM
#undef GS_FLUSH
    } else {
        f32x4 S[4];
#pragma unroll
        for (int mt = 0; mt < 4; ++mt) S[mt] = (f32x4){0.f, 0.f, 0.f, 0.f};
        __builtin_amdgcn_s_barrier();
        for (int ci = 0; ci < NCHUNK; ++ci) {
            const LAS unsigned char* buf = F.lds + (ci & 1) * GS_BUF; const LAS float* gc = (const LAS float*)(buf + GS_GC);
            int row0, step; gdn_rows(bl, dir, ci, row0, step);
            bf16x8 aW[4][2], aQ[4][2]; f32x4 uin[4], eg[4], ed[4];
            const float gcl = gc[63];
#pragma unroll
            for (int mt = 0; mt < 4; ++mt) {
#pragma unroll
                for (int ks = 0; ks < 2; ++ks) { aW[mt][ks] = gs_ldA(buf + GS_WM, 16 * mt + n, ks, g); aQ[mt][ks] = gs_ldA(buf + GS_Q, 16 * mt + n, ks, g); }
#pragma unroll
                for (int r = 0; r < 4; ++r) uin[mt][r] = bf2f(*(const LAS bf16_t*)(buf + GS_U + (16 * mt + 4 * g + r) * 128 + (16 * wq + n) * 2));
                eg[mt] = *(const LAS f32x4*)(buf + GS_EG + (16 * mt + 4 * g) * 4); ed[mt] = *(const LAS f32x4*)(buf + GS_ED + (16 * mt + 4 * g) * 4); }
            const float cd = __expf(gcl);
            __builtin_amdgcn_sched_barrier(0);
            bf16x8 Sb[2]; Sb[0] = gs_pack(S[0], S[1]); Sb[1] = gs_pack(S[2], S[3]);
            f32x4 vn[4], o[4];
#pragma unroll
            for (int mt = 0; mt < 4; ++mt) { vn[mt] = __builtin_amdgcn_mfma_f32_16x16x32_bf16(aW[mt][0], Sb[0], uin[mt], 0, 0, 0); o[mt] = __builtin_amdgcn_mfma_f32_16x16x32_bf16(aQ[mt][0], Sb[0], (f32x4){0.f, 0.f, 0.f, 0.f}, 0, 0, 0); }
#pragma unroll
            for (int mt = 0; mt < 4; ++mt) { vn[mt] = __builtin_amdgcn_mfma_f32_16x16x32_bf16(aW[mt][1], Sb[1], vn[mt], 0, 0, 0); o[mt] = __builtin_amdgcn_mfma_f32_16x16x32_bf16(aQ[mt][1], Sb[1], o[mt], 0, 0, 0); }
            __builtin_amdgcn_sched_barrier(0);
            bf16x8 aQK[4][2], aK[4][2];
#pragma unroll
            for (int mt = 0; mt < 4; ++mt)
#pragma unroll
                for (int ks = 0; ks < 2; ++ks) { aQK[mt][ks] = gs_ldA(buf + GS_QK, 16 * mt + n, ks, g); aK[mt][ks] = gs_ldKT(buf + GS_K, mt, ks, g, n); }
            __builtin_amdgcn_sched_barrier(0);
#pragma unroll
            for (int mt = 0; mt < 4; ++mt) o[mt] = o[mt] * eg[mt];
            bf16x8 Vb[2]; Vb[0] = gs_pack(vn[0], vn[1]); Vb[1] = gs_pack(vn[2], vn[3]);
#pragma unroll
            for (int mt = 0; mt < 4; ++mt) vn[mt] = vn[mt] * ed[mt];
            bf16x8 Vd[2]; Vd[0] = gs_pack(vn[0], vn[1]); Vd[1] = gs_pack(vn[2], vn[3]);
#pragma unroll
            for (int mt = 0; mt < 4; ++mt) { o[mt] = __builtin_amdgcn_mfma_f32_16x16x32_bf16(aQK[mt][0], Vb[0], o[mt], 0, 0, 0); S[mt] = __builtin_amdgcn_mfma_f32_16x16x32_bf16(aK[mt][0], Vd[0], S[mt] * cd, 0, 0, 0); }
#pragma unroll
            for (int mt = 0; mt < 4; ++mt) { o[mt] = __builtin_amdgcn_mfma_f32_16x16x32_bf16(aQK[mt][1], Vb[1], o[mt], 0, 0, 0); S[mt] = __builtin_amdgcn_mfma_f32_16x16x32_bf16(aK[mt][1], Vd[1], S[mt], 0, 0, 0); }
#pragma unroll
            for (int mt = 0; mt < 4; ++mt)
#pragma unroll
                for (int r = 0; r < 4; ++r) { const int c = 16 * mt + 4 * g + r; *(LAS bf16_t*)(F.lds + GS_OUT + (ci & 1) * 8192 + c * 128 + (16 * wq + n) * 2) = (bf16_t)f2bf(o[mt][r]); }
            asm volatile("s_waitcnt lgkmcnt(0)" ::: "memory"); __builtin_amdgcn_s_barrier();
        }
    }
    __syncthreads();
}

__device__ __forceinline__ void attn_mla_phase(Frame& F, int vcu) {
    for (int i = 0;; ++i) {
        const int U = i * F.G + vcu; if (U >= GB * 8 * 32 + GB * 8) break;
        int bl, h, q0, seq;
        if (U < GB * 8 * 32) { const int bh = U >> 5; bl = bh >> 3; h = bh & 7; q0 = CTXL + 256 * (U & 31); seq = TT; }
        else { const int cu = U - GB * 8 * 32; bl = cu >> 3; h = cu & 7; q0 = 0; seq = CTXL; }
        const size_t rb = (size_t)bl * TT;
        att::attn_unit<96, 64>(F.QR() + (rb + q0) * 768 + h * 96, 768, F.KV() + rb * 1024 + h * 128, 1024, F.KPE() + rb * 32, F.KV() + rb * 1024 + h * 128 + 64, 1024,
                               F.HB() + (rb + q0) * DM + h * 64, DM, seq, F.ldsg, F.tid, F.TAB8(), (seq == TT) ? q0 - CTXL : -1);
    }
}
__device__ __forceinline__ void attn_l1_phase(Frame& F, int vcu, const int grp, const float* gkn) {
    float kd2[8]; float kg2;
    { const float* tb = (const float*)(F.ctl + CW_KMAX) + (size_t)grp * 256 * 8;
#pragma unroll
      for (int v = 0; v < 8; ++v) { float m = 0.f;
#pragma unroll
          for (int i = 0; i < 4; ++i) m = fmaxf(m, tb[(F.lane * 4 + i) * 8 + v]);
          m = red_max<64>(m);
          kd2[v] = (F.G == 256) ? __builtin_bit_cast(float, __builtin_amdgcn_readfirstlane(__builtin_bit_cast(int, m))) : -1.f; }
      float g = gkn[F.lane] * gkn[F.lane];
      g = red_max<64>(g);
      kg2 = 64.f * __builtin_bit_cast(float, __builtin_amdgcn_readfirstlane(__builtin_bit_cast(int, g))); }
    for (int i = 0;; ++i) {
        const int U = i * F.G + vcu; if (U >= GB * 8 * 32) break;
        const int bh = U >> 5, bl = bh >> 3, vh = bh & 7, hd = vh >> 1, q0 = CTXL + 256 * (U & 31); const size_t rb = (size_t)bl * TT;
        float kb = kd2[0];
#pragma unroll
        for (int v = 1; v < 8; ++v) kb = (vh == v) ? kd2[v] : kb;
        att::attn_unit<64, 128>(F.PB() + (rb + q0) * OD_IN + P1_DQ + vh * 64, OD_IN, F.PB() + rb * OD_IN + P1_DK + vh * 64, OD_IN, nullptr, F.PB() + rb * OD_IN + P1_DV + hd * 128, OD_IN,
                                F.KV() + (rb + q0) * DM + vh * 128, DM, TT, F.ldsg, F.tid, nullptr, -1, kb);
    }
    int tid2 = F.tid; asm volatile("" : "+v"(tid2));
    for (int i = 0;; ++i) {
        const int U = i * F.G + vcu; if (U >= GB * 8 * 32) break;
        const int bh = U >> 5, bl = bh >> 3, hq = bh & 7, kvh = hq >> 2, q0 = CTXL + 256 * (U & 31); const size_t rb = (size_t)bl * TT;
        att::attn_unit<64, 64>(F.PB() + (rb + q0) * OD_IN + P1_GQ + hq * 64, OD_IN, F.PB() + rb * OD_IN + P1_GK + kvh * 64, OD_IN, nullptr, F.PB() + rb * OD_IN + P1_GV + kvh * 64, OD_IN,
                               F.HB() + (rb + q0) * DM + 512 + hq * 64, DM, TT, F.ldsg, tid2, nullptr, -1, kg2);
    }
}

#ifndef PHMASK
#define PHMASK 0xffffffffu
#endif
#ifndef DUPMASK
#define DUPMASK 0u
#endif
#define RUNS(k) (1 + (int)((DUPMASK >> (k)) & 1u))
struct Args { const float* in[29]; float* out; unsigned char* ws; int do_pro, g_lo, g_hi, ph_lo, ph_hi, li, pad0, pad1; };
constexpr int NPH = 22;
__global__ void __launch_bounds__(NTHREADS, 2) mega_fwd(Args args) {
    extern __shared__ __attribute__((aligned(16))) unsigned char lds[];
    Frame F;
    F.lds = (LAS unsigned char*)lds; F.ldsg = (char*)lds;
    F.MISC = (volatile LAS unsigned*)(F.lds + LDSCTL_OFF);
    F.tid = threadIdx.x; F.lane = F.tid & 63; F.wave = __builtin_amdgcn_readfirstlane(F.tid >> 6); const int wave_s = F.wave;
    F.G = gridDim.x; F.gw = blockIdx.x * NWAVES + F.wave; F.NGW = F.G * NWAVES;
    unsigned char* ws = args.ws; F.ws = ws; F.ctl = (unsigned*)(F.ws + WS_CTL); F.X = args.out;
    for (int u = F.tid; u < (LDS_BYTES - LDSCTL_OFF) / 4; u += NTHREADS) ((LAS unsigned*)(F.lds + LDSCTL_OFF))[u] = 0u;
    __syncthreads();
    XcdBarrier bar = xcd_barrier_post((unsigned*)(F.ctl + CW_BAR) + args.li * XCD_BAR_WORDS, F.MISC + 8);
#define GRID_BAR() xcd_barrier(bar)
#define RETID() do { int t_ = F.tid; asm volatile("" : "+v"(t_)); F.tid = t_; } while (0)
#ifndef CTX_SPLITK
#define CTX_SPLITK 0
#endif
#ifndef WGM_N1024
#define WGM_N1024 4
#endif
#ifndef WGM_MOEGU
#define WGM_MOEGU 4
#endif
#ifndef WGM_MOED
#define WGM_MOED 4
#endif
#ifndef WGM_FFNGU
#define WGM_FFNGU 4
#endif
#ifndef WGM_WIN
#define WGM_WIN 4
#endif
#define KA(i) ((const float*)(const GAS float*)ka[i])
    typedef const float* const __attribute__((address_space(4)))* kaptr_t; kaptr_t ka;
#define REFRESH() int bx; do { int w_ = wave_s; asm volatile("" : "+s"(w_)); int l_; asm volatile("v_mbcnt_lo_u32_b32 %0, -1, 0\n\tv_mbcnt_hi_u32_b32 %0, -1, %0" : "=v"(l_)); bx = blockIdx.x; asm volatile("" : "+s"(bx)); GAS unsigned char* ws_ = (GAS unsigned char*)args.ws; asm volatile("" : "+s"(ws_)); GAS float* o_ = (GAS float*)args.out; asm volatile("" : "+s"(o_)); F.ws = (unsigned char*)ws_; F.ctl = (unsigned*)ws_; F.X = (float*)o_; ka = (kaptr_t)__builtin_amdgcn_kernarg_segment_ptr(); asm volatile("" : "+s"(ka)); F.tid = w_ * 64 + l_; F.lane = l_; F.wave = w_; F.gw = bx * NWAVES + w_; } while (0)
    LAS unsigned char* ring = F.lds;

    if (((PHMASK >> 0) & 1u) && args.do_pro) { const ProIn I{args.in[7], args.in[10], args.in[11], args.in[16], args.in[17], args.in[18], args.in[19], args.in[24], args.in[26], args.in[27], args.in[1], args.in[3], args.in[4], args.in[5]};
        for (int rep_ = 0; rep_ < RUNS(0); ++rep_) { p0_prologue(F, I); __syncthreads(); } GRID_BAR();
        if (!I8_STRIP) { p0_deferred_gu(F, args.in[26], 0, MOE_DEFER_GU, (int)blockIdx.x, F.G, args.in[7], args.in[17], args.in[19]); GRID_BAR(); } }

    for (int grp = args.g_lo; grp < args.g_hi; ++grp) {
#ifdef MK_SPLIT
        const int lo = args.ph_lo, hi = args.ph_hi;
#else
        constexpr int lo = 1, hi = NPH + 1;
#endif
#define IN(k) (((PHMASK >> (k)) & 1u) && lo <= (k) && (k) < hi)
#define SEAM(k) do { if ((k) + 1 < hi || ((k) + 1 == hi && grp + 1 < args.g_hi)) { GRID_BAR(); if (RUNS(25) == 2) GRID_BAR(); } } while (0)
        if (IN(1)) { for (int rep_ = 0; rep_ < RUNS(1); ++rep_) { REFRESH(); norm_pass<true, false, I8_WIN0 != 0>(F, grp, 0, 0, KA(6), KA(0), KA(2), nullptr); } SEAM(1); }
        if (IN(2)) { for (int rep_ = 0; rep_ < RUNS(2); ++rep_) { REFRESH(); pg8::Gemm g{F.HB(), (const bf16_t*)(F.ws + WS_WI0), RROWS, EV_INP, 1024, 1024, 1024}; pg8::StaticOrder S; S.init(RROWS, EV_INP, F.G, bx, 0, WGM_WIN);
            if (I8_WIN0) { pg8::EpiBf16I8 E{F.PB(), EV_INP, F.SATOK(), F.SWD2()}; pg8::gemm_phase<pg8::EpiBf16I8, pg8::StaticOrder, true, true, true>(ring, g, S, E, F.tid); }
            else { pg8::EpiBf16 E{F.PB(), EV_INP}; pg8::gemm_phase<pg8::EpiBf16, pg8::StaticOrder>(ring, g, S, E, F.tid); } } SEAM(2); }
        if (IN(3)) { if (RUNS(3) == 2) { REFRESH(); fix_even(F, KA(8), KA(9), KA(12), KA(13), KA(14), 1, true); __syncthreads(); } { REFRESH(); fix_even(F, KA(8), KA(9), KA(12), KA(13), KA(14), RUNS(24)); } SEAM(3); }
        if (IN(4)) { for (int rep_ = 0; rep_ < RUNS(23); ++rep_) { REFRESH(); gdn_pre(F, bx); } SEAM(4); }
        if (IN(5)) { REFRESH();
            if (bx < GB * 16) { gdn_scan(F, bx); if (RUNS(26) == 2) { RETID(); F.lane = F.tid & 63; gdn_scan(F, (bx + 32) & 63); } }
            else { const int G2 = F.G - GB * 16, c2 = bx - GB * 16;
              { pg8::Gemm g{F.PB() + PC_CQ, (const bf16_t*)(F.ws + WS_WUQ), RROWS, 768, 384, EV_INP, 384}; pg8::StaticOrder S; S.init(RROWS, 768, G2, c2);
                pg8::EpiBf16 E{F.QR(), 768}; pg8::gemm_phase<pg8::EpiBf16, pg8::StaticOrder>(ring, g, S, E, F.tid); } RETID();
              { pg8::Gemm g{F.PB() + PC_CKV, (const bf16_t*)(F.ws + WS_WUKV), RROWS, 1024, 256, EV_INP, 256}; pg8::StaticOrder S; S.init(RROWS, 1024, G2, c2);
                pg8::EpiBf16 E{F.KV(), 1024}; pg8::gemm_phase<pg8::EpiBf16, pg8::StaticOrder>(ring, g, S, E, F.tid); }
              if (grp == 0 && args.do_pro) { RETID(); F.lane = F.tid & 63; p0_deferred(F, KA(26), KA(27), c2, G2); if (F.G != 256) p0_deferred_gu(F, KA(26), 3, 8, c2, G2); } }
            SEAM(5); }
        if (IN(6)) { for (int rep_ = 0; rep_ < RUNS(6); ++rep_) { REFRESH();
            attn_mla_phase(F, (F.G % 8 == 0) ? (bx % 8) * (F.G / 8) + bx / 8 : bx);
            } SEAM(6); }
        if (IN(7)) { for (int rep_ = 0; rep_ < RUNS(7); ++rep_) { REFRESH(); gdn_out(F, KA(15)); } SEAM(7); }
        if (IN(8)) { for (int rep_ = 0; rep_ < RUNS(8); ++rep_) { REFRESH(); if (CTX_SPLITK) { pg8::Gemm gc{F.HB(), (const bf16_t*)(F.ws + WS_WO0), RROWS, 1024, 256, 1024, 1024}; pg8::CtxSplitOrder SC; SC.init(4, F.G, bx);
              pg8::EpiCtxPartial EC{F.PART()}; pg8::gemm_phase<pg8::EpiCtxPartial, pg8::CtxSplitOrder>(ring, gc, SC, EC, F.tid); } RETID();
            pg8::Gemm g{F.HB(), (const bf16_t*)(F.ws + WS_WO0), RROWS, 1024, 1024, 1024, 1024}; pg8::StaticOrder S; if (CTX_SPLITK) S.init(GB * 32 * 256, 1024, F.G, bx, 1); else S.init(RROWS, 1024, F.G, bx, 0, WGM_N1024);
            pg8::EpiResid E{F.X16(), F.CX(), rep_ ? (const float*)(F.ws + 512 * 1024) : F.MOD(), 2, grp, 0}; pg8::gemm_phase<pg8::EpiResid, pg8::StaticOrder>(ring, g, S, E, F.tid);
            if (grp == 0 && args.do_pro && rep_ == 0 && bx >= 16 && F.G == 256) { RETID(); F.lane = F.tid & 63; p0_deferred_gu(F, KA(26), 3, 4, bx - 16, F.G - 16); } } SEAM(8); }
        if (IN(9)) { for (int rep_ = 0; rep_ < RUNS(9); ++rep_) { REFRESH(); norm_pass<false, false, I8_GU0 != 0>(F, grp, 0, 1, KA(6), nullptr, nullptr, nullptr, CTX_SPLITK ? F.PART() : nullptr, 4, 2, F.MOD()); } SEAM(9); }
        if (IN(10)) { for (int rep_ = 0; rep_ < RUNS(10); ++rep_) { REFRESH(); pg8::Gemm g{F.HB(), (const bf16_t*)(F.ws + WS_WGU0), RROWS, 2 * FFN, 1024, 1024, 1024}; pg8::StaticOrder S; S.init(RROWS, 2 * FFN, F.G, bx, 0, WGM_FFNGU);
            if (I8_GU0) { pg8::EpiSwiGLUI8 E{F.PB(), FFN, F.SATOK(), F.SWD2() + EV_INP}; pg8::gemm_phase<pg8::EpiSwiGLUI8, pg8::StaticOrder, true, true, true>(ring, g, S, E, F.tid); }
            else { pg8::EpiSwiGLU E{F.PB(), FFN}; pg8::gemm_phase<pg8::EpiSwiGLU, pg8::StaticOrder>(ring, g, S, E, F.tid); } } SEAM(10); }
        if (IN(11)) { for (int rep_ = 0; rep_ < RUNS(11); ++rep_) { REFRESH(); if (CTX_SPLITK) { pg8::Gemm gc{F.PB(), (const bf16_t*)(F.ws + WS_WD0), RROWS, 1024, 256, FFN, FFN}; pg8::CtxSplitOrder SC; SC.init(FFN / 256, F.G, bx);
              pg8::EpiCtxPartial EC{F.PART()}; pg8::gemm_phase<pg8::EpiCtxPartial, pg8::CtxSplitOrder>(ring, gc, SC, EC, F.tid); } RETID();
            pg8::Gemm g{F.PB(), (const bf16_t*)(F.ws + WS_WD0), RROWS, 1024, FFN, FFN, FFN}; pg8::StaticOrder S; if (CTX_SPLITK) S.init(GB * 32 * 256, 1024, F.G, bx, 1); else S.init(RROWS, 1024, F.G, bx, 0, WGM_N1024);
            pg8::EpiResid E{F.X16(), F.CX(), rep_ ? (const float*)(F.ws + 512 * 1024) : F.MOD(), 5, grp, 0}; pg8::gemm_phase<pg8::EpiResid, pg8::StaticOrder>(ring, g, S, E, F.tid);
            if (grp == 0 && args.do_pro && rep_ == 0 && bx >= 16 && F.G == 256) { RETID(); F.lane = F.tid & 63; p0_deferred_gu(F, KA(26), 4, 8, bx - 16, F.G - 16); } } SEAM(11); }
        if (IN(12)) { for (int rep_ = 0; rep_ < RUNS(12); ++rep_) { REFRESH(); norm_pass<false, false, I8_WIN1 != 0>(F, grp, 1, 0, KA(6), nullptr, nullptr, nullptr, CTX_SPLITK ? F.PART() : nullptr, FFN / 256, 5, F.MOD()); } SEAM(12); }
        if (IN(13)) { for (int rep_ = 0; rep_ < RUNS(13); ++rep_) { REFRESH(); pg8::Gemm g{F.HB(), (const bf16_t*)(F.ws + WS_WI1), RROWS, OD_IN, 1024, 1024, 1024}; pg8::StaticOrder S; S.init(RROWS, OD_IN, F.G, bx, 0, WGM_WIN);
            if (I8_WIN1) { pg8::EpiBf16I8 E{F.PB(), OD_IN, F.SATOK(), F.SWD2() + EV_INP + 2 * FFN}; pg8::gemm_phase<pg8::EpiBf16I8, pg8::StaticOrder, true, true, true>(ring, g, S, E, F.tid); }
            else { pg8::EpiBf16 E{F.PB(), OD_IN}; pg8::gemm_phase<pg8::EpiBf16, pg8::StaticOrder>(ring, g, S, E, F.tid); } } SEAM(13); }
        if (IN(14)) { if (RUNS(14) == 2) { REFRESH(); fix_odd(F, KA(22), KA(23), grp, true); } { REFRESH(); fix_odd(F, KA(22), KA(23), grp); } SEAM(14); }
        if (IN(15)) { for (int rep_ = 0; rep_ < RUNS(15); ++rep_) { REFRESH(); attn_l1_phase(F, (F.G % 8 == 0) ? (bx % 8) * (F.G / 8) + bx / 8 : bx, grp, KA(23)); } SEAM(15); }
        if (IN(16)) { for (int rep_ = 0; rep_ < RUNS(16); ++rep_) { REFRESH(); diff_post(F, KA(20), KA(21)); } SEAM(16); }
        if (IN(17)) { for (int rep_ = 0; rep_ < RUNS(17); ++rep_) { REFRESH(); pg8::Gemm g{F.HB(), (const bf16_t*)(F.ws + WS_WO1), RROWS, 1024, 1024, 1024, 1024}; pg8::StaticOrder S; S.init(GB * 32 * 256, 1024, F.G, bx, 1, WGM_N1024);
            pg8::EpiResid E{F.X16(), F.CX(), rep_ ? (const float*)(F.ws + 512 * 1024) : F.MOD() + 9 * MOD_ROW, 2, grp, 1}; pg8::gemm_phase<pg8::EpiResid, pg8::StaticOrder>(ring, g, S, E, F.tid); } SEAM(17); }
        if (IN(18)) { if (RUNS(18) == 2) { REFRESH(); norm_pass<false, true>(F, grp, 1, 1, KA(6), nullptr, nullptr, KA(25), nullptr, 0, 0, nullptr, true); __syncthreads(); } { REFRESH(); norm_pass<false, true>(F, grp, 1, 1, KA(6), nullptr, nullptr, KA(25)); } SEAM(18); }
        if (IN(19)) { REFRESH(); moe_tends(F, grp); if (RUNS(19) == 2) { moe_gather(F, grp, true); GRID_BAR(); } moe_gather(F, grp); SEAM(19); }
        if (IN(20)) { for (int rep_ = 0; rep_ < RUNS(20); ++rep_) { REFRESH(); moe_tends(F, grp); const int ntile = (int)F.MISC[23];
            pg8::Gemm g{F.HB(), (const bf16_t*)(F.ws + WS_WGU1), ntile * 256, 2 * EXD, 1024, 1024, 1024, (const int*)((const signed char*)F.XG() + (size_t)MOE_ROWS * DM + (size_t)MOE_ROWS * 4)}; pg8::StaticOrder S; S.init(ntile * 256, 2 * EXD, F.G, bx, 0, WGM_MOEGU);
            S.tend = (const int*)(lds + LDSCTL_OFF + 16 * 4); S.estride = (size_t)2 * EXD * 1024;
            pg8::EpiSwiGLUI8 E{F.ACT1(), EXD, (const float*)((const signed char*)F.XG() + (size_t)MOE_ROWS * DM), F.SWD()}; pg8::gemm_phase<pg8::EpiSwiGLUI8, pg8::StaticOrder, true, true, true, true>(ring, g, S, E, F.tid); } SEAM(20); }
        if (IN(21)) { for (int rep_ = 0; rep_ < RUNS(21); ++rep_) { REFRESH(); moe_tends(F, grp); const int ntile = (int)F.MISC[23];
            pg8::Gemm g{F.ACT1(), (const bf16_t*)(F.ws + WS_WD1), ntile * 256, 1024, EXD, EXD, EXD}; pg8::StaticOrder S; S.init(ntile * 256, 1024, F.G, bx, 0, WGM_MOED);
            S.tend = (const int*)(lds + LDSCTL_OFF + 16 * 4); S.estride = (size_t)1024 * EXD * 2;
            pg8::EpiBf16 E{F.XG(), 1024}; pg8::gemm_phase<pg8::EpiBf16, pg8::StaticOrder>(ring, g, S, E, F.tid); } SEAM(21); }
        if (IN(22)) { if (RUNS(22) == 2) { REFRESH(); final_pass(F, grp, KA(28), true); } { REFRESH(); final_pass(F, grp, KA(28)); } SEAM(22); }
#undef IN
#undef SEAM
    }
}

extern "C" void kernel_launch(void* const* d_in, const int* in_sizes, int n_in, void* d_out, int out_size, void* d_ws, size_t ws_size, hipStream_t stream) {
    static int grid = 0;
    if (grid == 0) {
        if (n_in != 29 || out_size != NBATCH * SEQ * DM || ws_size < WS_END) { fprintf(stderr, "kernel_launch: unexpected shapes: n_in %d out %d ws %zu (need %zu)\n", n_in, out_size, ws_size, (size_t)WS_END); grid = -1; return; }
        int dev = 0, cus = 0, per_cu = 0;
        if (hipGetDevice(&dev) != hipSuccess || hipDeviceGetAttribute(&cus, hipDeviceAttributeMultiprocessorCount, dev) != hipSuccess) { grid = -1; return; }
        if (hipFuncSetAttribute((const void*)mega_fwd, hipFuncAttributeMaxDynamicSharedMemorySize, LDS_BYTES) != hipSuccess) { fprintf(stderr, "kernel_launch: hipFuncSetAttribute failed\n"); grid = -1; return; }
        if (hipOccupancyMaxActiveBlocksPerMultiprocessor(&per_cu, (const void*)mega_fwd, NTHREADS, LDS_BYTES) != hipSuccess || per_cu < 1) { fprintf(stderr, "kernel_launch: occupancy query says %d\n", per_cu); }
        (void)hipGetLastError();
        grid = cus;
    }
    if (grid < 0) return;
    (void)hipMemsetAsync((char*)d_ws + WS_CTL, 0, CTL_BYTES, stream);
    Args a{};
    for (int i = 0; i < 29; ++i) a.in[i] = (const float*)d_in[i];
    a.out = (float*)d_out; a.ws = (unsigned char*)d_ws;
#ifndef MK_SPLIT
    a.do_pro = 1; a.g_lo = 0; a.g_hi = NGRP; a.ph_lo = 1; a.ph_hi = NPH + 1; a.li = 0;
    hipLaunchKernelGGL(mega_fwd, dim3(grid), dim3(NTHREADS), LDS_BYTES, stream, a);
#else
    a.li = 0;
    a.do_pro = 1; a.g_lo = 0; a.g_hi = 0; a.ph_lo = 1; a.ph_hi = 1;
    hipLaunchKernelGGL(mega_fwd, dim3(grid), dim3(NTHREADS), LDS_BYTES, stream, a);
    for (int g = 0; g < NGRP; ++g) for (int ph = 1; ph <= NPH; ++ph) { a.do_pro = 0; a.g_lo = g; a.g_hi = g + 1; a.ph_lo = ph; a.ph_hi = ph + 1;
        hipLaunchKernelGGL(mega_fwd, dim3(grid), dim3(NTHREADS), LDS_BYTES, stream, a); }
#endif
}
```

```cpp
#include <hip/hip_runtime.h>
#include <cstdio>
#include <cstdint>

#define LAS __attribute__((address_space(3)))
#define GAS __attribute__((address_space(1)))
typedef unsigned short bf16_t;
typedef short bf16x8 __attribute__((ext_vector_type(8)));
typedef short s16x4 __attribute__((ext_vector_type(4)));
typedef float f32x4 __attribute__((ext_vector_type(4)));
typedef float f32x2 __attribute__((ext_vector_type(2)));
typedef float f32x16 __attribute__((ext_vector_type(16)));
typedef unsigned u32x4 __attribute__((ext_vector_type(4)));
typedef unsigned u32x2 __attribute__((ext_vector_type(2)));
typedef int i32x4 __attribute__((ext_vector_type(4)));

#ifndef I8_STRIP
#define I8_STRIP 1
#endif
#ifndef I8_WIN0
#define I8_WIN0 1
#endif
#ifndef I8_GU0
#define I8_GU0 1
#endif
#ifndef I8_WIN1
#define I8_WIN1 1
#endif
constexpr int DM = 1024, NBATCH = 8, SEQ = 8192, CTXL = 256, TT = SEQ + CTXL;
constexpr int GB = 4, NGRP = NBATCH / GB, RROWS = GB * TT, RTILES = RROWS / 256;
constexpr int EV_IN = 2752, EV_INP = 2816, OD_IN = 2304, FFN = 2816, EXD = 3584, NEXP = 8;
constexpr int MOD_ROW = 6 * DM;
constexpr int NTOK_G = GB * SEQ;
constexpr int MOE_ROWS = 2 * NTOK_G + NEXP * 256;
constexpr float NORM_EPS = 1e-6f;
constexpr float ATT_C64 = 0.125f * 1.4426950408889634f, ATT_C96 = 0.10206207261596575f * 1.4426950408889634f;
constexpr int PC_CQ = 0, PC_CKV = 384, PC_KPE = 640, PC_GQKV = 672, PC_Z = 2208, PC_A = 2720, PC_B = 2736;
constexpr int P1_DQ = 0, P1_DK = 512, P1_DV = 1024, P1_GQ = 1536, P1_GK = 2048, P1_GV = 2176;
constexpr int NCHUNK = TT / 64;
constexpr int GPRE_CHUNK = 3 * 8192;

constexpr size_t MiB = 1u << 20;
constexpr size_t WS_CTL = 0, CTL_BYTES = 1 * MiB;
constexpr size_t WS_MOD = 1 * MiB;
constexpr size_t WS_TAB8 = WS_MOD + 448 * 1024;
constexpr size_t WS_TAB16 = WS_TAB8 + 8 * 1024;
constexpr size_t WS_TOPE = WS_TAB16 + 16 * 1024;
constexpr size_t WS_TOPW = WS_TOPE + 256 * 1024;
constexpr size_t WS_SLOT = WS_TOPW + 256 * 1024;
constexpr size_t WS_SWD = 2 * MiB + 256 * 1024;
constexpr size_t WS_SATOK = 2 * MiB + 512 * 1024;
constexpr size_t WS_SWD2 = 2 * MiB + 704 * 1024;
static_assert(WS_SLOT + 256 * 1024 <= WS_SWD && WS_SWD + 8 * 7168 * 4 <= WS_SATOK && WS_SATOK + RROWS * 4 <= WS_SWD2 && WS_SWD2 + (2816 + 5632 + 2304) * 4 <= 3 * MiB, "small region");
constexpr size_t WS_CX = 3 * MiB;
constexpr size_t WS_W = 11 * MiB;
constexpr size_t WS_WI0 = WS_W;
constexpr size_t WS_WUQ = WS_WI0 + (size_t)EV_INP * 1024 * 2;
constexpr size_t WS_WUKV = WS_WUQ + (size_t)768 * 384 * 2;
constexpr size_t WS_WO0 = WS_WUKV + (size_t)1024 * 256 * 2;
constexpr size_t WS_WGU0 = WS_WO0 + (size_t)1024 * 1024 * 2;
constexpr size_t WS_WD0 = WS_WGU0 + (size_t)2 * FFN * 1024 * 2;
constexpr size_t WS_WI1 = WS_WD0 + (size_t)1024 * FFN * 2;
constexpr size_t WS_WO1 = WS_WI1 + (size_t)OD_IN * 1024 * 2;
constexpr size_t WS_WGU1 = WS_WO1 + (size_t)1024 * 1024 * 2;
constexpr size_t WS_WD1 = WS_WGU1 + (size_t)NEXP * 2 * EXD * 1024 * 2;
constexpr size_t WS_WEND = WS_WD1 + (size_t)NEXP * 1024 * EXD * 2;
static_assert(WS_WEND <= 211 * MiB, "weights region");
constexpr size_t WS_HB = 211 * MiB;
constexpr size_t WS_PB = 277 * MiB;
constexpr size_t WS_QR = 459 * MiB;
constexpr size_t WS_KV = 509 * MiB;
constexpr size_t WS_KPE = 575 * MiB;
constexpr size_t WS_GQ = 578 * MiB, WS_GK = 611 * MiB, WS_GV = 644 * MiB;
constexpr size_t WS_GG = 677 * MiB, WS_GBT = 680 * MiB;
constexpr size_t WS_OF = 683 * MiB, WS_OB = 716 * MiB;
constexpr size_t WS_GPRE = 749 * MiB;
constexpr size_t WS_ACT1 = 277 * MiB;
constexpr size_t WS_PART = 749 * MiB;
constexpr size_t WS_XG = 749 * MiB;
constexpr size_t WS_X16 = 947 * MiB;
constexpr size_t WS_GCB = 1011 * MiB;
constexpr size_t WS_END = 1014 * MiB;
static_assert(WS_ACT1 + (size_t)MOE_ROWS * EXD * 2 <= WS_XG && WS_XG + (size_t)MOE_ROWS * 1024 * 2 <= WS_END, "moe map");
static_assert(WS_GPRE + (size_t)GB * 8 * 2 * NCHUNK * GPRE_CHUNK <= WS_END, "gpre map");
constexpr int CW_BAR = 4096;
constexpr int CW_KMAX = 40960;
constexpr int CW_SWMAX = 65536;
constexpr int CW_SWMAX2 = 122880;
constexpr int CW_WGB = 32768;
constexpr int CW_CNT = 16384;

constexpr int RING_BYTES = 131072;
constexpr int LDSCTL_OFF = 147456;
constexpr int LDS_BYTES = 163840;
constexpr int NWAVES = 8, NTHREADS = 512;

#define RLX_AGENT __ATOMIC_RELAXED, __HIP_MEMORY_SCOPE_AGENT
__device__ __forceinline__ unsigned f2bf(float f) { unsigned u = __builtin_bit_cast(unsigned, f); return (u + 0x7fffu + ((u >> 16) & 1u)) >> 16; }
__device__ __forceinline__ unsigned pk2(float lo, float hi) { return f2bf(lo) | (f2bf(hi) << 16); }
__device__ __forceinline__ float bflo(unsigned w) { return __builtin_bit_cast(float, w << 16); }
__device__ __forceinline__ float bfhi(unsigned w) { return __builtin_bit_cast(float, w & 0xffff0000u); }
__device__ __forceinline__ float bf2f(bf16_t v) { return __builtin_bit_cast(float, (unsigned)v << 16); }
typedef __bf16 bf16x2_t __attribute__((ext_vector_type(2)));
__device__ __forceinline__ unsigned cvt_pk_bf16(float lo, float hi) { const f32x2 v = {lo, hi}; return __builtin_bit_cast(unsigned, __builtin_convertvector(v, bf16x2_t)); }
__device__ __forceinline__ float sx(float v, int mask, int lane) { return __builtin_bit_cast(float, __builtin_amdgcn_ds_bpermute((lane ^ mask) << 2, __builtin_bit_cast(int, v))); }
template <int CTRL> __device__ __forceinline__ float dppf(float v) { return __builtin_bit_cast(float, __builtin_amdgcn_update_dpp(0, __builtin_bit_cast(int, v), CTRL, 0xf, 0xf, true)); }
template <int N> __device__ __forceinline__ float red_sum(float v) {
    if constexpr (N >= 2) v += dppf<0xB1>(v);
    if constexpr (N >= 4) v += dppf<0x4E>(v);
    if constexpr (N >= 8) v += dppf<0x141>(v);
    if constexpr (N >= 16) v += dppf<0x140>(v);
    if constexpr (N >= 32) { auto rr = __builtin_amdgcn_permlane16_swap(__float_as_uint(v), __float_as_uint(v), false, false); v = __uint_as_float(rr[0]) + __uint_as_float(rr[1]); }
    if constexpr (N >= 64) { auto rr = __builtin_amdgcn_permlane32_swap(__float_as_uint(v), __float_as_uint(v), false, false); v = __uint_as_float(rr[0]) + __uint_as_float(rr[1]); }
    return v;
}
template <int N> __device__ __forceinline__ float red_max(float v) {
    if constexpr (N >= 2) v = fmaxf(v, dppf<0xB1>(v));
    if constexpr (N >= 4) v = fmaxf(v, dppf<0x4E>(v));
    if constexpr (N >= 8) v = fmaxf(v, dppf<0x141>(v));
    if constexpr (N >= 16) v = fmaxf(v, dppf<0x140>(v));
    if constexpr (N >= 32) { auto rr = __builtin_amdgcn_permlane16_swap(__float_as_uint(v), __float_as_uint(v), false, false); v = fmaxf(__uint_as_float(rr[0]), __uint_as_float(rr[1])); }
    if constexpr (N >= 64) { auto rr = __builtin_amdgcn_permlane32_swap(__float_as_uint(v), __float_as_uint(v), false, false); v = fmaxf(__uint_as_float(rr[0]), __uint_as_float(rr[1])); }
    return v;
}
__device__ __forceinline__ float wave_sum(float v, int lane) { (void)lane; return red_sum<64>(v); }
__device__ __forceinline__ float silu_f(float x) { return x * __builtin_amdgcn_rcpf(1.f + __expf(-x)); }
__device__ __forceinline__ float rsq_f(float x) { return __builtin_amdgcn_rsqf(x); }

namespace pg8 {
constexpr int BM = 256, BK = 64, HALF = 128, HTB = HALF * BK * 2, STAGE_BYTES = 8 * HTB, NXCD = 8, WGM = 4;
__host__ __device__ __forceinline__ int lds_byte(int r, int c) { const int st = (r >> 4) * 2 + (c >> 5), rr = r & 15, cc = c & 31, ob = rr * 64 + cc * 2; return st * 1024 + (ob ^ (((ob >> 9) & 1) << 5)); }
__host__ __device__ __forceinline__ void stage_rc(int b, int& R, int& C) { const int st = b / 1024, sb = b % 1024, swz = sb ^ (((sb >> 9) & 1) << 5); R = (st >> 1) * 16 + swz / 64; C = (st & 1) * 32 + (swz % 64) / 2; }
__host__ __device__ __forceinline__ int perm32(int rho) { const int n = rho >> 4, i = rho & 15; return 8 * (i >> 2) + 4 * n + (i & 3); }

struct Unit { int pm, pn; size_t boff, aoff; };
struct Gemm { const bf16_t* A; const bf16_t* Bt; int M, N, K, lda, ldb; const int* rowtab; };

struct StaticOrder {
    int nM, nN, nwg, G, c, lat, wgm; const int* tend; size_t estride;
    __device__ void init(int M, int N, int G_, int c_, int lat_ = 0, int wgm_ = WGM) { nM = M / BM; nN = N / BM; nwg = nM * nN; G = G_; c = c_; tend = nullptr; estride = 0; lat = lat_; wgm = wgm_; }
    __device__ bool next(int i, Unit& u) const {
        const long L = (long)i * G + c; if (L >= nwg) return false;
        int wgid = (int)L; { const int q = nwg / NXCD, r = nwg % NXCD, xcd = wgid % NXCD, off = wgid / NXCD; wgid = (xcd < r ? xcd * (q + 1) : r * (q + 1) + (xcd - r) * q) + off; }
        const int nig = wgm * nN, gid = wgid / nig, fm = gid * wgm, gsz = (nM - fm) < wgm ? (nM - fm) : wgm;
        u.pm = fm + ((wgid % nig) % gsz); u.pn = (wgid % nig) / gsz; u.boff = 0; u.aoff = 0;
        if (lat) u.pm = u.pm + (u.pm >> 5) + 1;
        if (tend) { int e = 0;
#pragma unroll
            for (int j = 0; j < 7; ++j) e += (u.pm >= tend[j]) ? 1 : 0;
            u.boff = (size_t)e * estride; }
        return true;
    }
};

struct CtxSplitOrder {
    int S, G, c;
    __device__ void init(int S_, int G_, int c_) { S = S_; G = G_; c = c_; }
    __device__ bool next(int i, Unit& u) const {
        const int L = i * G + c; if (L >= GB * 4 * S) return false;
        const int sl = L % S, r = L / S; u.pn = r & 3; u.pm = (r >> 2) * 33; u.boff = (size_t)sl * 512; u.aoff = (size_t)sl * 512; return true;
    }
};
struct EpiBf16 {
    static constexpr bool PERM = true;
    bf16_t* O; int ldc;
    __device__ __forceinline__ void operator()(const f32x4 (&acc)[2][2][4][2], const Unit& u, int wr, int wc, int fr_, int fq) const {
        const int fr = fr_;
        const int row0 = u.pm * BM + wr * 64 + fr, col0 = u.pn * BM + wc * 32 + 8 * fq;
#pragma unroll
        for (int ai = 0; ai < 2; ++ai)
#pragma unroll
            for (int m = 0; m < 4; ++m) { bf16_t* rowp = O + (size_t)(row0 + ai * HALF + m * 16) * ldc + col0;
#pragma unroll
                for (int bj = 0; bj < 2; ++bj) { const f32x4 v0 = acc[ai][bj][m][0], v1 = acc[ai][bj][m][1];
                    u32x4 w; w.x = cvt_pk_bf16(v0[0], v0[1]); w.y = cvt_pk_bf16(v0[2], v0[3]); w.z = cvt_pk_bf16(v1[0], v1[1]); w.w = cvt_pk_bf16(v1[2], v1[3]);
                    *(u32x4*)(rowp + bj * HALF) = w; } }
    }
};
struct EpiBf16I8 {
    static constexpr bool PERM = true;
    bf16_t* O; int ldc; const float* sa; const float* swd;
    __device__ __forceinline__ void operator()(const i32x4 (&acc)[2][2][4][2], const Unit& u, int wr, int wc, int fr_, int fq) const {
        const int fr = fr_;
        const int row0 = u.pm * BM + wr * 64 + fr, col0 = u.pn * BM + wc * 32 + 8 * fq;
        f32x4 sw[2][2];
#pragma unroll
        for (int bj = 0; bj < 2; ++bj) { sw[bj][0] = *(const f32x4*)(swd + col0 + bj * HALF); sw[bj][1] = *(const f32x4*)(swd + col0 + bj * HALF + 4); }
        float srv[2][4];
#pragma unroll
        for (int ai = 0; ai < 2; ++ai)
#pragma unroll
            for (int m = 0; m < 4; ++m) srv[ai][m] = sa[row0 + ai * HALF + m * 16];
#pragma unroll
        for (int ai = 0; ai < 2; ++ai)
#pragma unroll
            for (int m = 0; m < 4; ++m) { const int row = row0 + ai * HALF + m * 16; bf16_t* rowp = O + (size_t)row * ldc + col0; const float sr = srv[ai][m];
#pragma unroll
                for (int bj = 0; bj < 2; ++bj) { const i32x4 a0 = acc[ai][bj][m][0], a1 = acc[ai][bj][m][1]; const f32x4 s0 = sw[bj][0] * sr, s1 = sw[bj][1] * sr;
                    u32x4 w; w.x = cvt_pk_bf16((float)a0[0] * s0[0], (float)a0[1] * s0[1]); w.y = cvt_pk_bf16((float)a0[2] * s0[2], (float)a0[3] * s0[3]);
                    w.z = cvt_pk_bf16((float)a1[0] * s1[0], (float)a1[1] * s1[1]); w.w = cvt_pk_bf16((float)a1[2] * s1[2], (float)a1[3] * s1[3]);
                    *(u32x4*)(rowp + bj * HALF) = w; } }
    }
};
struct EpiSwiGLU {
    static constexpr bool PERM = true;
    bf16_t* O; int ldc;
    __device__ __forceinline__ void operator()(const f32x4 (&acc)[2][2][4][2], const Unit& u, int wr, int wc, int fr_, int fq) const {
        const int fr = fr_;
        const int row0 = u.pm * BM + wr * 64 + fr, col0 = u.pn * HALF + wc * 32 + 8 * fq;
#pragma unroll
        for (int ai = 0; ai < 2; ++ai)
#pragma unroll
            for (int m = 0; m < 4; ++m) { bf16_t* rowp = O + (size_t)(row0 + ai * HALF + m * 16) * ldc + col0;
                float h[8];
#pragma unroll
                for (int n = 0; n < 2; ++n)
#pragma unroll
                    for (int e = 0; e < 4; ++e) { const float g = acc[ai][0][m][n][e], up = acc[ai][1][m][n][e]; h[n * 4 + e] = g * __builtin_amdgcn_rcpf(1.f + __builtin_amdgcn_exp2f(-1.4426950408889634f * g)) * up; }
                u32x4 w; w.x = cvt_pk_bf16(h[0], h[1]); w.y = cvt_pk_bf16(h[2], h[3]); w.z = cvt_pk_bf16(h[4], h[5]); w.w = cvt_pk_bf16(h[6], h[7]);
                *(u32x4*)rowp = w; }
    }
};
struct EpiSwiGLUI8 {
    static constexpr bool PERM = true;
    bf16_t* O; int ldc; const float* sa; const float* swd;
    __device__ __forceinline__ void operator()(const i32x4 (&acc)[2][2][4][2], const Unit& u, int wr, int wc, int fr_, int fq) const {
        const int fr = fr_;
        const int row0 = u.pm * BM + wr * 64 + fr, col0 = u.pn * HALF + wc * 32 + 8 * fq;
        const float* sw = swd + (u.boff / ((size_t)2 * EXD * 1024)) * (size_t)(2 * EXD) + u.pn * BM + wc * 32 + 8 * fq;
        const f32x4 sg0 = *(const f32x4*)sw, sg1 = *(const f32x4*)(sw + 4), su0 = *(const f32x4*)(sw + HALF), su1 = *(const f32x4*)(sw + HALF + 4);
        const float sgv[8] = {sg0.x, sg0.y, sg0.z, sg0.w, sg1.x, sg1.y, sg1.z, sg1.w}, suv[8] = {su0.x, su0.y, su0.z, su0.w, su1.x, su1.y, su1.z, su1.w};
        float srv[2][4];
#pragma unroll
        for (int ai = 0; ai < 2; ++ai)
#pragma unroll
            for (int m = 0; m < 4; ++m) srv[ai][m] = sa[row0 + ai * HALF + m * 16];
#pragma unroll
        for (int ai = 0; ai < 2; ++ai)
#pragma unroll
            for (int m = 0; m < 4; ++m) { const int row = row0 + ai * HALF + m * 16; bf16_t* rowp = O + (size_t)row * ldc + col0; const float sr = srv[ai][m];
                float h[8];
#pragma unroll
                for (int n = 0; n < 2; ++n)
#pragma unroll
                    for (int e = 0; e < 4; ++e) { const float g = (float)acc[ai][0][m][n][e] * (sr * sgv[n * 4 + e]), up = (float)acc[ai][1][m][n][e] * (sr * suv[n * 4 + e]);
                        h[n * 4 + e] = g * __builtin_amdgcn_rcpf(1.f + __builtin_amdgcn_exp2f(-1.4426950408889634f * g)) * up; }
                u32x4 w; w.x = cvt_pk_bf16(h[0], h[1]); w.y = cvt_pk_bf16(h[2], h[3]); w.z = cvt_pk_bf16(h[4], h[5]); w.w = cvt_pk_bf16(h[6], h[7]);
                *(u32x4*)rowp = w; }
    }
};
struct EpiResid {
    static constexpr bool PERM = true;
    bf16_t* X16; float* CX; const float* mod; int gidx; int grp; int skip_ctx;
    __device__ __forceinline__ void operator()(const f32x4 (&acc)[2][2][4][2], const Unit& u, int wr, int wc, int fr_, int fq) const {
        const int fr = fr_;
        const int bl = u.pm / 33, tt = u.pm % 33, b = grp * GB + bl;
        const int col0 = u.pn * BM + wc * 32 + 8 * fq;
        if (tt == 0) { if (skip_ctx) return;
            float* base = CX + (size_t)b * CTXL * DM; const float* gate = mod + 8 * MOD_ROW + gidx * DM;
#pragma unroll
            for (int bj = 0; bj < 2; ++bj) { const f32x4 g0 = *(const f32x4*)(gate + col0 + bj * HALF), g1 = *(const f32x4*)(gate + col0 + bj * HALF + 4);
#pragma unroll
                for (int ai = 0; ai < 2; ++ai) {
#pragma unroll
                    for (int m = 0; m < 4; ++m) { f32x4* p = (f32x4*)(base + (size_t)(ai * HALF + wr * 64 + m * 16 + fr) * DM + col0 + bj * HALF); p[0] = p[0] + g0 * acc[ai][bj][m][0]; p[1] = p[1] + g1 * acc[ai][bj][m][1]; }
                    asm volatile("" ::: "memory"); } }
        } else {
            bf16_t* base = X16 + ((size_t)bl * SEQ + (size_t)(tt - 1) * 256) * DM; const float* gate = mod + b * MOD_ROW + gidx * DM;
#pragma unroll
            for (int bj = 0; bj < 2; ++bj) { const f32x4 g0 = *(const f32x4*)(gate + col0 + bj * HALF), g1 = *(const f32x4*)(gate + col0 + bj * HALF + 4);
#pragma unroll
                for (int ai = 0; ai < 2; ++ai) {
#pragma unroll
                    for (int m = 0; m < 4; ++m) { u32x4* p = (u32x4*)(base + (size_t)(ai * HALF + wr * 64 + m * 16 + fr) * DM + col0 + bj * HALF); const u32x4 w = *p; const f32x4 a0 = acc[ai][bj][m][0], a1 = acc[ai][bj][m][1];
                        u32x4 o; o.x = cvt_pk_bf16(bflo(w.x) + g0.x * a0.x, bfhi(w.x) + g0.y * a0.y); o.y = cvt_pk_bf16(bflo(w.y) + g0.z * a0.z, bfhi(w.y) + g0.w * a0.w);
                        o.z = cvt_pk_bf16(bflo(w.z) + g1.x * a1.x, bfhi(w.z) + g1.y * a1.y); o.w = cvt_pk_bf16(bflo(w.w) + g1.z * a1.z, bfhi(w.w) + g1.w * a1.w); *p = o; }
                    } asm volatile("" ::: "memory"); }
        }
    }
};

struct EpiCtxPartial {
    static constexpr bool PERM = false;
    float* PART;
    __device__ __forceinline__ void operator()(const f32x4 (&acc)[2][2][4][2], const Unit& u, int wr, int wc, int fr_, int fq) const {
        int fr = fr_; asm volatile("" : "+v"(fr));
        const int bl = u.pm / 33, sl = (int)(u.aoff >> 9);
        float* base = PART + ((size_t)sl * (GB * CTXL) + (size_t)bl * CTXL) * DM;
        const int col0 = u.pn * BM + wc * 32 + 4 * fq;
#pragma unroll
        for (int ai = 0; ai < 2; ++ai)
#pragma unroll
            for (int m = 0; m < 4; ++m) { float* rowp = base + (size_t)(ai * HALF + wr * 64 + m * 16 + fr) * DM + col0;
#pragma unroll
                for (int bj = 0; bj < 2; ++bj)
#pragma unroll
                    for (int n = 0; n < 2; ++n) *(f32x4*)(rowp + bj * HALF + n * 16) = acc[ai][bj][m][n]; }
    }
};

template <bool I8> struct AccT { typedef f32x4 T; };
template <> struct AccT<true> { typedef i32x4 T; };
template <class Epi, class Sched, bool ALIGN_EPI = true, bool SP2 = true, bool I8 = false, bool GATHER = false>
__device__ __forceinline__ void gemm_phase(LAS unsigned char* lds, const Gemm g, const Sched& S, const Epi& E, const int tid) {
    const int wid = __builtin_amdgcn_readfirstlane(tid >> 6), lane = tid & 63, wr = wid >> 2, wc = wid & 3, fr = lane & 15, fq = lane >> 4;
    constexpr int ES = I8 ? 1 : 2; typedef typename AccT<I8>::T acc_t;
    const int K = g.K, nt = K * ES / (BK * 2);
    unsigned voffA[2], voffB[2];
    int gRow[2]; unsigned gC2[2];
#pragma unroll
    for (int i = 0; i < 2; ++i) { int R, C; stage_rc(tid * 16 + i * 8192, R, C); const int Rb = Epi::PERM ? ((R & ~31) + perm32(R & 31)) : R;
        voffA[i] = (unsigned)(R * g.lda * ES + C * 2); voffB[i] = (unsigned)(Rb * g.ldb * ES + C * 2); gRow[i] = R; gC2[i] = (unsigned)(C * 2); }
    unsigned vc0[2], vc1[2], vn0[2], vn1[2], vq0[2], vq1[2];
#define PG8_GATH(u, v0, v1) do { _Pragma("unroll") for (int _i = 0; _i < 2; ++_i) { const GAS int* _tp = (const GAS int*)g.rowtab + (u).pm * BM + gRow[_i]; \
        v0[_i] = (unsigned)_tp[0] * (unsigned)(g.lda * ES) + gC2[_i]; v1[_i] = (unsigned)_tp[HALF] * (unsigned)(g.lda * ES) + gC2[_i]; } } while (0)
    const size_t kstep = (size_t)(BK * 2);
    const size_t hstepA = GATHER ? (size_t)0 : (size_t)HALF * g.lda * ES, hstepB = (size_t)HALF * g.ldb * ES;
    const size_t tstepA = 2 * hstepA, tstepB = 2 * hstepB;
    const unsigned ldsw = (unsigned)wid * 1024u;
    const int aoff = lds_byte(wr * 64 + fr, fq * 8), boff = lds_byte(wc * 32 + fr, fq * 8);
#define PG8_SA(b, h) (((b) * 2 + (h)) * HTB)
#define PG8_SB(b, h) ((4 + (b) * 2 + (h)) * HTB)
#define PG8_STAGE(bufoff, gbase, voff) do { _Pragma("unroll") for (int _i = 0; _i < 2; ++_i) \
        __builtin_amdgcn_global_load_lds((const unsigned*)((const char*)(gbase) + (voff)[_i]), (LAS unsigned*)(lds + (bufoff) + ldsw + _i * 8192), 16, 0, 0); } while (0)
#define PG8_LDA(dst, b, h) do { _Pragma("unroll") for (int m = 0; m < 4; ++m) _Pragma("unroll") for (int k = 0; k < 2; ++k) dst[m][k] = *(const LAS bf16x8*)(lds + PG8_SA(b, h) + aoff + m * 2048 + k * 1024); } while (0)
#define PG8_LDB(dst, b, h) do { _Pragma("unroll") for (int n = 0; n < 2; ++n) _Pragma("unroll") for (int k = 0; k < 2; ++k) dst[n][k] = *(const LAS bf16x8*)(lds + PG8_SB(b, h) + boff + n * 2048 + k * 1024); } while (0)
#define PG8_MMA(ai, bj, At, Bt) do { __builtin_amdgcn_s_setprio(1); _Pragma("unroll") for (int m = 0; m < 4; ++m) _Pragma("unroll") for (int n = 0; n < 2; ++n) _Pragma("unroll") for (int k = 0; k < 2; ++k) \
        { if constexpr (I8) acc[ai][bj][m][n] = __builtin_amdgcn_mfma_i32_16x16x64_i8(__builtin_bit_cast(i32x4, Bt[n][k]), __builtin_bit_cast(i32x4, At[m][k]), acc[ai][bj][m][n], 0, 0, 0); \
          else acc[ai][bj][m][n] = __builtin_amdgcn_mfma_f32_16x16x32_bf16(Bt[n][k], At[m][k], acc[ai][bj][m][n], 0, 0, 0); } __builtin_amdgcn_s_setprio(0); } while (0)
#define PG8_WAIT_V(n) asm volatile("s_waitcnt vmcnt(" #n ")" ::: "memory")
#define PG8_WAIT_L(n) asm volatile("s_waitcnt lgkmcnt(" #n ")" ::: "memory")
#define PG8_BAR __builtin_amdgcn_s_barrier()
#define PG8_SCHED __builtin_amdgcn_sched_barrier(0)
    Unit cur, nxt; int ui = 0;
    if (!S.next(0, cur)) return;
    acc_t acc[2][2][4][2];
#pragma unroll
    for (int a = 0; a < 2; ++a)
#pragma unroll
        for (int b = 0; b < 2; ++b)
#pragma unroll
            for (int m = 0; m < 4; ++m)
#pragma unroll
                for (int n = 0; n < 2; ++n) acc[a][b][m][n] = acc_t{};
    bf16x8 At[4][2], B0[2][2], B1[2][2];
    const char* cA = (const char*)g.A + cur.aoff + (size_t)cur.pm * tstepA; const char* cB = (const char*)g.Bt + cur.boff + (size_t)cur.pn * tstepB;
    if constexpr (GATHER) { PG8_GATH(cur, vc0, vc1); Unit t1; if (S.next(1, t1)) PG8_GATH(t1, vn0, vn1); else { vn0[0] = vc0[0]; vn0[1] = vc0[1]; vn1[0] = vc1[0]; vn1[1] = vc1[1]; } }
    else {
#pragma unroll
        for (int i = 0; i < 2; ++i) { vc0[i] = vc1[i] = vn0[i] = vn1[i] = voffA[i]; } }
    if constexpr (SP2) {
        PG8_STAGE(PG8_SB(0, 0), cB, voffB); PG8_STAGE(PG8_SB(0, 1), cB + hstepB, voffB); PG8_STAGE(PG8_SA(0, 0), cA, vc0); PG8_STAGE(PG8_SA(0, 1), cA + hstepA, vc1);
        if (wr == 1) PG8_BAR;
        PG8_WAIT_V(2); PG8_BAR;
        PG8_STAGE(PG8_SB(1, 0), cB + kstep, voffB); PG8_STAGE(PG8_SA(1, 0), cA + kstep, vc0); PG8_STAGE(PG8_SB(1, 1), cB + hstepB + kstep, voffB);
        PG8_WAIT_V(6); PG8_BAR;
    } else {
        PG8_STAGE(PG8_SB(0, 0), cB, voffB); PG8_STAGE(PG8_SA(0, 0), cA, voffA); PG8_STAGE(PG8_SB(0, 1), cB + hstepB, voffB); PG8_STAGE(PG8_SA(0, 1), cA + hstepA, voffA);
        if (wr == 1) PG8_BAR;
        PG8_WAIT_V(4); PG8_BAR;
        PG8_STAGE(PG8_SB(1, 0), cB + kstep, voffB); PG8_STAGE(PG8_SA(1, 0), cA + kstep, voffA); PG8_STAGE(PG8_SB(1, 1), cB + hstepB + kstep, voffB);
        PG8_WAIT_V(6); PG8_BAR;
    }
    for (;;) {
        const bool has_next = S.next(ui + 1, nxt);
        const char* nA = has_next ? (const char*)g.A + nxt.aoff + (size_t)nxt.pm * tstepA : cA; const char* nB = has_next ? (const char*)g.Bt + nxt.boff + (size_t)nxt.pn * tstepB : cB;
        for (int t = 0; t < nt; t += 2) {
            const bool last = (t == nt - 2);
            const char* a1 = cA + (size_t)(t + 1) * kstep;
            const char* a2 = last ? nA : cA + (size_t)(t + 2) * kstep; const char* b2 = last ? nB : cB + (size_t)(t + 2) * kstep;
            const char* a3 = a2 + kstep; const char* b3 = b2 + kstep;
            if constexpr (SP2) {
            unsigned sA0[2], sA1[2];
            if constexpr (GATHER) {
#pragma unroll
                for (int i = 0; i < 2; ++i) { sA0[i] = last ? vn0[i] : vc0[i]; sA1[i] = last ? vn1[i] : vc1[i]; } }
            else { sA0[0] = sA1[0] = voffA[0]; sA0[1] = sA1[1] = voffA[1]; }
            PG8_LDB(B0, 0, 0); PG8_LDB(B1, 0, 1); PG8_SCHED; PG8_LDA(At, 0, 0); PG8_STAGE(PG8_SA(1, 1), a1 + hstepA, vc1);
            PG8_WAIT_V(8); PG8_WAIT_L(0); PG8_BAR; PG8_MMA(0, 0, At, B0); PG8_MMA(0, 1, At, B1); PG8_BAR; PG8_SCHED;
            PG8_LDA(At, 0, 1); PG8_STAGE(PG8_SB(0, 0), b2, voffB); PG8_STAGE(PG8_SB(0, 1), b2 + hstepB, voffB); PG8_STAGE(PG8_SA(0, 0), a2, sA0);
            PG8_WAIT_V(8); PG8_WAIT_L(0); PG8_BAR; PG8_MMA(1, 0, At, B0); PG8_MMA(1, 1, At, B1); PG8_BAR; PG8_SCHED;
            PG8_LDB(B0, 1, 0); PG8_LDB(B1, 1, 1); PG8_SCHED; PG8_LDA(At, 1, 0); PG8_STAGE(PG8_SA(0, 1), a2 + hstepA, sA1);
            PG8_WAIT_V(8); PG8_WAIT_L(0); PG8_BAR; PG8_MMA(0, 0, At, B0); PG8_MMA(0, 1, At, B1); PG8_BAR; PG8_SCHED;
            PG8_LDA(At, 1, 1); PG8_STAGE(PG8_SB(1, 0), b3, voffB); PG8_STAGE(PG8_SB(1, 1), b3 + hstepB, voffB); PG8_STAGE(PG8_SA(1, 0), a3, sA0);
            PG8_WAIT_V(8); PG8_WAIT_L(0); PG8_BAR; PG8_MMA(1, 0, At, B0); PG8_MMA(1, 1, At, B1); PG8_BAR; PG8_SCHED;
            } else {
            PG8_LDB(B0, 0, 0); PG8_SCHED; PG8_LDA(At, 0, 0); PG8_STAGE(PG8_SA(1, 1), a1 + hstepA, voffA);
            PG8_WAIT_L(8); PG8_BAR; PG8_WAIT_L(0); PG8_MMA(0, 0, At, B0); PG8_BAR; PG8_SCHED;
            PG8_LDB(B1, 0, 1); PG8_STAGE(PG8_SB(0, 0), b2, voffB);
            PG8_BAR; PG8_WAIT_L(0); PG8_MMA(0, 1, At, B1); PG8_BAR;
            PG8_LDA(At, 0, 1); PG8_STAGE(PG8_SA(0, 0), a2, voffA);
            PG8_BAR; PG8_WAIT_L(0); PG8_MMA(1, 0, At, B0); PG8_BAR; PG8_SCHED;
            PG8_STAGE(PG8_SB(0, 1), b2 + hstepB, voffB);
            PG8_WAIT_V(6); PG8_BAR; PG8_MMA(1, 1, At, B1); PG8_BAR;
            PG8_LDB(B0, 1, 0); PG8_SCHED; PG8_LDA(At, 1, 0); PG8_STAGE(PG8_SA(0, 1), a2 + hstepA, voffA);
            PG8_WAIT_L(8); PG8_BAR; PG8_WAIT_L(0); PG8_MMA(0, 0, At, B0); PG8_BAR; PG8_SCHED;
            PG8_LDB(B1, 1, 1); PG8_STAGE(PG8_SB(1, 0), b3, voffB);
            PG8_BAR; PG8_WAIT_L(0); PG8_MMA(0, 1, At, B1); PG8_BAR;
            PG8_LDA(At, 1, 1); PG8_STAGE(PG8_SA(1, 0), a3, voffA);
            PG8_BAR; PG8_WAIT_L(0); PG8_MMA(1, 0, At, B0); PG8_BAR; PG8_SCHED;
            PG8_STAGE(PG8_SB(1, 1), b3 + hstepB, voffB);
            PG8_WAIT_V(6); PG8_BAR; PG8_MMA(1, 1, At, B1); PG8_BAR;
            }
        }
        if constexpr (ALIGN_EPI) { if (wr == 0) PG8_BAR; }
        bool has_q = false;
        if constexpr (GATHER) { Unit t2; has_q = has_next && S.next(ui + 2, t2); if (has_q) PG8_GATH(t2, vq0, vq1); }
        E(acc, cur, wr, wc, fr, fq);
        if (!has_next) break;
        if constexpr (GATHER) {
#pragma unroll
            for (int i = 0; i < 2; ++i) { vc0[i] = vn0[i]; vc1[i] = vn1[i]; if (has_q) { vn0[i] = vq0[i]; vn1[i] = vq1[i]; } } }
#pragma unroll
        for (int a = 0; a < 2; ++a)
#pragma unroll
            for (int b = 0; b < 2; ++b)
#pragma unroll
                for (int m = 0; m < 4; ++m)
#pragma unroll
                    for (int n = 0; n < 2; ++n) acc[a][b][m][n] = acc_t{};
        cur = nxt; cA = nA; cB = nB; ++ui;
        if constexpr (ALIGN_EPI) { if (wr == 1) PG8_BAR; }
    }
    PG8_WAIT_V(0);
    if constexpr (!ALIGN_EPI) { if (wr == 0) PG8_BAR; }
    PG8_BAR;
#undef PG8_GATH
#undef PG8_SA
#undef PG8_SB
#undef PG8_STAGE
#undef PG8_LDA
#undef PG8_LDB
#undef PG8_MMA
#undef PG8_WAIT_V
#undef PG8_WAIT_L
#undef PG8_BAR
#undef PG8_SCHED
}
}

#define XB_TMO      128
#define XB_XCNT(j)  (256  + 64 * (j))
#define XB_XSUB(j)  (1280 + 64 * (j))
#define XB_XGEN(j)  (2304 + 64 * (j))
#define XB_TOP      3328
#define XB_TOPGEN   3392
#define XCD_BAR_WORDS 3456
#define XB_SPIN_CAP (1u << 22)
__device__ __forceinline__ unsigned xb_ld(unsigned* p)              { return __hip_atomic_load(p, __ATOMIC_RELAXED, __HIP_MEMORY_SCOPE_AGENT); }
__device__ __forceinline__ unsigned xb_add(unsigned* p, unsigned v) { return __hip_atomic_fetch_add(p, v, __ATOMIC_RELAXED, __HIP_MEMORY_SCOPE_AGENT); }
__device__ __forceinline__ unsigned xb_xcc_id() { return (unsigned)__builtin_amdgcn_s_getreg((3 << 11) | 20) & 0xFu; }
#define XB_SPIN(cond, bar) do { unsigned _sp = 0; while (cond) { __builtin_amdgcn_s_sleep(1); \
    if ((++_sp & 255u) == 0u) { if (xb_ld(&(bar)[XB_TMO])) break; if (_sp > XB_SPIN_CAP) { atomicAdd(&(bar)[XB_TMO], 1u); break; } } } } while (0)
struct XcdBarrier { unsigned* bar; unsigned x; volatile LAS unsigned* st; };
__device__ __forceinline__ XcdBarrier xcd_barrier_post(unsigned* bar, volatile LAS unsigned* st) {
    XcdBarrier b; b.bar = bar; b.x = xb_xcc_id(); b.st = st;
    if (threadIdx.x == 0) (void)xb_add(&bar[XB_XCNT(b.x)], 1u);
    return b;
}
__device__ __forceinline__ void xcd_barrier_complete(unsigned* bar, unsigned x, unsigned& nloc, unsigned& nx) {
    const unsigned G = gridDim.x * gridDim.y * gridDim.z;
    unsigned sum, cnt, mine, sp = 0u;
    for (;;) {
        sum = 0u; cnt = 0u; mine = 0u;
#pragma unroll
        for (unsigned j = 0; j < 16; ++j) { const unsigned c = xb_ld(&bar[XB_XCNT(j)]); sum += c; cnt += (c > 0u) ? 1u : 0u; mine = (j == x) ? c : mine; }
        if (sum == G) break;
        __builtin_amdgcn_s_sleep(1);
        if ((++sp & 255u) == 0u) { if (xb_ld(&bar[XB_TMO])) break; if (sp > XB_SPIN_CAP) { atomicAdd(&bar[XB_TMO], 1u); break; } }
    }
    nloc = mine > 0u ? mine : 1u; nx = cnt > 0u ? cnt : 1u;
}
__device__ __forceinline__ void xcd_barrier(const XcdBarrier& b) {
    asm volatile("s_waitcnt vmcnt(0)" ::: "memory");
    __syncthreads();
    if (threadIdx.x == 0) {
        unsigned* bar = b.bar;
        __builtin_amdgcn_s_waitcnt(0);
        unsigned nloc = b.st[0], nx = b.st[1];
        if (nloc == 0u) { xcd_barrier_complete(bar, b.x, nloc, nx); b.st[0] = nloc; b.st[1] = nx; }
        const unsigned old = xb_add(&bar[XB_XSUB(b.x)], 1u);
        const unsigned gen = old / nloc;
        if (old + 1u == (gen + 1u) * nloc) {
            __builtin_amdgcn_fence(__ATOMIC_RELEASE, "agent");
            asm volatile("s_waitcnt vmcnt(0)" ::: "memory");
            const unsigned og = xb_add(&bar[XB_TOP], 1u);
            const unsigned tg = og / nx;
            if (og + 1u == (tg + 1u) * nx) xb_add(&bar[XB_TOPGEN], 1u);
            else XB_SPIN(xb_ld(&bar[XB_TOPGEN]) == tg, bar);
            __builtin_amdgcn_fence(__ATOMIC_ACQUIRE, "agent");
            xb_add(&bar[XB_XGEN(b.x)], 1u);
            asm volatile("s_waitcnt vmcnt(0)" ::: "memory");
        } else {
            XB_SPIN(xb_ld(&bar[XB_XGEN(b.x)]) == gen, bar);
            __builtin_amdgcn_fence(__ATOMIC_ACQUIRE, "agent");
            asm volatile("s_waitcnt vmcnt(0)" ::: "memory");
        }
    }
    __syncthreads();
}

namespace att {
#define SBAR() __builtin_amdgcn_sched_barrier(0)
__device__ __forceinline__ int crow(int r, int hi) { return (r & 3) + 8 * (r >> 2) + 4 * hi; }
template <int KPB> __device__ __forceinline__ int kswz(int row, int colB) {
    if constexpr (KPB == 128) return row * 128 + (colB ^ (((row >> 1) & 7) << 4));
    else return row * 256 + (colB ^ ((row & 15) << 4));
}
template <int NCB> __device__ __forceinline__ int v_st(int k, int c) { const int kk = k; return ((kk >> 3) * NCB + (c >> 5)) * 512 + ((kk & 7) * 32 + (c & 31)) * 2; }
__device__ __forceinline__ int v_rd_base(int lane) { return ((lane & 3) << 3) | (((lane >> 2) & 3) << 6) | (((lane >> 4) & 1) << 5) | (((lane >> 5) & 1) << 8); }
template <int OFF> __device__ __forceinline__ s16x4 tr_read(int vb) { s16x4 r; asm volatile("ds_read_b64_tr_b16 %0, %1 offset:%2" : "=&v"(r) : "v"(vb), "i"(OFF) : "memory"); return r; }

constexpr float ATT_THR = 11.541560327111707f;
template <bool FIRST>
__device__ __forceinline__ void partialSM(f32x16& p0, f32x16& p1, float& mhat, float& alpha, const bool nomax) {
    alpha = 1.f;
    if (!nomax) {
        float pmax = fmaxf(p0[0], p1[0]);
#pragma unroll
        for (int r = 1; r < 16; ++r) pmax = fmaxf(fmaxf(pmax, p0[r]), p1[r]);
        { auto rr = __builtin_amdgcn_permlane32_swap(__float_as_uint(pmax), __float_as_uint(pmax), false, false);
          pmax = fmaxf(__uint_as_float(rr[0]), __uint_as_float(rr[1])); }
        const float d = pmax - mhat; const bool move = FIRST ? (d > ATT_THR || d < -ATT_THR) : (d > ATT_THR);
        if (__builtin_expect(__any(move), 0)) { const float mn = move ? pmax : mhat; alpha = FIRST ? 1.f : __builtin_amdgcn_exp2f(mhat - mn); mhat = mn; }
        if (__builtin_expect(__any(mhat != 0.f), 0)) {
#pragma unroll
            for (int r = 0; r < 16; ++r) { p0[r] -= mhat; p1[r] -= mhat; } }
    }
#pragma unroll
    for (int r = 0; r < 16; ++r) p0[r] = __builtin_amdgcn_exp2f(p0[r]);
}
template <bool LM>
__device__ __forceinline__ void finishSM(f32x16& p0, f32x16& p1, float alpha, float& l_reg, bf16x8& pa0, bf16x8& pa1, bf16x8& pa2, bf16x8& pa3) {
#pragma unroll
    for (int r = 0; r < 16; ++r) p1[r] = __builtin_amdgcn_exp2f(p1[r]);
    if constexpr (!LM) { float ps = 0;
#pragma unroll
        for (int r = 0; r < 16; ++r) ps += p0[r];
#pragma unroll
        for (int r = 0; r < 16; ++r) ps += p1[r];
        { auto rr = __builtin_amdgcn_permlane32_swap(__float_as_uint(ps), __float_as_uint(ps), false, false);
          ps = __uint_as_float(rr[0]) + __uint_as_float(rr[1]); }
        l_reg = l_reg * alpha + ps; }
#define PK4(P, BASE, OUT) do { const u32x4 w = {cvt_pk_bf16(P[BASE + 0], P[BASE + 1]), cvt_pk_bf16(P[BASE + 2], P[BASE + 3]), cvt_pk_bf16(P[BASE + 4], P[BASE + 5]), cvt_pk_bf16(P[BASE + 6], P[BASE + 7])}; \
    OUT = __builtin_bit_cast(bf16x8, w); } while (0)
    PK4(p0, 0, pa0); PK4(p0, 8, pa1); PK4(p1, 0, pa2); PK4(p1, 8, pa3);
#undef PK4
}
template <int DQK, int KPB> __device__ __forceinline__ void qkt(f32x16& p0, f32x16& p1, const char* Ks, const bf16x8* qr, int r32, int hi) {
    p0 = f32x16{}; p1 = f32x16{};
#pragma unroll
    for (int d0 = 0; d0 < DQK / 16; ++d0) { const int cb = (d0 * 16 + hi * 8) * 2;
        const bf16x8 b0 = *reinterpret_cast<const bf16x8*>(Ks + kswz<KPB>(r32, cb));
        const bf16x8 b1 = *reinterpret_cast<const bf16x8*>(Ks + kswz<KPB>(32 + r32, cb));
        p0 = __builtin_amdgcn_mfma_f32_32x32x16_bf16(b0, qr[d0], p0, 0, 0, 0);
        p1 = __builtin_amdgcn_mfma_f32_32x32x16_bf16(b1, qr[d0], p1, 0, 0, 0); }
}
template <int NCB, int D0> __device__ __forceinline__ void pv_one(f32x16& od, int vb, bf16x8 pa0, bf16x8 pa1, bf16x8 pa2, bf16x8 pa3) {
    constexpr int KS = 2 * NCB * 512, HF = NCB * 512, B0 = D0 * 512;
    const s16x4 l0 = tr_read<B0>(vb), h0 = tr_read<B0 + HF>(vb), l1 = tr_read<B0 + KS>(vb), h1 = tr_read<B0 + KS + HF>(vb);
    const s16x4 l2 = tr_read<B0 + 2 * KS>(vb), h2 = tr_read<B0 + 2 * KS + HF>(vb), l3 = tr_read<B0 + 3 * KS>(vb), h3 = tr_read<B0 + 3 * KS + HF>(vb);
    asm volatile("s_waitcnt lgkmcnt(0)" ::: "memory"); SBAR();
#define PKV(L, H) (bf16x8){L[0], L[1], L[2], L[3], H[0], H[1], H[2], H[3]}
    od = __builtin_amdgcn_mfma_f32_32x32x16_bf16(pa0, PKV(l0, h0), od, 0, 0, 0);
    od = __builtin_amdgcn_mfma_f32_32x32x16_bf16(pa1, PKV(l1, h1), od, 0, 0, 0);
    od = __builtin_amdgcn_mfma_f32_32x32x16_bf16(pa2, PKV(l2, h2), od, 0, 0, 0);
    od = __builtin_amdgcn_mfma_f32_32x32x16_bf16(pa3, PKV(l3, h3), od, 0, 0, 0);
#undef PKV
}
template <int NCB, bool LM> __device__ __forceinline__ void pv_all(f32x16* o, f32x16& ol, int vb, bf16x8 pa0, bf16x8 pa1, bf16x8 pa2, bf16x8 pa3) {
    pv_one<NCB, 0>(o[0], vb, pa0, pa1, pa2, pa3); pv_one<NCB, 1>(o[1], vb, pa0, pa1, pa2, pa3);
    if constexpr (NCB == 4) { pv_one<NCB, 2>(o[2], vb, pa0, pa1, pa2, pa3); pv_one<NCB, 3>(o[3], vb, pa0, pa1, pa2, pa3); }
    if constexpr (LM) { const bf16x8 ones = {0x3F80, 0x3F80, 0x3F80, 0x3F80, 0x3F80, 0x3F80, 0x3F80, 0x3F80};
        ol = __builtin_amdgcn_mfma_f32_32x32x16_bf16(pa0, ones, ol, 0, 0, 0); ol = __builtin_amdgcn_mfma_f32_32x32x16_bf16(pa1, ones, ol, 0, 0, 0);
        ol = __builtin_amdgcn_mfma_f32_32x32x16_bf16(pa2, ones, ol, 0, 0, 0); ol = __builtin_amdgcn_mfma_f32_32x32x16_bf16(pa3, ones, ol, 0, 0, 0); }
}

template <int DQK, int DV>
__device__ __forceinline__ void attn_unit(const bf16_t* __restrict__ Qb, int ldq, const bf16_t* __restrict__ Kh, int ldk, const bf16_t* __restrict__ Kpe,
                                          const bf16_t* __restrict__ Vh, int ldv, bf16_t* __restrict__ Ob, int ldo, int seq, char* lds, const int tid, const float* ropetab = nullptr, const int rope_t0 = -1, const float kmax2 = -1.f) {
    constexpr int KPB = (DQK == 64) ? 128 : 256, NCB = DV / 32, SHM_K = 64 * KPB, SHM_V = 64 * DV * 2, NV = DV / 64;
    constexpr bool KS = (DQK == 96), LM = false;
    const int wid = tid >> 6, lane = tid & 63, r32 = lane & 31, hi = lane >> 5;
    char* V_lds = lds; char* K_lds = lds + 3 * SHM_V;
    float* ws = (float*)(lds + 3 * SHM_V + 3 * SHM_K) + wid * 64; float* li_l = ws; float* al_l = ws + 32;
    float mhat = 0.f, l_reg = 0; f32x16 o[NCB], ol = f32x16{}; bf16x8 qr[DQK / 16];
#pragma unroll
    for (int d = 0; d < NCB; ++d) o[d] = f32x16{};
    const bf16_t* Qw = Qb + (long)(wid * 32 + r32) * ldq + hi * 8;
#pragma unroll
    for (int d0 = 0; d0 < DQK / 16; ++d0) qr[d0] = *reinterpret_cast<const bf16x8*>(Qw + d0 * 16);
    if constexpr (DQK == 96) { if (rope_t0 >= 0) {
        const int tl = rope_t0 + wid * 32 + r32;
#pragma unroll
        for (int d0 = 4; d0 < 6; ++d0) { const int pos = (d0 == 4) ? (tl >> 6) : (tl & 63); const float* tb = ropetab + pos * 8;
            const f32x4 c0 = *(const f32x4*)tb, c1 = *(const f32x4*)(tb + 4), s0 = *(const f32x4*)(tb + 1024), s1 = *(const f32x4*)(tb + 1028);
            const float cs[8] = {c0.x, c0.y, c0.z, c0.w, c1.x, c1.y, c1.z, c1.w}, sn[8] = {s0.x, s0.y, s0.z, s0.w, s1.x, s1.y, s1.z, s1.w};
            const u32x4 own = __builtin_bit_cast(u32x4, qr[d0]); u32x4 res;
#pragma unroll
            for (int w = 0; w < 4; ++w) { auto rr = __builtin_amdgcn_permlane32_swap(own[w], own[w], false, false); const unsigned oth = hi ? rr[0] : rr[1];
                const float a0 = bflo(own[w]), a1 = bfhi(own[w]), b0 = bflo(oth), b1 = bfhi(oth);
                const float r0 = hi ? (a0 * cs[2 * w] + b0 * sn[2 * w]) : (a0 * cs[2 * w] - b0 * sn[2 * w]);
                const float r1 = hi ? (a1 * cs[2 * w + 1] + b1 * sn[2 * w + 1]) : (a1 * cs[2 * w + 1] - b1 * sn[2 * w + 1]);
                res[w] = pk2(r0, r1); }
            qr[d0] = __builtin_bit_cast(bf16x8, res); } } }
    bool nomax = false;
    if (kmax2 >= 0.f) {
        float qn = 0.f;
#pragma unroll
        for (int d0 = 0; d0 < DQK / 16; ++d0) { const u32x4 w = __builtin_bit_cast(u32x4, qr[d0]);
#pragma unroll
            for (int e = 0; e < 4; ++e) { const float a = bflo(w[e]), b = bfhi(w[e]); qn += a * a + b * b; } }
        { auto rr = __builtin_amdgcn_permlane32_swap(__float_as_uint(qn), __float_as_uint(qn), false, false); qn = __uint_as_float(rr[0]) + __uint_as_float(rr[1]); }
        nomax = __all(qn * kmax2 * 1.1f < 3600.f);
    }
    const int krow = tid >> 3, kch = tid & 7, kst = kswz<KPB>(krow, kch * 16);
    const int k2row = (tid >> 2) & 63, k2ch = tid & 3, k2st = kswz<KPB>(k2row, 128 + k2ch * 16);
    const int vrow = (NV == 1) ? (tid >> 3) : (tid >> 4), vcol = (NV == 1) ? (tid & 7) * 8 : (tid & 15) * 8;
    const int vst0 = v_st<NCB>(vrow, vcol), vst1 = v_st<NCB>(32 + vrow, vcol);
    const int vb0 = (int)(uintptr_t)V_lds + v_rd_base(lane);
    struct { bf16x8 k0, k1, v0, v1; } sr_[2];
    const unsigned koff = (unsigned)(krow * ldk + kch * 8), k2off = (unsigned)(k2row * 32 + k2ch * 8), voff0 = (unsigned)(vrow * ldv + vcol), voff1 = (unsigned)((32 + vrow) * ldv + vcol);
#define SLOAD(i, k0_) do { const bf16_t* kt_ = Kh + (size_t)(k0_) * ldk; const bf16_t* vt_ = Vh + (size_t)(k0_) * ldv; sr_[i].k0 = *reinterpret_cast<const bf16x8*>(kt_ + koff); \
    if constexpr (KS) { if (tid < 256) sr_[i].k1 = *reinterpret_cast<const bf16x8*>(Kpe + (size_t)(k0_) * 32 + k2off); } \
    sr_[i].v0 = *reinterpret_cast<const bf16x8*>(vt_ + voff0); \
    if constexpr (NV == 2) sr_[i].v1 = *reinterpret_cast<const bf16x8*>(vt_ + voff1); } while (0)
#define SWRITE(slot, i) do { char* kd_ = K_lds + (slot) * SHM_K; char* vd_ = V_lds + (slot) * SHM_V; *(bf16x8*)(kd_ + kst) = sr_[i].k0; \
    if constexpr (KS) { if (tid < 256) *(bf16x8*)(kd_ + k2st) = sr_[i].k1; } \
    *(bf16x8*)(vd_ + vst0) = sr_[i].v0; \
    if constexpr (NV == 2) *(bf16x8*)(vd_ + vst1) = sr_[i].v1; } while (0)
    constexpr int NLD = 1 + (KS ? 1 : 0) + NV;
#define SWAIT() do { if constexpr (KS) asm volatile("s_waitcnt vmcnt(2)" ::: "memory"); else if constexpr (NLD == 2) asm volatile("s_waitcnt vmcnt(2)" ::: "memory"); else asm volatile("s_waitcnt vmcnt(3)" ::: "memory"); } while (0)
#define RESC(a) do { if (__any((a) < 1.f)) { if (hi == 0) al_l[r32] = (a); asm volatile("s_waitcnt lgkmcnt(0)" ::: "memory"); \
    _Pragma("unroll") for (int r = 0; r < 16; ++r) { const float f_ = al_l[crow(r, hi)]; _Pragma("unroll") for (int d = 0; d < NCB; ++d) o[d][r] *= f_; if constexpr (LM) ol[r] *= f_; } } } while (0)
    f32x16 pA0, pA1, pB0, pB1; float alA, alB; bf16x8 pa0, pa1, pa2, pa3; const int NT = seq / 64;
    SLOAD(0, 0); asm volatile("s_waitcnt vmcnt(0)" ::: "memory"); SWRITE(0, 0); __syncthreads();
    qkt<DQK, KPB>(pA0, pA1, K_lds, qr, r32, hi); partialSM<true>(pA0, pA1, mhat, alA, nomax);
    SLOAD(1, 64); if (2 < NT) SLOAD(0, 128);
    SWAIT(); SWRITE(1, 1); __syncthreads();
    int sp = 0, sc = 1, sn = 2;
#define ROT() do { const int t_ = sp; sp = sc; sc = sn; sn = t_; } while (0)
    for (int j = 1; j + 1 < NT; j += 2) {
        SBAR(); qkt<DQK, KPB>(pB0, pB1, K_lds + sc * SHM_K, qr, r32, hi);
        finishSM<LM>(pA0, pA1, alA, l_reg, pa0, pa1, pa2, pa3); SBAR();
        SLOAD(1, (j + 2) * 64); SBAR();
        pv_all<NCB, LM>(o, ol, vb0 + sp * SHM_V, pa0, pa1, pa2, pa3); partialSM<false>(pB0, pB1, mhat, alB, nomax);
        SWAIT(); SWRITE(sn, 0);
        RESC(alB); __syncthreads(); ROT();
        SBAR(); qkt<DQK, KPB>(pA0, pA1, K_lds + sc * SHM_K, qr, r32, hi);
        finishSM<LM>(pB0, pB1, alB, l_reg, pa0, pa1, pa2, pa3); SBAR();
        if (j + 3 < NT) SLOAD(0, (j + 3) * 64); SBAR();
        pv_all<NCB, LM>(o, ol, vb0 + sp * SHM_V, pa0, pa1, pa2, pa3); partialSM<false>(pA0, pA1, mhat, alA, nomax);
        SWAIT(); SWRITE(sn, 1);
        RESC(alA); __syncthreads(); ROT();
    }
    SBAR(); qkt<DQK, KPB>(pB0, pB1, K_lds + sc * SHM_K, qr, r32, hi);
    finishSM<LM>(pA0, pA1, alA, l_reg, pa0, pa1, pa2, pa3); SBAR();
    pv_all<NCB, LM>(o, ol, vb0 + sp * SHM_V, pa0, pa1, pa2, pa3); partialSM<false>(pB0, pB1, mhat, alB, nomax);
    RESC(alB);
    finishSM<LM>(pB0, pB1, alB, l_reg, pa0, pa1, pa2, pa3); SBAR();
    pv_all<NCB, LM>(o, ol, vb0 + sc * SHM_V, pa0, pa1, pa2, pa3);
#undef ROT
    float rli[16];
    if constexpr (LM) {
#pragma unroll
        for (int r = 0; r < 16; ++r) rli[r] = __builtin_amdgcn_rcpf(ol[r]);
    } else { if (hi == 0) li_l[r32] = l_reg; asm volatile("s_waitcnt lgkmcnt(0)" ::: "memory");
#pragma unroll
        for (int r = 0; r < 16; ++r) rli[r] = __builtin_amdgcn_rcpf(li_l[crow(r, hi)]); }
    bf16_t* Ow = Ob + (long)(wid * 32) * ldo;
    { char* stg = lds + 3 * SHM_V + 3 * SHM_K + 8 * 256 + wid * (32 * DV * 2);
#pragma unroll
      for (int r = 0; r < 16; ++r) { const int orow = crow(r, hi);
#pragma unroll
          for (int d0 = 0; d0 < NCB; ++d0) *(bf16_t*)(stg + (orow * DV + d0 * 32 + r32) * 2) = (bf16_t)f2bf(o[d0][r] * rli[r]); }
      asm volatile("s_waitcnt lgkmcnt(0)" ::: "memory");
      constexpr int LPR = DV / 8, RPI = 64 / LPR;
#pragma unroll
      for (int i = 0; i < 32 / RPI; ++i) { const int row = i * RPI + lane / LPR, ch = lane % LPR; const u32x4 v = *(const u32x4*)(stg + (row * DV + ch * 8) * 2); *(u32x4*)(Ow + (long)row * ldo + ch * 8) = v; } }
    __syncthreads();
#undef SLOAD
#undef SWRITE
#undef SWAIT
#undef RESC
}
#undef SBAR
}

struct Frame {
    LAS unsigned char* lds; char* ldsg;
    volatile LAS unsigned* MISC;
    unsigned* ctl;
    int tid, lane, wave, G, gw, NGW;
    float* X; unsigned char* ws;
#define WSP(T, name, off) __device__ __forceinline__ T* name() const { return (T*)(ws + (off)); }
    WSP(float, CX, WS_CX) WSP(float, MOD, WS_MOD) WSP(float, TAB8, WS_TAB8) WSP(float, TAB16, WS_TAB16)
    WSP(bf16_t, HB, WS_HB) WSP(bf16_t, PB, WS_PB) WSP(bf16_t, QR, WS_QR) WSP(bf16_t, KV, WS_KV) WSP(bf16_t, KPE, WS_KPE)
    WSP(bf16_t, GQ, WS_GQ) WSP(bf16_t, GK, WS_GK) WSP(bf16_t, GV, WS_GV) WSP(bf16_t, OF, WS_OF) WSP(bf16_t, OB, WS_OB)
    WSP(bf16_t, ACT1, WS_ACT1) WSP(bf16_t, XG, WS_XG) WSP(float, GG, WS_GG) WSP(float, GBT, WS_GBT) WSP(unsigned char, GPRE, WS_GPRE)
    WSP(float, GCB, WS_GCB) WSP(float, SWD, WS_SWD) WSP(float, SATOK, WS_SATOK) WSP(float, SWD2, WS_SWD2) WSP(bf16_t, X16, WS_X16) WSP(float, PART, WS_PART) WSP(int, TOPE, WS_TOPE) WSP(int, SLOT, WS_SLOT) WSP(float, TOPW, WS_TOPW)
#undef WSP
};
struct ProIn { const float *w_in0, *w_uq, *w_ukv, *w_out0, *w_gu0, *w_d0, *w_in1, *w_out1, *w_gu1, *w_d1, *c, *c_ctx, *mod_w, *mod_b; };
__device__ __forceinline__ void row_bt(int r, int& bl, int& t) { bl = r / TT; t = r - bl * TT; }

__device__ __forceinline__ void p0_transpose_block(const float* W, int K, int N, bf16_t* WT, int ldt, int k0, int n0, int drow, LAS float* scr, int lane, const float sc) {
    float tv[32];
#pragma unroll
    for (int i = 0; i < 32; ++i) { const int kk = 2 * i + (lane >> 5); tv[i] = W[(size_t)(k0 + kk) * N + n0 + (lane & 31)]; }
#pragma unroll
    for (int i = 0; i < 32; ++i) { const int kk = 2 * i + (lane >> 5); scr[kk * 33 + (lane & 31)] = sc * tv[i]; }
    asm volatile("s_waitcnt lgkmcnt(0)" ::: "memory");
    const int c = lane & 7;
#pragma unroll
    for (int j = 0; j < 4; ++j) { const int n = (lane >> 3) + 8 * j; const LAS float* s = scr + (8 * c) * 33 + n;
        u32x4 o; o.x = pk2(s[0 * 33], s[1 * 33]); o.y = pk2(s[2 * 33], s[3 * 33]); o.z = pk2(s[4 * 33], s[5 * 33]); o.w = pk2(s[6 * 33], s[7 * 33]);
        *(u32x4*)(WT + (size_t)(drow + n) * ldt + k0 + 8 * c) = o; }
    asm volatile("s_waitcnt lgkmcnt(0)" ::: "memory");
}
__device__ __forceinline__ void p0_transpose_block_i8(const float* W, int K, int N, signed char* WT, int k0, int n0, int drow, LAS float* scr, int lane, const unsigned* smax, float* swd, const float presc) {
    float tv[32];
#pragma unroll
    for (int i = 0; i < 32; ++i) { const int kk = 2 * i + (lane >> 5); tv[i] = W[(size_t)(k0 + kk) * N + n0 + (lane & 31)]; }
    const float mx = __builtin_bit_cast(float, smax[n0 + (lane & 31)]); const float inv = mx > 0.f ? 127.0f / mx : 0.f;
#pragma unroll
    for (int i = 0; i < 32; ++i) { const int kk = 2 * i + (lane >> 5); scr[kk * 33 + (lane & 31)] = rintf(tv[i] * inv); }
    if (lane < 32 && k0 == 0) swd[drow + lane] = mx * presc * (1.0f / 127.0f);
    asm volatile("s_waitcnt lgkmcnt(0)" ::: "memory");
    const int c = lane & 3;
#pragma unroll
    for (int j = 0; j < 2; ++j) { const int n = (lane >> 2) + 16 * j; const LAS float* sp = scr + (16 * c) * 33 + n; u32x4 o;
#pragma unroll
        for (int q = 0; q < 4; ++q) { const int b0 = (int)sp[(4 * q + 0) * 33], b1 = (int)sp[(4 * q + 1) * 33], b2 = (int)sp[(4 * q + 2) * 33], b3 = (int)sp[(4 * q + 3) * 33];
            o[q] = (unsigned)(b0 & 0xff) | ((unsigned)(b1 & 0xff) << 8) | ((unsigned)(b2 & 0xff) << 16) | ((unsigned)(b3 & 0xff) << 24); }
        *(u32x4*)(WT + (size_t)(drow + n) * K + k0 + 16 * c) = o; }
    asm volatile("s_waitcnt lgkmcnt(0)" ::: "memory");
}
__device__ __forceinline__ int p0_matrix_i8(Frame& F, const float* W, int K, int N, signed char* WT, int F_gu, int base, LAS float* scr, const unsigned* smax, float* swd, int gw = -1, int ngw = 0, const float scale = 1.f, const int nscale = 0) {
    const int nblk = N / 32, items = (K / 64) * nblk; if (gw < 0) { gw = F.gw; ngw = F.NGW; }
    int first = (gw - base) % ngw; if (first < 0) first += ngw;
    for (int it = first; it < items; it += ngw) {
        const int kb = it / nblk, nb = it % nblk, n0 = 32 * nb;
        int drow = n0; if (F_gu) { const int up = n0 >= F_gu ? 1 : 0, f = n0 - up * F_gu; drow = (f >> 7) * 256 + up * 128 + (f & 127); }
        p0_transpose_block_i8(W, K, N, WT, 64 * kb, n0, drow, scr, F.lane, smax, swd, n0 < nscale ? scale : 1.f);
    }
    return base + items;
}
__device__ __forceinline__ int p0_absmax(Frame& F, const float* W, int K, int N, unsigned* smax, int base) {
    const int ncb = N / 64, nkh = K / 512, items = ncb * nkh;
    int first = (F.gw - base) % F.NGW; if (first < 0) first += F.NGW;
    for (int it = first; it < items; it += F.NGW) { const int kh = it % nkh, cb = it / nkh;
        const float* w = W + (size_t)(kh * 512) * N + cb * 64 + F.lane; float m = 0.f;
#pragma unroll 16
        for (int k = 0; k < 512; ++k) m = fmaxf(m, fabsf(w[(size_t)k * N]));
        atomicMax(smax + cb * 64 + F.lane, __builtin_bit_cast(unsigned, m)); }
    return base + items;
}
__device__ __forceinline__ int p0_matrix(Frame& F, const float* W, int K, int N, bf16_t* WT, int F_gu, int base, LAS float* scr, const float scale = 1.f, const int nscale = 0, int gw = -1, int ngw = 0) {
    const int nblk = N / 32, items = (K / 64) * nblk; if (gw < 0) { gw = F.gw; ngw = F.NGW; }
    int first = (gw - base) % ngw; if (first < 0) first += ngw;
    for (int it = first; it < items; it += ngw) {
        const int kb = it / nblk, nb = it % nblk, n0 = 32 * nb;
        int drow = n0;
        if (F_gu) { const int up = n0 >= F_gu ? 1 : 0, f = n0 - up * F_gu; drow = (f >> 7) * 256 + up * 128 + (f & 127); }
        p0_transpose_block(W, K, N, WT, K, 64 * kb, n0, drow, scr, F.lane, n0 < nscale ? scale : 1.f);
    }
    return base + items;
}
__device__ __forceinline__ void p0_strip_i8(Frame& F, const float* W, int N, signed char* WT, int n0, int drow, float* swd, const float presc, int par) {
    LAS float* scr = (LAS float*)(F.lds + F.wave * 16384);
    LAS float* red = (LAS float*)(F.lds + 131072 + par * 2048);
    const int lane = F.lane, kb = F.wave * 128;
    float tv[64];
#pragma unroll
    for (int i = 0; i < 64; ++i) { const int kk = 64 * (i >> 5) + 2 * (i & 31) + (lane >> 5); tv[i] = W[(size_t)(kb + kk) * N + n0 + (lane & 31)]; }
    float m = 0.f;
#pragma unroll
    for (int i = 0; i < 64; ++i) m = fmaxf(m, fabsf(tv[i]));
    red[(F.wave * 2 + (lane >> 5)) * 32 + (lane & 31)] = m;
    __syncthreads();
    float mx = 0.f;
#pragma unroll
    for (int j = 0; j < 16; ++j) mx = fmaxf(mx, red[j * 32 + (lane & 31)]);
    const float inv = mx > 0.f ? 127.0f / mx : 0.f;
    if (F.wave == 0 && lane < 32) swd[drow + lane] = mx * presc * (1.0f / 127.0f);
    const int c = lane & 3;
#pragma unroll
    for (int h = 0; h < 2; ++h) {
#pragma unroll
        for (int i = 0; i < 32; ++i) { const int kk = 2 * i + (lane >> 5); scr[kk * 33 + (lane & 31)] = rintf(tv[32 * h + i] * inv); }
        asm volatile("s_waitcnt lgkmcnt(0)" ::: "memory");
#pragma unroll
        for (int j = 0; j < 2; ++j) { const int n = (lane >> 2) + 16 * j; const LAS float* sp = scr + (16 * c) * 33 + n; u32x4 o;
#pragma unroll
            for (int q = 0; q < 4; ++q) { const int b0 = (int)sp[(4 * q + 0) * 33], b1 = (int)sp[(4 * q + 1) * 33], b2 = (int)sp[(4 * q + 2) * 33], b3 = (int)sp[(4 * q + 3) * 33];
                o[q] = (unsigned)(b0 & 0xff) | ((unsigned)(b1 & 0xff) << 8) | ((unsigned)(b2 & 0xff) << 16) | ((unsigned)(b3 & 0xff) << 24); }
            *(u32x4*)(WT + (size_t)(drow + n) * 1024 + kb + 64 * h + 16 * c) = o; }
        asm volatile("s_waitcnt lgkmcnt(0)" ::: "memory");
    }
}
__device__ __forceinline__ void p0_strips(Frame& F, int wg, int nwg, const float* w_in0, const float* w_gu0, const float* w_in1, const float* w_gu1, int e0, int e1) {
    constexpr int S0 = EV_IN / 32, S1 = 2 * FFN / 32, S2 = OD_IN / 32, SE = 2 * EXD / 32;
    const int nd = w_in0 ? S0 + S1 + S2 : 0, total = nd + (e1 - e0) * SE;
    int par = 0;
    __syncthreads();
    for (int it = wg; it < total; it += nwg, par ^= 1) {
        const float* W; int N, n0, drow, fgu = 0; signed char* WT; float* sd; float presc = 1.f;
        if (it < nd) {
            if (it < S0) { W = w_in0; N = EV_IN; n0 = 32 * it; WT = (signed char*)(F.ws + WS_WI0); sd = F.SWD2(); }
            else if (it < S0 + S1) { W = w_gu0; N = 2 * FFN; n0 = 32 * (it - S0); WT = (signed char*)(F.ws + WS_WGU0); sd = F.SWD2() + EV_INP; fgu = FFN; }
            else { W = w_in1; N = OD_IN; n0 = 32 * (it - S0 - S1); WT = (signed char*)(F.ws + WS_WI1); sd = F.SWD2() + EV_INP + 2 * FFN; if (n0 < 512) presc = ATT_C64; }
        } else { const int j = it - nd, e = e0 + j / SE; n0 = 32 * (j % SE); W = w_gu1 + (size_t)e * 1024 * 2 * EXD; N = 2 * EXD; WT = (signed char*)(F.ws + WS_WGU1) + (size_t)e * 2 * EXD * 1024; sd = F.SWD() + e * (2 * EXD); fgu = EXD; }
        drow = n0; if (fgu) { const int up = n0 >= fgu ? 1 : 0, f = n0 - up * fgu; drow = (f >> 7) * 256 + up * 128 + (f & 127); }
        p0_strip_i8(F, W, N, WT, n0, drow, sd, presc, par);
    }
    if (w_in0) { u32x4 z = {0u, 0u, 0u, 0u}; u32x4* p = (u32x4*)((signed char*)(F.ws + WS_WI0) + (size_t)EV_IN * 1024); const int gw = wg * NWAVES + F.wave, ngw = nwg * NWAVES;
        for (int i = gw * 64 + F.lane; i < (EV_INP - EV_IN) * 1024 / 16; i += ngw * 64) p[i] = z;
        if (gw == 0) F.SWD2()[EV_IN + F.lane] = 0.f; }
    __syncthreads();
}
constexpr int MOE_DEFER_GU = 3;
constexpr int MOE_DEFER_GU_OLD = 8;
__device__ __forceinline__ void p0_deferred(Frame& F, const float* w_gu1, const float* w_d1, int wg, int nwg) {
    LAS float* scr = (LAS float*)(F.lds + F.wave * 16384);
    const int gw = wg * NWAVES + F.wave, ngw = nwg * NWAVES; int base = 0;
    for (int e = 0; e < NEXP; ++e) base = p0_matrix(F, w_d1 + (size_t)e * EXD * 1024, EXD, 1024, (bf16_t*)(F.ws + WS_WD1) + (size_t)e * 1024 * EXD, 0, base, scr, 1.f, 0, gw, ngw);
    __syncthreads();
}
__device__ __forceinline__ void p0_deferred_gu(Frame& F, const float* w_gu1, int e0, int e1, int wg, int nwg, const float* w_in0 = nullptr, const float* w_gu0 = nullptr, const float* w_in1 = nullptr) {
    if (I8_STRIP) { p0_strips(F, wg, nwg, w_in0, w_gu0, w_in1, w_gu1, e0, e1); return; }
    LAS float* scr = (LAS float*)(F.lds + F.wave * 16384);
    const int gw = wg * NWAVES + F.wave, ngw = nwg * NWAVES; int base = 0;
    if (w_in0) {
        unsigned* sm = F.ctl + CW_SWMAX2; float* sd = F.SWD2();
        if (I8_WIN0) base = p0_matrix_i8(F, w_in0, 1024, EV_IN, (signed char*)(F.ws + WS_WI0), 0, base, scr, sm, sd, gw, ngw);
        if (I8_GU0) base = p0_matrix_i8(F, w_gu0, 1024, 2 * FFN, (signed char*)(F.ws + WS_WGU0), FFN, base, scr, sm + EV_IN, sd + EV_INP, gw, ngw);
        if (I8_WIN1) base = p0_matrix_i8(F, w_in1, 1024, OD_IN, (signed char*)(F.ws + WS_WI1), 0, base, scr, sm + EV_IN + 2 * FFN, sd + EV_INP + 2 * FFN, gw, ngw, ATT_C64, 512);
        if (I8_WIN0) { u32x4 z = {0u, 0u, 0u, 0u}; u32x4* p = (u32x4*)((signed char*)(F.ws + WS_WI0) + (size_t)EV_IN * 1024);
          for (int i = gw * 64 + F.lane; i < (EV_INP - EV_IN) * 1024 / 16; i += ngw * 64) p[i] = z;
          if (gw == 0) sd[EV_IN + F.lane] = 0.f; } }
    for (int e = e0; e < e1; ++e) base = p0_matrix_i8(F, w_gu1 + (size_t)e * 1024 * 2 * EXD, 1024, 2 * EXD, (signed char*)(F.ws + WS_WGU1) + (size_t)e * 2 * EXD * 1024, EXD, base, scr, F.ctl + CW_SWMAX + e * (2 * EXD), F.SWD() + e * (2 * EXD), gw, ngw);
    __syncthreads();
}
__device__ __forceinline__ void p0_prologue(Frame& F, const ProIn I) {
    LAS float* scr = (LAS float*)(F.lds + F.wave * 16384);
    unsigned char* ws = F.ws;
    int base = 0;
    if (I8_STRIP) p0_strips(F, (int)blockIdx.x, F.G, I.w_in0, I.w_gu0, I.w_in1, I.w_gu1, 0, MOE_DEFER_GU);
    if (!I8_WIN0) base = p0_matrix(F, I.w_in0, 1024, EV_IN, (bf16_t*)(ws + WS_WI0), 0, base, scr);
    if (!I8_GU0) base = p0_matrix(F, I.w_gu0, 1024, 2 * FFN, (bf16_t*)(ws + WS_WGU0), FFN, base, scr);
    if (!I8_WIN1) base = p0_matrix(F, I.w_in1, 1024, OD_IN, (bf16_t*)(ws + WS_WI1), 0, base, scr, ATT_C64, 512);
    if (!I8_WIN0) { u32x4 z = {0u, 0u, 0u, 0u}; u32x4* p = (u32x4*)((bf16_t*)(ws + WS_WI0) + (size_t)EV_IN * 1024); for (int i = F.gw * 64 + F.lane; i < (EV_INP - EV_IN) * 1024 / 8; i += F.NGW * 64) p[i] = z; }
    base = p0_matrix(F, I.w_uq, 384, 768, (bf16_t*)(ws + WS_WUQ), 0, base, scr, ATT_C96, 768);
    base = p0_matrix(F, I.w_ukv, 256, 1024, (bf16_t*)(ws + WS_WUKV), 0, base, scr);
    base = p0_matrix(F, I.w_out0, 1024, 1024, (bf16_t*)(ws + WS_WO0), 0, base, scr);
    base = p0_matrix(F, I.w_d0, FFN, 1024, (bf16_t*)(ws + WS_WD0), 0, base, scr);
    base = p0_matrix(F, I.w_out1, 1024, 1024, (bf16_t*)(ws + WS_WO1), 0, base, scr);
    if (!I8_STRIP) for (int e = 0; e < NEXP; ++e) base = p0_absmax(F, I.w_gu1 + (size_t)e * 1024 * 2 * EXD, 1024, 2 * EXD, F.ctl + CW_SWMAX + e * (2 * EXD), base);
    if (!I8_STRIP) { base = p0_absmax(F, I.w_in0, 1024, EV_IN, F.ctl + CW_SWMAX2, base); } if (!I8_STRIP) base = p0_absmax(F, I.w_gu0, 1024, 2 * FFN, F.ctl + CW_SWMAX2 + EV_IN, base); if (!I8_STRIP) base = p0_absmax(F, I.w_in1, 1024, OD_IN, F.ctl + CW_SWMAX2 + EV_IN + 2 * FFN, base);
    if (blockIdx.x == F.G - 1) {
        for (int i = F.tid; i < 128 * 8; i += NTHREADS) { const int pos = i >> 3, f = i & 7; const float inv = 1.0f / powf(10000.0f, (float)f / 8.0f); const float a = (float)pos * inv; F.TAB8()[i] = cosf(a); F.TAB8()[1024 + i] = sinf(a); }
        for (int i = F.tid; i < 128 * 16; i += NTHREADS) { const int pos = i >> 4, f = i & 15; const float inv = 1.0f / powf(10000.0f, (float)f / 16.0f); const float a = (float)pos * inv; F.TAB16()[i] = cosf(a); F.TAB16()[2048 + i] = sinf(a); }
    }
    __syncthreads();
    if ((int)blockIdx.x < 192) {
        LAS float* sc = (LAS float*)F.lds;
        LAS float* red = (LAS float*)(F.lds + 40960);
        for (int i = F.tid; i < 9 * 1024; i += NTHREADS) { const int r = i >> 10, k = i & 1023; const float v = (r < 8) ? I.c[r * 1024 + k] : I.c_ctx[k]; sc[i] = silu_f(v); }
        __syncthreads();
        const int layer = blockIdx.x / 96, n0 = (blockIdx.x % 96) * 64;
        const float* w = I.mod_w + (size_t)layer * 1024 * MOD_ROW + n0 + F.lane;
        float acc[9];
#pragma unroll
        for (int r = 0; r < 9; ++r) acc[r] = 0.f;
        const int kb = F.wave * 128;
#pragma unroll 8
        for (int k = 0; k < 128; ++k) { const float wv = w[(size_t)(kb + k) * MOD_ROW];
#pragma unroll
            for (int r = 0; r < 9; ++r) acc[r] += sc[r * 1024 + kb + k] * wv; }
#pragma unroll
        for (int r = 0; r < 9; ++r) red[(F.wave * 9 + r) * 64 + F.lane] = acc[r];
        __syncthreads();
        for (int i = F.tid; i < 9 * 64; i += NTHREADS) { const int r = i >> 6, l = i & 63; float s = I.mod_b[layer * MOD_ROW + n0 + l];
#pragma unroll
            for (int wv = 0; wv < 8; ++wv) s += red[(wv * 9 + r) * 64 + l];
            F.MOD()[((size_t)layer * 9 + r) * MOD_ROW + n0 + l] = s; }
    }
}

template <bool SRC_IN, bool ROUTER, bool OUT8 = true>
__device__ __forceinline__ void norm_pass(Frame& F, int grp, int layer, int which, const float* norm_g, const float* xin, const float* ctxin, const float* router_w, const float* part = nullptr, const int nslice = 0, const int gidx = 0, const float* gmod = nullptr, const bool dry = false) {
    const float* gain = norm_g + (size_t)(layer * 2 + which) * DM;
    const float* mod = F.MOD() + (size_t)layer * 9 * MOD_ROW;
    LAS float* rw = (LAS float*)F.lds;
    LAS unsigned* lcnt = (LAS unsigned*)(F.lds + 32768);
    if constexpr (ROUTER) { for (int i = F.tid; i < 1024 * 8; i += NTHREADS) rw[i] = router_w[i]; if (F.tid < 8) lcnt[F.tid] = 0u; __syncthreads(); }
    constexpr int RPW = (RROWS + 2047) / 2048;
    const int rpw = (RROWS + F.NGW - 1) / F.NGW; (void)RPW;
    const int r0 = F.gw * rpw, r1 = (r0 + rpw < RROWS) ? r0 + rpw : RROWS;
    f32x4 pg[4], psc[4], psh[4]; int cur = -1;
#pragma unroll
    for (int j = 0; j < 4; ++j) pg[j] = *(const f32x4*)(gain + 4 * F.lane + 256 * j);
    f32x4 nf[4]; u32x2 nb[4]; bool have = false;
#define NP_ISSUE(rr) do { int bl_, t_; row_bt((rr), bl_, t_); if (t_ >= CTXL) { have = true; \
        if constexpr (SRC_IN) { const float* s_ = xin + ((size_t)(grp * GB + bl_) * SEQ + (t_ - CTXL)) * DM + 4 * F.lane; _Pragma("unroll") for (int j = 0; j < 4; ++j) nf[j] = *(const f32x4*)(s_ + 256 * j); } \
        else { const bf16_t* s_ = F.X16() + ((size_t)bl_ * SEQ + (t_ - CTXL)) * DM + 4 * F.lane; _Pragma("unroll") for (int j = 0; j < 4; ++j) nb[j] = *(const u32x2*)(s_ + 256 * j); } } } while (0)
    if (r0 < r1) NP_ISSUE(r0);
    for (int r = r0; r < r1; ++r) {
        int bl, t; row_bt(r, bl, t); const int b = grp * GB + bl; const bool isctx = t < CTXL;
        f32x4 v[4]; const bool pre = have;
        if (pre) {
#pragma unroll
            for (int j = 0; j < 4; ++j) { if constexpr (SRC_IN) v[j] = nf[j]; else v[j] = (f32x4){bflo(nb[j].x), bfhi(nb[j].x), bflo(nb[j].y), bfhi(nb[j].y)}; } }
        have = false; if (r + 1 < r1) NP_ISSUE(r + 1);
        if (ROUTER && isctx) continue;
        const int mrow = isctx ? 8 : b;
        if (mrow != cur) { cur = mrow;
#pragma unroll
            for (int j = 0; j < 4; ++j) { psh[j] = *(const f32x4*)(mod + mrow * MOD_ROW + (which ? 3 : 0) * DM + 4 * F.lane + 256 * j); psc[j] = *(const f32x4*)(mod + mrow * MOD_ROW + (which ? 4 : 1) * DM + 4 * F.lane + 256 * j); } }
        const float* src = nullptr; float* dst = nullptr; bf16_t* x16 = F.X16() + ((size_t)bl * SEQ + (t - CTXL)) * DM;
        if (isctx) { dst = F.CX() + ((size_t)b * CTXL + t) * DM; src = SRC_IN ? ctxin + ((size_t)b * CTXL + t) * DM : dst; }
        else if (SRC_IN) src = xin + ((size_t)b * SEQ + (t - CTXL)) * DM;
        float s = 0.f;
        if (!pre) {
#pragma unroll
            for (int j = 0; j < 4; ++j) v[j] = *(const f32x4*)(src + 4 * F.lane + 256 * j); }
        if (part != nullptr && isctx) {
            const float* pr = part + ((size_t)bl * CTXL + t) * DM + 4 * F.lane;
#pragma unroll
            for (int j = 0; j < 4; ++j) { f32x4 a = *(const f32x4*)(pr + 256 * j);
                for (int sl = 1; sl < nslice; ++sl) a = a + *(const f32x4*)(pr + (size_t)sl * (GB * CTXL) * DM + 256 * j);
                v[j] = v[j] + a * *(const f32x4*)(gmod + 8 * MOD_ROW + gidx * DM + 4 * F.lane + 256 * j); *(f32x4*)(dst + 4 * F.lane + 256 * j) = v[j]; } }
#pragma unroll
        for (int j = 0; j < 4; ++j) s += (v[j].x * v[j].x + v[j].y * v[j].y) + (v[j].z * v[j].z + v[j].w * v[j].w);
        if constexpr (SRC_IN) {
            if (isctx) {
#pragma unroll
                for (int j = 0; j < 4; ++j) *(f32x4*)(dst + 4 * F.lane + 256 * j) = v[j];
            } else {
#pragma unroll
                for (int j = 0; j < 4; ++j) { u32x2 w; w.x = pk2(v[j].x, v[j].y); w.y = pk2(v[j].z, v[j].w); *(u32x2*)(x16 + 4 * F.lane + 256 * j) = w; } } }
        const float rstd = rsq_f(wave_sum(s, F.lane) * (1.0f / DM) + NORM_EPS);
#pragma unroll
        for (int j = 0; j < 4; ++j) v[j] = (v[j] * rstd) * pg[j] * (psc[j] + 1.0f) + psh[j];
        if constexpr (!OUT8) {
#pragma unroll
            for (int j = 0; j < 4; ++j) { u32x2 w; w.x = pk2(v[j].x, v[j].y); w.y = pk2(v[j].z, v[j].w); *(u32x2*)(F.HB() + (size_t)r * DM + 4 * F.lane + 256 * j) = w; }
        } else {
            float mx = 0.f;
#pragma unroll
            for (int j = 0; j < 4; ++j) mx = fmaxf(fmaxf(fmaxf(mx, fabsf(v[j].x)), fabsf(v[j].y)), fmaxf(fabsf(v[j].z), fabsf(v[j].w)));
            mx = red_max<64>(mx);
            const float inv = mx > 0.f ? 127.0f / mx : 0.f; signed char* h8 = (signed char*)F.HB() + (size_t)r * DM;
#pragma unroll
            for (int j = 0; j < 4; ++j) { const int b0 = (int)rintf(v[j].x * inv), b1 = (int)rintf(v[j].y * inv), b2 = (int)rintf(v[j].z * inv), b3 = (int)rintf(v[j].w * inv);
                *(unsigned*)(h8 + 4 * F.lane + 256 * j) = (unsigned)(b0 & 0xff) | ((unsigned)(b1 & 0xff) << 8) | ((unsigned)(b2 & 0xff) << 16) | ((unsigned)(b3 & 0xff) << 24); }
            if (F.lane == 0 && !dry) F.SATOK()[r] = mx * (1.0f / 127.0f); }
        if constexpr (ROUTER) {
            float lg[8];
#pragma unroll
            for (int e = 0; e < 8; ++e) lg[e] = 0.f;
#pragma unroll
            for (int j = 0; j < 4; ++j)
#pragma unroll
                for (int q = 0; q < 4; ++q) { const int col = 4 * F.lane + 256 * j + q; const f32x4 wa = *(const LAS f32x4*)(rw + col * 8), wb = *(const LAS f32x4*)(rw + col * 8 + 4); const float hv = v[j][q];
                    lg[0] += hv * wa.x; lg[1] += hv * wa.y; lg[2] += hv * wa.z; lg[3] += hv * wa.w; lg[4] += hv * wb.x; lg[5] += hv * wb.y; lg[6] += hv * wb.z; lg[7] += hv * wb.w; }
#pragma unroll
            for (int e = 0; e < 8; ++e) lg[e] = wave_sum(lg[e], F.lane);
            int e0 = 0; float l0 = lg[0];
#pragma unroll
            for (int e = 1; e < 8; ++e) if (lg[e] > l0) { l0 = lg[e]; e0 = e; }
            int e1 = -1; float l1 = -3.0e38f;
#pragma unroll
            for (int e = 0; e < 8; ++e) if (e != e0 && lg[e] > l1) { l1 = lg[e]; e1 = e; }
            if (F.lane == 0 && !dry) { const int tok = bl * SEQ + (t - CTXL); const float w1 = 1.0f / (1.0f + __expf(l0 - l1)), w0 = 1.0f - w1;
                F.TOPE()[tok * 2] = e0; F.TOPE()[tok * 2 + 1] = e1; F.TOPW()[tok * 2] = w0; F.TOPW()[tok * 2 + 1] = w1;
                F.SLOT()[tok * 2] = (int)__hip_atomic_fetch_add(lcnt + e0, 1u, __ATOMIC_RELAXED, __HIP_MEMORY_SCOPE_WORKGROUP); F.SLOT()[tok * 2 + 1] = (int)__hip_atomic_fetch_add(lcnt + e1, 1u, __ATOMIC_RELAXED, __HIP_MEMORY_SCOPE_WORKGROUP); }
        }
    }
#undef NP_ISSUE
    if constexpr (ROUTER) if (!dry) { __syncthreads();
        if (F.tid < 8) { const unsigned c = lcnt[F.tid]; const unsigned base = __hip_atomic_fetch_add(F.ctl + CW_CNT + grp * 64 + F.tid, c, RLX_AGENT); F.ctl[CW_WGB + (grp * 256 + (F.gw >> 3)) * 8 + F.tid] = base; } }
}

__device__ __forceinline__ void fix_even(Frame& F, const float* qn, const float* kvn, const float* cw, const float* alog, const float* dtb, const int conv_reps, const bool dry = false) {
    LAS float* cwl = (LAS float*)F.lds;
    for (int i = F.tid; i < 5 * 1536; i += NTHREADS) cwl[i] = cw[i];
    __syncthreads();
    const int rpw = (RROWS + F.NGW - 1) / F.NGW, r0w = F.gw * rpw, r1w = (r0w + rpw < RROWS) ? r0w + rpw : RROWS;
    unsigned win[5][12];
    for (int r = r0w; r < r1w; ++r) {
        int bl, t; row_bt(r, bl, t); const bool isctx = t < CTXL;
        bf16_t* prow = F.PB() + (size_t)r * EV_INP;
        { unsigned w[3]; float s = 0.f;
#pragma unroll
          for (int j = 0; j < 3; ++j) { w[j] = *(const unsigned*)(prow + PC_CQ + 2 * (F.lane + 64 * j)); const float a = bflo(w[j]), b2 = bfhi(w[j]); s += a * a + b2 * b2; }
          const float rstd = rsq_f(wave_sum(s, F.lane) * (1.0f / 384.0f) + NORM_EPS);
#pragma unroll
          for (int j = 0; j < 3; ++j) { const int c = 2 * (F.lane + 64 * j); if (!dry) *(unsigned*)(prow + PC_CQ + c) = pk2(bflo(w[j]) * rstd * qn[c], bfhi(w[j]) * rstd * qn[c + 1]); } }
        { unsigned w[2]; float s = 0.f;
#pragma unroll
          for (int j = 0; j < 2; ++j) { w[j] = *(const unsigned*)(prow + PC_CKV + 2 * (F.lane + 64 * j)); const float a = bflo(w[j]), b2 = bfhi(w[j]); s += a * a + b2 * b2; }
          const float rstd = rsq_f(wave_sum(s, F.lane) * (1.0f / 256.0f) + NORM_EPS);
#pragma unroll
          for (int j = 0; j < 2; ++j) { const int c = 2 * (F.lane + 64 * j); if (!dry) *(unsigned*)(prow + PC_CKV + c) = pk2(bflo(w[j]) * rstd * kvn[c], bfhi(w[j]) * rstd * kvn[c + 1]); } }
        { const int i = F.lane & 31; const float v = bf2f(prow[PC_KPE + i]); const float pv = sx(v, 8, F.lane); float o = v;
          if (!isctx) { const int tl = t - CTXL; const int pos = (i >> 4) ? (tl & 63) : (tl >> 6); const int f = i & 7; const float cs = F.TAB8()[pos * 8 + f], sn = F.TAB8()[1024 + pos * 8 + f];
              o = (i & 8) ? (v * cs + pv * sn) : (v * cs - pv * sn); }
          if (F.lane < 32) F.KPE()[(size_t)r * 32 + i] = (bf16_t)f2bf(o); }
        if (F.lane < 16) { const float a = bf2f(prow[PC_A + F.lane]), bb = bf2f(prow[PC_B + F.lane]); const float xx = a + dtb[F.lane];
            const float sp = (xx > 20.f) ? xx : __logf(1.0f + __expf(xx)); F.GG()[(size_t)r * 16 + F.lane] = -__expf(alog[F.lane]) * sp; F.GBT()[(size_t)r * 16 + F.lane] = __builtin_amdgcn_rcpf(1.0f + __expf(-bb)); }
        for (int crep = 0; crep < conv_reps; ++crep) { const int tlo = isctx ? 0 : CTXL, thi = isctx ? CTXL : TT;
          unsigned cwa = (unsigned)(uintptr_t)(const void*)cwl; asm volatile("" : "+v"(cwa)); const LAS float* cwr = (const LAS float*)(uintptr_t)cwa;
          float va[12], vb[12];
#pragma unroll
          for (int j = 0; j < 12; ++j) { va[j] = 0.f; vb[j] = 0.f; }
          if (r == r0w && crep == 0) {
#pragma unroll
              for (int k = 0; k < 4; ++k) { int rr = r + k - 2; rr = rr < 0 ? 0 : (rr >= RROWS ? RROWS - 1 : rr); const bf16_t* nrow = F.PB() + (size_t)rr * EV_INP + PC_GQKV;
#pragma unroll
                  for (int j = 0; j < 12; ++j) win[k][j] = *(const unsigned*)(nrow + 2 * (F.lane + 64 * j)); } }
          if (crep == 0) { int rr = r + 2; rr = rr >= RROWS ? RROWS - 1 : rr; const bf16_t* nrow = F.PB() + (size_t)rr * EV_INP + PC_GQKV;
#pragma unroll
              for (int j = 0; j < 12; ++j) win[4][j] = *(const unsigned*)(nrow + 2 * (F.lane + 64 * j)); }
#pragma unroll
          for (int k = 0; k < 5; ++k) { const int tk = t + k - 2; const float msk = (tk < tlo || tk >= thi) ? 0.f : 1.f;
#pragma unroll
              for (int j = 0; j < 12; ++j) { const int c = 2 * (F.lane + 64 * j); const unsigned w = win[k][j]; const f32x2 wk = *(const LAS f32x2*)(cwr + k * 1536 + c);
                  va[j] += bflo(w) * (wk.x * msk); vb[j] += bfhi(w) * (wk.y * msk); } }
#pragma unroll
          for (int j = 0; j < 12; ++j) { float a = silu_f(va[j]), b2 = silu_f(vb[j]);
              if (j < 8) { float s = a * a + b2 * b2;
                  s = red_sum<32>(s);
                  const float sc = (j < 4 ? 0.125f : 1.0f) * rsq_f(s + NORM_EPS); a *= sc; b2 *= sc; }
              bf16_t* dst = (j < 4) ? F.GQ() : (j < 8) ? F.GK() : F.GV();
              *(unsigned*)(dst + (size_t)r * 512 + (j & 3) * 128 + 2 * F.lane) = pk2(a, b2); } }
#pragma unroll
        for (int k = 0; k < 4; ++k)
#pragma unroll
            for (int j = 0; j < 12; ++j) win[k][j] = win[k + 1][j];
    }
}

__device__ __forceinline__ void q_rope(Frame& F, const bool dry = false) {
    for (int r = F.gw; r < RROWS; r += F.NGW) {
        int bl, t; row_bt(r, bl, t); if (t < CTXL) continue;
        const int tl = t - CTXL; const int h = F.lane >> 3, gq = F.lane & 7;
        bf16_t* p = F.QR() + (size_t)r * 768 + h * 96 + 64 + 4 * gq;
        const u32x2 w = *(const u32x2*)p; float v[4] = {bflo(w.x), bfhi(w.x), bflo(w.y), bfhi(w.y)}, o[4];
        const int pos = (gq & 4) ? (tl & 63) : (tl >> 6);
#pragma unroll
        for (int e = 0; e < 4; ++e) { const float pv = sx(v[e], 2, F.lane); const int f = 4 * (gq & 1) + e; const float cs = F.TAB8()[pos * 8 + f], sn = F.TAB8()[1024 + pos * 8 + f];
            o[e] = (gq & 2) ? (v[e] * cs + pv * sn) : (v[e] * cs - pv * sn); }
        u32x2 ow; ow.x = pk2(o[0], o[1]); ow.y = pk2(o[2], o[3]); *(u32x2*)p = dry ? w : ow;
    }
}

__device__ __forceinline__ void fix_odd(Frame& F, const float* gqn, const float* gkn, const int grp, const bool dry = false) {
    float kmx[2] = {0.f, 0.f};
    const int s16 = F.lane & 15, vq = F.lane >> 4;
    for (int rb = F.gw; rb < RROWS; rb += 2 * F.NGW) {
        u32x2 wv[2][7];
#pragma unroll
        for (int u = 0; u < 2; ++u) { const int r = (rb + u * F.NGW < RROWS) ? rb + u * F.NGW : rb; const bf16_t* prow = F.PB() + (size_t)r * OD_IN;
#pragma unroll
            for (int it = 0; it < 7; ++it) { const int v = it * 4 + vq; const bool act = v < 26;
                const int col = (v < 8) ? (P1_DQ + 64 * v) : (v < 16) ? (P1_DK + 64 * (v - 8)) : (v < 24) ? (P1_GQ + 64 * (v - 16)) : (P1_GK + 64 * (v - 24));
                wv[u][it] = *(const u32x2*)(prow + (act ? col : 0) + 4 * s16); } }
#pragma unroll
        for (int u = 0; u < 2; ++u) { const int r = rb + u * F.NGW; if (r >= RROWS) break;
            int bl, t; row_bt(r, bl, t); const bool isctx = t < CTXL; const int tl = t - CTXL;
            bf16_t* prow = F.PB() + (size_t)r * OD_IN;
            const int pos = (s16 & 8) ? (tl & 63) : (tl >> 6);
            float cs[4], sn[4];
#pragma unroll
            for (int e = 0; e < 4; ++e) { const int f = 4 * (s16 & 3) + e; cs[e] = isctx ? 1.f : F.TAB16()[pos * 16 + f]; sn[e] = isctx ? 0.f : F.TAB16()[2048 + pos * 16 + f]; if (!(s16 & 4)) sn[e] = -sn[e]; }
#pragma unroll
            for (int it = 0; it < 7; ++it) { const int v = it * 4 + vq; const bool act = v < 26;
                const int col = (v < 8) ? (P1_DQ + 64 * v) : (v < 16) ? (P1_DK + 64 * (v - 8)) : (v < 24) ? (P1_GQ + 64 * (v - 16)) : (P1_GK + 64 * (v - 24));
                bf16_t* p = prow + (act ? col : 0) + 4 * s16;
                const u32x2 w = wv[u][it]; float x[4] = {bflo(w.x), bfhi(w.x), bflo(w.y), bfhi(w.y)};
                if (it == 2 || it == 3) { float s = x[0] * x[0] + x[1] * x[1] + x[2] * x[2] + x[3] * x[3];
                    s = red_sum<16>(s);
                    kmx[it - 2] = fmaxf(kmx[it - 2], s); }
                if (v >= 16) { float s = x[0] * x[0] + x[1] * x[1] + x[2] * x[2] + x[3] * x[3];
                    s = red_sum<16>(s);
                    const float rstd = rsq_f(s * (1.0f / 64.0f) + NORM_EPS); const float* gn = (v < 24) ? gqn : gkn;
#pragma unroll
                    for (int e = 0; e < 4; ++e) x[e] = x[e] * (v < 24 ? rstd * ATT_C64 : rstd) * gn[4 * s16 + e]; }
                float o4[4];
#pragma unroll
                for (int e = 0; e < 4; ++e) { const float pu = dppf<0x104>(x[e]), pd = dppf<0x114>(x[e]); const float pv = (s16 & 4) ? pd : pu;
                    o4[e] = x[e] * cs[e] + pv * sn[e]; }
                if (act) { u32x2 ow; ow.x = pk2(o4[0], o4[1]); ow.y = pk2(o4[2], o4[3]); *(u32x2*)p = dry ? w : ow; }
            }
        }
    }
    { LAS float* red = (LAS float*)F.lds; const int vq = F.lane >> 4;
      if ((F.lane & 15) == 0) { red[F.wave * 8 + vq] = kmx[0]; red[F.wave * 8 + 4 + vq] = kmx[1]; }
      __syncthreads();
      if (F.tid < 8 && !dry) { float m = 0.f;
#pragma unroll
          for (int w = 0; w < 8; ++w) m = fmaxf(m, red[w * 8 + F.tid]);
          ((float*)(F.ctl + CW_KMAX))[(grp * 256 + (F.gw >> 3)) * 8 + F.tid] = m; }
      __syncthreads(); }
}

__device__ __forceinline__ void gdn_out(Frame& F, const float* on) {
    const int c0 = 8 * F.lane;
    float onv[8];
#pragma unroll
    for (int q = 0; q < 8; ++q) onv[q] = on[(c0 & 63) + q];
    for (int rb = F.gw; rb < RROWS; rb += 4 * F.NGW) {
        u32x4 a[4], b[4], z[4];
#pragma unroll
        for (int u = 0; u < 4; ++u) { const int r = rb + u * F.NGW; const size_t rr = r < RROWS ? r : 0;
            a[u] = *(const u32x4*)(F.OF() + rr * 512 + c0); b[u] = *(const u32x4*)(F.OB() + rr * 512 + c0); z[u] = *(const u32x4*)(F.PB() + rr * EV_INP + PC_Z + c0); }
#pragma unroll
        for (int u = 0; u < 4; ++u) { const int r = rb + u * F.NGW;
            float o[8]; float s = 0.f;
#pragma unroll
            for (int q = 0; q < 4; ++q) { o[2 * q] = bflo(a[u][q]) + bflo(b[u][q]); o[2 * q + 1] = bfhi(a[u][q]) + bfhi(b[u][q]); s += o[2 * q] * o[2 * q] + o[2 * q + 1] * o[2 * q + 1]; }
            s = red_sum<8>(s);
            const float rstd = rsq_f(s * (1.0f / 64.0f) + NORM_EPS);
            u32x4 w;
#pragma unroll
            for (int q = 0; q < 4; ++q) { const float y0 = o[2 * q] * rstd * onv[2 * q] * silu_f(bflo(z[u][q])), y1 = o[2 * q + 1] * rstd * onv[2 * q + 1] * silu_f(bfhi(z[u][q])); w[q] = pk2(y0, y1); }
            if (r < RROWS) *(u32x4*)(F.HB() + (size_t)r * DM + 512 + c0) = w; }
    }
}

__device__ __forceinline__ void diff_post(Frame& F, const float* lp, const float* dn) {
    const float lambda_init = 0.8f - 0.6f * expf(-0.3f);
    const float s1 = red_sum<64>(lp[F.lane] * lp[64 + F.lane]), s2 = red_sum<64>(lp[128 + F.lane] * lp[192 + F.lane]);
    const float lam = __expf(s1) - __expf(s2) + lambda_init;
    const int h = F.lane >> 4, j0 = 8 * (F.lane & 15);
    float dnv[8];
#pragma unroll
    for (int q = 0; q < 8; ++q) dnv[q] = dn[j0 + q];
    for (int rb = F.gw; rb < RROWS; rb += 4 * F.NGW) {
        u32x4 a[4], b[4]; bool ok[4];
#pragma unroll
        for (int u = 0; u < 4; ++u) { const int r = rb + u * F.NGW; int bl = 0, t = 0; ok[u] = r < RROWS; if (ok[u]) { row_bt(r, bl, t); ok[u] = t >= CTXL; }
            const bf16_t* od = F.KV() + (size_t)(ok[u] ? r : 0) * DM + h * 256 + j0; a[u] = *(const u32x4*)od; b[u] = *(const u32x4*)(od + 128); }
#pragma unroll
        for (int u = 0; u < 4; ++u) { const int r = rb + u * F.NGW;
            float d[8]; float s = 0.f;
#pragma unroll
            for (int q = 0; q < 4; ++q) { d[2 * q] = bflo(a[u][q]) - lam * bflo(b[u][q]); d[2 * q + 1] = bfhi(a[u][q]) - lam * bfhi(b[u][q]); s += d[2 * q] * d[2 * q] + d[2 * q + 1] * d[2 * q + 1]; }
            s = red_sum<16>(s);
            const float rstd = (1.0f - lambda_init) * rsq_f(s * (1.0f / 128.0f) + NORM_EPS);
            u32x4 w;
#pragma unroll
            for (int q = 0; q < 4; ++q) w[q] = pk2(d[2 * q] * rstd * dnv[2 * q], d[2 * q + 1] * rstd * dnv[2 * q + 1]);
            if (ok[u]) *(u32x4*)(F.HB() + (size_t)r * DM + h * 128 + j0) = w; }
    }
}

__device__ __forceinline__ void moe_tends(Frame& F, int grp) {
    if (F.tid < 8) { int c[8];
#pragma unroll
        for (int e = 0; e < 8; ++e) c[e] = (int)__hip_atomic_load(F.ctl + CW_CNT + grp * 64 + e, RLX_AGENT);
        int acc = 0, st = 0, en = 0;
#pragma unroll
        for (int e = 0; e < 8; ++e) { if (e == F.tid) st = acc; acc += (c[e] + 255) >> 8; if (e == F.tid) en = acc; }
        F.MISC[24 + F.tid] = (unsigned)(st * 256); F.MISC[16 + F.tid] = (unsigned)en; }
    __syncthreads();
}
__device__ __forceinline__ void moe_gather(Frame& F, int grp, const bool dry = false) {
    if (dry) return;
    const int rpw = (RROWS + F.NGW - 1) / F.NGW; const int r0 = F.gw * rpw, r1 = (r0 + rpw < RROWS) ? r0 + rpw : RROWS;
    const unsigned* wgb = F.ctl + CW_WGB + (grp * 256 + (F.gw >> 3)) * 8;
    float* ssc = (float*)((signed char*)F.XG() + (size_t)MOE_ROWS * DM); int* s2t = (int*)(ssc + MOE_ROWS);
    for (int rb = r0; rb < r1; rb += 64) { const int r = rb + F.lane;
        if (r < r1) { int bl, t; row_bt(r, bl, t);
            if (t >= CTXL) { const int tok = bl * SEQ + (t - CTXL); const float sat = F.SATOK()[r];
#pragma unroll
                for (int k = 0; k < 2; ++k) { const int e = F.TOPE()[tok * 2 + k]; const int row = (int)F.MISC[24 + e] + (int)wgb[e] + F.SLOT()[tok * 2 + k];
                    s2t[row] = r; ssc[row] = sat; F.SLOT()[tok * 2 + k] = row; } } } }
    if (F.gw < 64) { const int e = F.gw >> 3;
        const int start = (int)F.MISC[24 + e], cnt = (int)__hip_atomic_load(F.ctl + CW_CNT + grp * 64 + e, RLX_AGENT), end = (int)F.MISC[16 + e] * 256;
        for (int sidx = start + cnt + F.tid; sidx < end; sidx += NTHREADS) { s2t[sidx] = 0; ssc[sidx] = 0.f; } }
}
__device__ __forceinline__ void final_pass(Frame& F, int grp, const float* fn, const bool dry = false) {
    const float* mod = F.MOD() + (size_t)1 * 9 * MOD_ROW;
    f32x4 pf[4];
#pragma unroll
    for (int j = 0; j < 4; ++j) pf[j] = *(const f32x4*)(fn + 4 * F.lane + 256 * j);
    constexpr int U = 4;
    for (int tokb = F.gw; tokb < NTOK_G; tokb += U * F.NGW) {
        int s0[U], s1[U]; float w0[U], w1[U];
#pragma unroll
        for (int u = 0; u < U; ++u) { const int tok = (tokb + u * F.NGW < NTOK_G) ? tokb + u * F.NGW : tokb;
            s0[u] = F.SLOT()[tok * 2]; s1[u] = F.SLOT()[tok * 2 + 1]; w0[u] = F.TOPW()[tok * 2]; w1[u] = F.TOPW()[tok * 2 + 1]; }
        u32x2 xr[U][4], ya[U][4], yb[U][4];
#pragma unroll
        for (int u = 0; u < U; ++u) { const int tok = (tokb + u * F.NGW < NTOK_G) ? tokb + u * F.NGW : tokb; const int bl = tok / SEQ, tl = tok - bl * SEQ;
            const bf16_t* x16 = F.X16() + ((size_t)bl * SEQ + tl) * DM + 4 * F.lane; const bf16_t* y0 = F.XG() + (size_t)s0[u] * DM + 4 * F.lane; const bf16_t* y1 = F.XG() + (size_t)s1[u] * DM + 4 * F.lane;
#pragma unroll
            for (int j = 0; j < 4; ++j) { xr[u][j] = *(const u32x2*)(x16 + 256 * j); ya[u][j] = *(const u32x2*)(y0 + 256 * j); yb[u][j] = *(const u32x2*)(y1 + 256 * j); } }
#pragma unroll
        for (int u = 0; u < U; ++u) { const int tok = tokb + u * F.NGW; const bool okt = tok < NTOK_G; const int tk = okt ? tok : tokb;
            const int bl = tk / SEQ, tl = tk - bl * SEQ, b = grp * GB + bl;
            float* xrow = F.X + ((size_t)b * SEQ + tl) * DM; const float* gt = mod + b * MOD_ROW + 5 * DM;
            f32x4 v[4]; float s = 0.f;
#pragma unroll
            for (int j = 0; j < 4; ++j) { const int c = 4 * F.lane + 256 * j; const u32x2 xw = xr[u][j]; v[j] = (f32x4){bflo(xw.x), bfhi(xw.x), bflo(xw.y), bfhi(xw.y)}; const f32x4 g4 = *(const f32x4*)(gt + c);
                const u32x2 a = ya[u][j], bb = yb[u][j];
                v[j].x += g4.x * (w0[u] * bflo(a.x) + w1[u] * bflo(bb.x)); v[j].y += g4.y * (w0[u] * bfhi(a.x) + w1[u] * bfhi(bb.x));
                v[j].z += g4.z * (w0[u] * bflo(a.y) + w1[u] * bflo(bb.y)); v[j].w += g4.w * (w0[u] * bfhi(a.y) + w1[u] * bfhi(bb.y));
                s += (v[j].x * v[j].x + v[j].y * v[j].y) + (v[j].z * v[j].z + v[j].w * v[j].w); }
            const float rstd = rsq_f(wave_sum(s, F.lane) * (1.0f / DM) + NORM_EPS);
            if (okt && !dry) {
#pragma unroll
                for (int j = 0; j < 4; ++j) { const int c = 4 * F.lane + 256 * j; *(f32x4*)(xrow + c) = v[j] * rstd * pf[j]; } } }
    }
}

__device__ __forceinline__ void gdn_rows(int bl, int dir, int ci, int& row0, int& step) {
    int T, base, ip; if (ci < 4) { T = CTXL; base = 0; ip = ci; } else { T = SEQ; base = CTXL; ip = ci - 4; }
    row0 = bl * TT + (dir ? base + T - 1 - 64 * ip : base + 64 * ip); step = dir ? -1 : 1;
}
__device__ __forceinline__ float wave_incl_scan(float v, int lane) {
#pragma unroll
    for (int o = 1; o < 64; o <<= 1) { const float t = __builtin_bit_cast(float, __builtin_amdgcn_ds_bpermute((lane - o) << 2, __builtin_bit_cast(int, v))); if (lane >= o) v += t; }
    return v;
}
__device__ __forceinline__ void gdn_pre(Frame& F, const int bx) {
    const int team = F.wave >> 1, w2 = F.wave & 1, lane = F.lane, r32 = lane & 31, hi = lane >> 5, tt = F.tid & 127;
    LAS float* Lm = (LAS float*)(F.lds + team * 17408);
    LAS unsigned char* Kt = F.lds + 69632 + team * 16384; LAS unsigned char* Vt = Kt + 8192;
    LAS float* gcs = (LAS float*)(F.lds + LDSCTL_OFF + 1024 + F.wave * 512);
    int zv; asm volatile("v_mov_b32 %0, 0" : "=v"(zv));
    const LAS float* gcz = gcs + zv; const LAS float* Lz = Lm + zv;
    constexpr int NC = GB * 8 * 2 * NCHUNK;
    const int per_pass = F.G * 4, npass = (NC + per_pass - 1) / per_pass;
    for (int pass = 0; pass < npass; ++pass) {
        const int q = pass * per_pass + bx * 4 + team; const bool active = q < NC;
        const int qq = active ? q : 0; const int ci = qq % NCHUNK, rest = qq / NCHUNK, dir = rest & 1, h = (rest >> 1) & 7, bl = rest >> 4;
        int row0, step; gdn_rows(bl, dir, ci, row0, step);
        unsigned char* out = F.GPRE() + (size_t)qq * GPRE_CHUNK;
        { u32x4 tk[4], tv[4];
#pragma unroll
          for (int i = 0; i < 4; ++i) { const int p = tt + 128 * i, row = p >> 3, ch = p & 7; const size_t rr = (size_t)(row0 + step * row) * 512 + h * 64 + ch * 8; tk[i] = *(const u32x4*)(F.GK() + rr); tv[i] = *(const u32x4*)(F.GV() + rr); }
#pragma unroll
          for (int i = 0; i < 4; ++i) { const int p = tt + 128 * i, row = p >> 3, ch = p & 7; *(LAS u32x4*)(Kt + att::kswz<128>(row, ch * 16)) = tk[i]; *(LAS u32x4*)(Vt + row * 128 + ch * 16) = tv[i]; } }
        { const size_t rr = (size_t)(row0 + step * lane) * 16 + dir * 8 + h; const float g = F.GG()[rr], bt = F.GBT()[rr]; const float gc = wave_incl_scan(g, lane); gcs[lane] = gc; gcs[64 + lane] = bt; if (w2 == 0 && active) F.GCB()[(size_t)qq * 64 + lane] = gc; }
        __syncthreads();
        { bf16x8 Af[2][4], Bf[2][4];
#pragma unroll
          for (int bi = 0; bi < 2; ++bi)
#pragma unroll
              for (int ks = 0; ks < 4; ++ks) { Bf[bi][ks] = *(const LAS bf16x8*)(Kt + att::kswz<128>(32 * bi + r32, (16 * ks + 8 * hi) * 2));
                  if (w2) Af[bi][ks] = *(const bf16x8*)(F.GQ() + (size_t)(row0 + step * (32 * bi + r32)) * 512 + h * 64 + 8 * hi + 16 * ks); else Af[bi][ks] = Bf[bi][ks]; }
          f32x16 acc[2][2];
#pragma unroll
          for (int bi = 0; bi < 2; ++bi)
#pragma unroll
              for (int bj = 0; bj < 2; ++bj) { acc[bi][bj] = f32x16{};
#pragma unroll
                  for (int ks = 0; ks < 4; ++ks) acc[bi][bj] = __builtin_amdgcn_mfma_f32_32x32x16_bf16(Af[bi][ks], Bf[bj][ks], acc[bi][bj], 0, 0, 0); }
          const int thr = w2 ? 0 : 1; int r32p = r32, hip = hi; asm volatile("" : "+v"(r32p), "+v"(hip));
#pragma unroll
          for (int bi = 0; bi < 2; ++bi)
#pragma unroll
              for (int bj = 0; bj < 2; ++bj) { const int s = 32 * bj + r32p; const float gs = gcs[s];
#pragma unroll
                  for (int r = 0; r < 16; ++r) { const int c = 32 * bi + (r & 3) + 8 * (r >> 2) + 4 * hip; const float gcc = gcs[c];
                      const float v = acc[bi][bj][r] * __expf(fminf(gcc - gs, 0.f)); const int keep = ~((c - s - thr) >> 31);
                      acc[bi][bj][r] = __builtin_bit_cast(float, __builtin_bit_cast(int, v) & keep); } }
          if (w2 == 0) {
#pragma unroll
              for (int bi = 0; bi < 2; ++bi)
#pragma unroll
                  for (int bj = 0; bj < 2; ++bj)
#pragma unroll
                      for (int r = 0; r < 16; ++r) { const int c = 32 * bi + (r & 3) + 8 * (r >> 2) + 4 * hi; Lm[(32 * bj + r32) * 68 + c] = acc[bi][bj][r] * gcs[64 + c]; }
          } else if (active) {
              bf16_t* qo = (bf16_t*)(out + 8192) + (4 * hi) * 64 + r32;
#pragma unroll
              for (int bi = 0; bi < 2; ++bi)
#pragma unroll
                  for (int bj = 0; bj < 2; ++bj)
#pragma unroll
                      for (int r = 0; r < 16; ++r) qo[(32 * bi + (r & 3) + 8 * (r >> 2)) * 64 + 32 * bj] = (bf16_t)f2bf(acc[bi][bj][r]);
          } }
        __syncthreads();
        { float x[64];
#pragma unroll
          for (int c = 0; c < 64; ++c) x[c] = gcz[64 + c];
          if (w2) {
#pragma unroll
              for (int c = 0; c < 64; ++c) x[c] *= bf2f(*(const LAS bf16_t*)(Kt + c * 128 + ((lane * 2) ^ (((c >> 1) & 7) << 4)))) * __expf(gcz[c]);
          } else {
#pragma unroll
              for (int c = 0; c < 64; ++c) x[c] *= bf2f(*(const LAS bf16_t*)(Vt + c * 128 + lane * 2));
          }
          const unsigned lza = (unsigned)(uintptr_t)(const void*)Lm + (unsigned)zv;
#define PRE_LD(dst, off) asm volatile("ds_read_b128 %0, %1 offset:%2" : "=v"(dst) : "v"(lza), "i"(off))
#define PRE_PIN(i) asm volatile("" : "+v"(x[(i)]), "+v"(x[(i) + 1]), "+v"(x[(i) + 2]), "+v"(x[(i) + 3]))
#define PRE_W4(n, a0, a1, a2, a3) asm volatile("s_waitcnt lgkmcnt(" #n ")" : "+v"(a0), "+v"(a1), "+v"(a2), "+v"(a3))
#pragma unroll
          for (int s4 = 0; s4 < 16; ++s4) { const int s0 = 4 * s4;
              f32x4 A0, A1, A2, A3, B0, B1, B2, B3;
              { f32x4 t0, t1, t2, t3; PRE_LD(t0, ((s0 + 0) * 68 + s0) * 4); PRE_LD(t1, ((s0 + 1) * 68 + s0) * 4); PRE_LD(t2, ((s0 + 2) * 68 + s0) * 4); t3 = t2;
                if (s4 + 1 < 16) { PRE_LD(A0, ((s0 + 0) * 68 + s0 + 4) * 4); PRE_LD(A1, ((s0 + 1) * 68 + s0 + 4) * 4); PRE_LD(A2, ((s0 + 2) * 68 + s0 + 4) * 4); PRE_LD(A3, ((s0 + 3) * 68 + s0 + 4) * 4); PRE_W4(4, t0, t1, t2, t3); }
                else PRE_W4(0, t0, t1, t2, t3);
                x[s0 + 1] -= t0.y * x[s0];
                x[s0 + 2] -= t0.z * x[s0]; x[s0 + 2] -= t1.z * x[s0 + 1];
                x[s0 + 3] -= t0.w * x[s0]; x[s0 + 3] -= t1.w * x[s0 + 1]; x[s0 + 3] -= t2.w * x[s0 + 2]; PRE_PIN(s0); }
#pragma unroll
              for (int r4 = s4 + 1; r4 < 16; ++r4) { const int r0 = 4 * r4; const bool useA = ((r4 - s4) & 1) != 0, more = r4 + 1 < 16;
                  if (useA) { if (more) { PRE_LD(B0, ((s0 + 0) * 68 + r0 + 4) * 4); PRE_LD(B1, ((s0 + 1) * 68 + r0 + 4) * 4); PRE_LD(B2, ((s0 + 2) * 68 + r0 + 4) * 4); PRE_LD(B3, ((s0 + 3) * 68 + r0 + 4) * 4); PRE_W4(4, A0, A1, A2, A3); } else PRE_W4(0, A0, A1, A2, A3);
#pragma unroll
                      for (int e = 0; e < 4; ++e) { float a = x[r0 + e]; a -= A0[e] * x[s0]; a -= A1[e] * x[s0 + 1]; a -= A2[e] * x[s0 + 2]; a -= A3[e] * x[s0 + 3]; x[r0 + e] = a; } PRE_PIN(r0); }
                  else { if (more) { PRE_LD(A0, ((s0 + 0) * 68 + r0 + 4) * 4); PRE_LD(A1, ((s0 + 1) * 68 + r0 + 4) * 4); PRE_LD(A2, ((s0 + 2) * 68 + r0 + 4) * 4); PRE_LD(A3, ((s0 + 3) * 68 + r0 + 4) * 4); PRE_W4(4, B0, B1, B2, B3); } else PRE_W4(0, B0, B1, B2, B3);
#pragma unroll
                      for (int e = 0; e < 4; ++e) { float a = x[r0 + e]; a -= B0[e] * x[s0]; a -= B1[e] * x[s0 + 1]; a -= B2[e] * x[s0 + 2]; a -= B3[e] * x[s0 + 3]; x[r0 + e] = a; } PRE_PIN(r0); } } }
#undef PRE_LD
#undef PRE_W4
#undef PRE_PIN
          if (active) { bf16_t* dst = (bf16_t*)(out + (w2 ? 0 : 16384)) + lane; const float sg = w2 ? -1.f : 1.f;
#pragma unroll
              for (int c = 0; c < 64; ++c) dst[c * 64] = (bf16_t)f2bf(sg * x[c]); } }
        __syncthreads();
    }
}

constexpr int GS_WM = 0, GS_QK = 9216, GS_Q = 18432, GS_K = 27648, GS_U = 36864, GS_GC = 45056, GS_EG = 45312, GS_ED = 45568, GS_BUF = 46080, GS_OUT = 2 * 46080;
typedef short v4i16_t __attribute__((ext_vector_type(4)));
__device__ __forceinline__ bf16x8 gs_ldA(const LAS unsigned char* m, int row, int ks, int g) {
    return *(const LAS bf16x8*)(m + row * 144 + (32 * ks + 8 * g) * 2);
}
__device__ __forceinline__ bf16x8 gs_ldKT(const LAS unsigned char* km, int mt, int ks, int g, int i16) {
    const int q = i16 >> 2, p = i16 & 3;
    const LAS unsigned char* a0 = km + (32 * ks + 4 * g + q) * 144 + (16 * mt + 4 * p) * 2;
    const s16x4 lo = __builtin_bit_cast(s16x4, __builtin_amdgcn_ds_read_tr16_b64_v4i16((LAS v4i16_t*)a0));
    const s16x4 hi = __builtin_bit_cast(s16x4, __builtin_amdgcn_ds_read_tr16_b64_v4i16((LAS v4i16_t*)(a0 + 16 * 144)));
    return (bf16x8){lo[0], lo[1], lo[2], lo[3], hi[0], hi[1], hi[2], hi[3]};
}
__device__ __forceinline__ bf16x8 gs_pack(const f32x4 a, const f32x4 b) { const u32x4 w = {cvt_pk_bf16(a[0], a[1]), cvt_pk_bf16(a[2], a[3]), cvt_pk_bf16(b[0], b[1]), cvt_pk_bf16(b[2], b[3])}; return __builtin_bit_cast(bf16x8, w); }
__device__ __forceinline__ void gdn_scan(Frame& F, int chain) {
    const int dir = chain & 1, h = (chain >> 1) & 7, bl = chain >> 4;
    const int lane = F.lane, n = lane & 15, g = lane >> 4, wq = F.wave;
    if (F.wave >= 4) {
        const int lt = F.tid - 256;
        struct LSet { u32x4 t[10]; float graw; } A, B;
#define GS_ISSUE(X, ci_) do { const int ci2 = (ci_); if (ci2 < NCHUNK) { int row0, step; gdn_rows(bl, dir, ci2, row0, step); \
        const unsigned char* gp = F.GPRE() + (size_t)(chain * NCHUNK + ci2) * GPRE_CHUNK; \
        _Pragma("unroll") for (int i = 0; i < 2; ++i) { const int p = lt + 256 * i, row = p >> 3, pc = p & 7; \
            X.t[i] = *(const u32x4*)(gp + row * 128 + pc * 16); X.t[2 + i] = *(const u32x4*)(gp + 8192 + row * 128 + pc * 16); X.t[4 + i] = *(const u32x4*)(gp + 16384 + row * 128 + pc * 16); \
            const size_t rr = (size_t)(row0 + step * row) * 512 + h * 64 + pc * 8; X.t[6 + i] = *(const u32x4*)(F.GQ() + rr); X.t[8 + i] = *(const u32x4*)(F.GK() + rr); } \
        X.graw = (lt < 64) ? F.GCB()[(size_t)(chain * NCHUNK + ci2) * 64 + lt] : 0.f; } } while (0)
#define GS_PERM(base, row, pc, v) do { const int pos_ = ((pc) >> 2) * 32 + ((pc) & 1) * 16 + (((pc) & 2) ? 4 : 0); LAS unsigned char* d_ = (base) + (row) * 144 + pos_ * 2; \
        *(LAS u32x2*)d_ = (u32x2){(v).x, (v).y}; *(LAS u32x2*)(d_ + 16) = (u32x2){(v).z, (v).w}; } while (0)
#define GS_WRITE(X, ci_) do { const int ci2 = (ci_); if (ci2 < NCHUNK) { LAS unsigned char* buf = F.lds + (ci2 & 1) * GS_BUF; \
        _Pragma("unroll") for (int i = 0; i < 2; ++i) { const int p = lt + 256 * i, row = p >> 3, pc = p & 7; \
            GS_PERM(buf + GS_WM, row, pc, X.t[i]); GS_PERM(buf + GS_QK, row, pc, X.t[2 + i]); *(LAS u32x4*)(buf + GS_U + row * 128 + pc * 16) = X.t[4 + i]; \
            GS_PERM(buf + GS_Q, row, pc, X.t[6 + i]); *(LAS u32x4*)(buf + GS_K + row * 144 + pc * 16) = X.t[8 + i]; } \
        if (lt < 64) { const float gcv = X.graw; const float gl = __builtin_bit_cast(float, __builtin_amdgcn_readlane(__builtin_bit_cast(int, gcv), 63)); \
            ((LAS float*)(buf + GS_GC))[lt] = gcv; ((LAS float*)(buf + GS_EG))[lt] = __expf(gcv); ((LAS float*)(buf + GS_ED))[lt] = __expf(gl - gcv); } } } while (0)
#define GS_FLUSH(ci_) do { const int ci2 = (ci_); if (ci2 >= 0) { const LAS unsigned char* ob = F.lds + GS_OUT + (ci2 & 1) * 8192; int row0, step; gdn_rows(bl, dir, ci2, row0, step); \
        _Pragma("unroll") for (int i = 0; i < 2; ++i) { const int p = lt + 256 * i, row = p >> 3, pc = p & 7; \
            *(u32x4*)(Od + (size_t)(row0 + step * row) * 512 + h * 64 + pc * 8) = *(const LAS u32x4*)(ob + row * 128 + pc * 16); } } } while (0)
        bf16_t* Od = dir ? F.OB() : F.OF();
        GS_ISSUE(A, 0); GS_ISSUE(B, 1); GS_WRITE(A, 0); GS_ISSUE(A, 2);
        asm volatile("s_waitcnt lgkmcnt(0)" ::: "memory"); __builtin_amdgcn_s_barrier();
        for (int ci = 0; ci < NCHUNK; ci += 2) {
            GS_FLUSH(ci - 1); GS_WRITE(B, ci + 1); GS_ISSUE(B, ci + 3); asm volatile("s_waitcnt lgkmcnt(0)" ::: "memory"); __builtin_amdgcn_s_barrier();
            GS_FLUSH(ci); GS_WRITE(A, ci + 2); GS_ISSUE(A, ci + 4); asm volatile("s_waitcnt lgkmcnt(0)" ::: "memory"); __builtin_amdgcn_s_barrier();
        }
        GS_FLUSH(NCHUNK - 1);
#undef GS_ISSUE
#undef GS_WRITE
#undef GS_PERM
#undef GS_FLUSH
    } else {
        f32x4 S[4];
#pragma unroll
        for (int mt = 0; mt < 4; ++mt) S[mt] = (f32x4){0.f, 0.f, 0.f, 0.f};
        __builtin_amdgcn_s_barrier();
        for (int ci = 0; ci < NCHUNK; ++ci) {
            const LAS unsigned char* buf = F.lds + (ci & 1) * GS_BUF; const LAS float* gc = (const LAS float*)(buf + GS_GC);
            int row0, step; gdn_rows(bl, dir, ci, row0, step);
            bf16x8 aW[4][2], aQ[4][2]; f32x4 uin[4], eg[4], ed[4];
            const float gcl = gc[63];
#pragma unroll
            for (int mt = 0; mt < 4; ++mt) {
#pragma unroll
                for (int ks = 0; ks < 2; ++ks) { aW[mt][ks] = gs_ldA(buf + GS_WM, 16 * mt + n, ks, g); aQ[mt][ks] = gs_ldA(buf + GS_Q, 16 * mt + n, ks, g); }
#pragma unroll
                for (int r = 0; r < 4; ++r) uin[mt][r] = bf2f(*(const LAS bf16_t*)(buf + GS_U + (16 * mt + 4 * g + r) * 128 + (16 * wq + n) * 2));
                eg[mt] = *(const LAS f32x4*)(buf + GS_EG + (16 * mt + 4 * g) * 4); ed[mt] = *(const LAS f32x4*)(buf + GS_ED + (16 * mt + 4 * g) * 4); }
            const float cd = __expf(gcl);
            __builtin_amdgcn_sched_barrier(0);
            bf16x8 Sb[2]; Sb[0] = gs_pack(S[0], S[1]); Sb[1] = gs_pack(S[2], S[3]);
            f32x4 vn[4], o[4];
#pragma unroll
            for (int mt = 0; mt < 4; ++mt) { vn[mt] = __builtin_amdgcn_mfma_f32_16x16x32_bf16(aW[mt][0], Sb[0], uin[mt], 0, 0, 0); o[mt] = __builtin_amdgcn_mfma_f32_16x16x32_bf16(aQ[mt][0], Sb[0], (f32x4){0.f, 0.f, 0.f, 0.f}, 0, 0, 0); }
#pragma unroll
            for (int mt = 0; mt < 4; ++mt) { vn[mt] = __builtin_amdgcn_mfma_f32_16x16x32_bf16(aW[mt][1], Sb[1], vn[mt], 0, 0, 0); o[mt] = __builtin_amdgcn_mfma_f32_16x16x32_bf16(aQ[mt][1], Sb[1], o[mt], 0, 0, 0); }
            __builtin_amdgcn_sched_barrier(0);
            bf16x8 aQK[4][2], aK[4][2];
#pragma unroll
            for (int mt = 0; mt < 4; ++mt)
#pragma unroll
                for (int ks = 0; ks < 2; ++ks) { aQK[mt][ks] = gs_ldA(buf + GS_QK, 16 * mt + n, ks, g); aK[mt][ks] = gs_ldKT(buf + GS_K, mt, ks, g, n); }
            __builtin_amdgcn_sched_barrier(0);
#pragma unroll
            for (int mt = 0; mt < 4; ++mt) o[mt] = o[mt] * eg[mt];
            bf16x8 Vb[2]; Vb[0] = gs_pack(vn[0], vn[1]); Vb[1] = gs_pack(vn[2], vn[3]);
#pragma unroll
            for (int mt = 0; mt < 4; ++mt) vn[mt] = vn[mt] * ed[mt];
            bf16x8 Vd[2]; Vd[0] = gs_pack(vn[0], vn[1]); Vd[1] = gs_pack(vn[2], vn[3]);
#pragma unroll
            for (int mt = 0; mt < 4; ++mt) { o[mt] = __builtin_amdgcn_mfma_f32_16x16x32_bf16(aQK[mt][0], Vb[0], o[mt], 0, 0, 0); S[mt] = __builtin_amdgcn_mfma_f32_16x16x32_bf16(aK[mt][0], Vd[0], S[mt] * cd, 0, 0, 0); }
#pragma unroll
            for (int mt = 0; mt < 4; ++mt) { o[mt] = __builtin_amdgcn_mfma_f32_16x16x32_bf16(aQK[mt][1], Vb[1], o[mt], 0, 0, 0); S[mt] = __builtin_amdgcn_mfma_f32_16x16x32_bf16(aK[mt][1], Vd[1], S[mt], 0, 0, 0); }
#pragma unroll
            for (int mt = 0; mt < 4; ++mt)
#pragma unroll
                for (int r = 0; r < 4; ++r) { const int c = 16 * mt + 4 * g + r; *(LAS bf16_t*)(F.lds + GS_OUT + (ci & 1) * 8192 + c * 128 + (16 * wq + n) * 2) = (bf16_t)f2bf(o[mt][r]); }
            asm volatile("s_waitcnt lgkmcnt(0)" ::: "memory"); __builtin_amdgcn_s_barrier();
        }
    }
    __syncthreads();
}

__device__ __forceinline__ void attn_mla_phase(Frame& F, int vcu) {
    for (int i = 0;; ++i) {
        const int U = i * F.G + vcu; if (U >= GB * 8 * 32 + GB * 8) break;
        int bl, h, q0, seq;
        if (U < GB * 8 * 32) { const int bh = U >> 5; bl = bh >> 3; h = bh & 7; q0 = CTXL + 256 * (U & 31); seq = TT; }
        else { const int cu = U - GB * 8 * 32; bl = cu >> 3; h = cu & 7; q0 = 0; seq = CTXL; }
        const size_t rb = (size_t)bl * TT;
        att::attn_unit<96, 64>(F.QR() + (rb + q0) * 768 + h * 96, 768, F.KV() + rb * 1024 + h * 128, 1024, F.KPE() + rb * 32, F.KV() + rb * 1024 + h * 128 + 64, 1024,
                               F.HB() + (rb + q0) * DM + h * 64, DM, seq, F.ldsg, F.tid, F.TAB8(), (seq == TT) ? q0 - CTXL : -1);
    }
}
__device__ __forceinline__ void attn_l1_phase(Frame& F, int vcu, const int grp, const float* gkn) {
    float kd2[8]; float kg2;
    { const float* tb = (const float*)(F.ctl + CW_KMAX) + (size_t)grp * 256 * 8;
#pragma unroll
      for (int v = 0; v < 8; ++v) { float m = 0.f;
#pragma unroll
          for (int i = 0; i < 4; ++i) m = fmaxf(m, tb[(F.lane * 4 + i) * 8 + v]);
          m = red_max<64>(m);
          kd2[v] = (F.G == 256) ? __builtin_bit_cast(float, __builtin_amdgcn_readfirstlane(__builtin_bit_cast(int, m))) : -1.f; }
      float g = gkn[F.lane] * gkn[F.lane];
      g = red_max<64>(g);
      kg2 = 64.f * __builtin_bit_cast(float, __builtin_amdgcn_readfirstlane(__builtin_bit_cast(int, g))); }
    for (int i = 0;; ++i) {
        const int U = i * F.G + vcu; if (U >= GB * 8 * 32) break;
        const int bh = U >> 5, bl = bh >> 3, vh = bh & 7, hd = vh >> 1, q0 = CTXL + 256 * (U & 31); const size_t rb = (size_t)bl * TT;
        float kb = kd2[0];
#pragma unroll
        for (int v = 1; v < 8; ++v) kb = (vh == v) ? kd2[v] : kb;
        att::attn_unit<64, 128>(F.PB() + (rb + q0) * OD_IN + P1_DQ + vh * 64, OD_IN, F.PB() + rb * OD_IN + P1_DK + vh * 64, OD_IN, nullptr, F.PB() + rb * OD_IN + P1_DV + hd * 128, OD_IN,
                                F.KV() + (rb + q0) * DM + vh * 128, DM, TT, F.ldsg, F.tid, nullptr, -1, kb);
    }
    int tid2 = F.tid; asm volatile("" : "+v"(tid2));
    for (int i = 0;; ++i) {
        const int U = i * F.G + vcu; if (U >= GB * 8 * 32) break;
        const int bh = U >> 5, bl = bh >> 3, hq = bh & 7, kvh = hq >> 2, q0 = CTXL + 256 * (U & 31); const size_t rb = (size_t)bl * TT;
        att::attn_unit<64, 64>(F.PB() + (rb + q0) * OD_IN + P1_GQ + hq * 64, OD_IN, F.PB() + rb * OD_IN + P1_GK + kvh * 64, OD_IN, nullptr, F.PB() + rb * OD_IN + P1_GV + kvh * 64, OD_IN,
                               F.HB() + (rb + q0) * DM + 512 + hq * 64, DM, TT, F.ldsg, tid2, nullptr, -1, kg2);
    }
}

#ifndef PHMASK
#define PHMASK 0xffffffffu
#endif
#ifndef DUPMASK
#define DUPMASK 0u
#endif
#define RUNS(k) (1 + (int)((DUPMASK >> (k)) & 1u))
struct Args { const float* in[29]; float* out; unsigned char* ws; int do_pro, g_lo, g_hi, ph_lo, ph_hi, li, pad0, pad1; };
constexpr int NPH = 22;
__global__ void __launch_bounds__(NTHREADS, 2) mega_fwd(Args args) {
    extern __shared__ __attribute__((aligned(16))) unsigned char lds[];
    Frame F;
    F.lds = (LAS unsigned char*)lds; F.ldsg = (char*)lds;
    F.MISC = (volatile LAS unsigned*)(F.lds + LDSCTL_OFF);
    F.tid = threadIdx.x; F.lane = F.tid & 63; F.wave = __builtin_amdgcn_readfirstlane(F.tid >> 6); const int wave_s = F.wave;
    F.G = gridDim.x; F.gw = blockIdx.x * NWAVES + F.wave; F.NGW = F.G * NWAVES;
    unsigned char* ws = args.ws; F.ws = ws; F.ctl = (unsigned*)(F.ws + WS_CTL); F.X = args.out;
    for (int u = F.tid; u < (LDS_BYTES - LDSCTL_OFF) / 4; u += NTHREADS) ((LAS unsigned*)(F.lds + LDSCTL_OFF))[u] = 0u;
    __syncthreads();
    XcdBarrier bar = xcd_barrier_post((unsigned*)(F.ctl + CW_BAR) + args.li * XCD_BAR_WORDS, F.MISC + 8);
#define GRID_BAR() xcd_barrier(bar)
#define RETID() do { int t_ = F.tid; asm volatile("" : "+v"(t_)); F.tid = t_; } while (0)
#ifndef CTX_SPLITK
#define CTX_SPLITK 0
#endif
#ifndef WGM_N1024
#define WGM_N1024 4
#endif
#ifndef WGM_MOEGU
#define WGM_MOEGU 4
#endif
#ifndef WGM_MOED
#define WGM_MOED 4
#endif
#ifndef WGM_FFNGU
#define WGM_FFNGU 4
#endif
#ifndef WGM_WIN
#define WGM_WIN 4
#endif
#define KA(i) ((const float*)(const GAS float*)ka[i])
    typedef const float* const __attribute__((address_space(4)))* kaptr_t; kaptr_t ka;
#define REFRESH() int bx; do { int w_ = wave_s; asm volatile("" : "+s"(w_)); int l_; asm volatile("v_mbcnt_lo_u32_b32 %0, -1, 0\n\tv_mbcnt_hi_u32_b32 %0, -1, %0" : "=v"(l_)); bx = blockIdx.x; asm volatile("" : "+s"(bx)); GAS unsigned char* ws_ = (GAS unsigned char*)args.ws; asm volatile("" : "+s"(ws_)); GAS float* o_ = (GAS float*)args.out; asm volatile("" : "+s"(o_)); F.ws = (unsigned char*)ws_; F.ctl = (unsigned*)ws_; F.X = (float*)o_; ka = (kaptr_t)__builtin_amdgcn_kernarg_segment_ptr(); asm volatile("" : "+s"(ka)); F.tid = w_ * 64 + l_; F.lane = l_; F.wave = w_; F.gw = bx * NWAVES + w_; } while (0)
    LAS unsigned char* ring = F.lds;

    if (((PHMASK >> 0) & 1u) && args.do_pro) { const ProIn I{args.in[7], args.in[10], args.in[11], args.in[16], args.in[17], args.in[18], args.in[19], args.in[24], args.in[26], args.in[27], args.in[1], args.in[3], args.in[4], args.in[5]};
        for (int rep_ = 0; rep_ < RUNS(0); ++rep_) { p0_prologue(F, I); __syncthreads(); } GRID_BAR();
        if (!I8_STRIP) { p0_deferred_gu(F, args.in[26], 0, MOE_DEFER_GU, (int)blockIdx.x, F.G, args.in[7], args.in[17], args.in[19]); GRID_BAR(); } }

    for (int grp = args.g_lo; grp < args.g_hi; ++grp) {
#ifdef MK_SPLIT
        const int lo = args.ph_lo, hi = args.ph_hi;
#else
        constexpr int lo = 1, hi = NPH + 1;
#endif
#define IN(k) (((PHMASK >> (k)) & 1u) && lo <= (k) && (k) < hi)
#define SEAM(k) do { if ((k) + 1 < hi || ((k) + 1 == hi && grp + 1 < args.g_hi)) { GRID_BAR(); if (RUNS(25) == 2) GRID_BAR(); } } while (0)
        if (IN(1)) { for (int rep_ = 0; rep_ < RUNS(1); ++rep_) { REFRESH(); norm_pass<true, false, I8_WIN0 != 0>(F, grp, 0, 0, KA(6), KA(0), KA(2), nullptr); } SEAM(1); }
        if (IN(2)) { for (int rep_ = 0; rep_ < RUNS(2); ++rep_) { REFRESH(); pg8::Gemm g{F.HB(), (const bf16_t*)(F.ws + WS_WI0), RROWS, EV_INP, 1024, 1024, 1024}; pg8::StaticOrder S; S.init(RROWS, EV_INP, F.G, bx, 0, WGM_WIN);
            if (I8_WIN0) { pg8::EpiBf16I8 E{F.PB(), EV_INP, F.SATOK(), F.SWD2()}; pg8::gemm_phase<pg8::EpiBf16I8, pg8::StaticOrder, true, true, true>(ring, g, S, E, F.tid); }
            else { pg8::EpiBf16 E{F.PB(), EV_INP}; pg8::gemm_phase<pg8::EpiBf16, pg8::StaticOrder>(ring, g, S, E, F.tid); } } SEAM(2); }
        if (IN(3)) { if (RUNS(3) == 2) { REFRESH(); fix_even(F, KA(8), KA(9), KA(12), KA(13), KA(14), 1, true); __syncthreads(); } { REFRESH(); fix_even(F, KA(8), KA(9), KA(12), KA(13), KA(14), RUNS(24)); } SEAM(3); }
        if (IN(4)) { for (int rep_ = 0; rep_ < RUNS(23); ++rep_) { REFRESH(); gdn_pre(F, bx); } SEAM(4); }
        if (IN(5)) { REFRESH();
            if (bx < GB * 16) { gdn_scan(F, bx); if (RUNS(26) == 2) { RETID(); F.lane = F.tid & 63; gdn_scan(F, (bx + 32) & 63); } }
            else { const int G2 = F.G - GB * 16, c2 = bx - GB * 16;
              { pg8::Gemm g{F.PB() + PC_CQ, (const bf16_t*)(F.ws + WS_WUQ), RROWS, 768, 384, EV_INP, 384}; pg8::StaticOrder S; S.init(RROWS, 768, G2, c2);
                pg8::EpiBf16 E{F.QR(), 768}; pg8::gemm_phase<pg8::EpiBf16, pg8::StaticOrder>(ring, g, S, E, F.tid); } RETID();
              { pg8::Gemm g{F.PB() + PC_CKV, (const bf16_t*)(F.ws + WS_WUKV), RROWS, 1024, 256, EV_INP, 256}; pg8::StaticOrder S; S.init(RROWS, 1024, G2, c2);
                pg8::EpiBf16 E{F.KV(), 1024}; pg8::gemm_phase<pg8::EpiBf16, pg8::StaticOrder>(ring, g, S, E, F.tid); }
              if (grp == 0 && args.do_pro) { RETID(); F.lane = F.tid & 63; p0_deferred(F, KA(26), KA(27), c2, G2); if (F.G != 256) p0_deferred_gu(F, KA(26), 3, 8, c2, G2); } }
            SEAM(5); }
        if (IN(6)) { for (int rep_ = 0; rep_ < RUNS(6); ++rep_) { REFRESH();
            attn_mla_phase(F, (F.G % 8 == 0) ? (bx % 8) * (F.G / 8) + bx / 8 : bx);
            } SEAM(6); }
        if (IN(7)) { for (int rep_ = 0; rep_ < RUNS(7); ++rep_) { REFRESH(); gdn_out(F, KA(15)); } SEAM(7); }
        if (IN(8)) { for (int rep_ = 0; rep_ < RUNS(8); ++rep_) { REFRESH(); if (CTX_SPLITK) { pg8::Gemm gc{F.HB(), (const bf16_t*)(F.ws + WS_WO0), RROWS, 1024, 256, 1024, 1024}; pg8::CtxSplitOrder SC; SC.init(4, F.G, bx);
              pg8::EpiCtxPartial EC{F.PART()}; pg8::gemm_phase<pg8::EpiCtxPartial, pg8::CtxSplitOrder>(ring, gc, SC, EC, F.tid); } RETID();
            pg8::Gemm g{F.HB(), (const bf16_t*)(F.ws + WS_WO0), RROWS, 1024, 1024, 1024, 1024}; pg8::StaticOrder S; if (CTX_SPLITK) S.init(GB * 32 * 256, 1024, F.G, bx, 1); else S.init(RROWS, 1024, F.G, bx, 0, WGM_N1024);
            pg8::EpiResid E{F.X16(), F.CX(), rep_ ? (const float*)(F.ws + 512 * 1024) : F.MOD(), 2, grp, 0}; pg8::gemm_phase<pg8::EpiResid, pg8::StaticOrder>(ring, g, S, E, F.tid);
            if (grp == 0 && args.do_pro && rep_ == 0 && bx >= 16 && F.G == 256) { RETID(); F.lane = F.tid & 63; p0_deferred_gu(F, KA(26), 3, 4, bx - 16, F.G - 16); } } SEAM(8); }
        if (IN(9)) { for (int rep_ = 0; rep_ < RUNS(9); ++rep_) { REFRESH(); norm_pass<false, false, I8_GU0 != 0>(F, grp, 0, 1, KA(6), nullptr, nullptr, nullptr, CTX_SPLITK ? F.PART() : nullptr, 4, 2, F.MOD()); } SEAM(9); }
        if (IN(10)) { for (int rep_ = 0; rep_ < RUNS(10); ++rep_) { REFRESH(); pg8::Gemm g{F.HB(), (const bf16_t*)(F.ws + WS_WGU0), RROWS, 2 * FFN, 1024, 1024, 1024}; pg8::StaticOrder S; S.init(RROWS, 2 * FFN, F.G, bx, 0, WGM_FFNGU);
            if (I8_GU0) { pg8::EpiSwiGLUI8 E{F.PB(), FFN, F.SATOK(), F.SWD2() + EV_INP}; pg8::gemm_phase<pg8::EpiSwiGLUI8, pg8::StaticOrder, true, true, true>(ring, g, S, E, F.tid); }
            else { pg8::EpiSwiGLU E{F.PB(), FFN}; pg8::gemm_phase<pg8::EpiSwiGLU, pg8::StaticOrder>(ring, g, S, E, F.tid); } } SEAM(10); }
        if (IN(11)) { for (int rep_ = 0; rep_ < RUNS(11); ++rep_) { REFRESH(); if (CTX_SPLITK) { pg8::Gemm gc{F.PB(), (const bf16_t*)(F.ws + WS_WD0), RROWS, 1024, 256, FFN, FFN}; pg8::CtxSplitOrder SC; SC.init(FFN / 256, F.G, bx);
              pg8::EpiCtxPartial EC{F.PART()}; pg8::gemm_phase<pg8::EpiCtxPartial, pg8::CtxSplitOrder>(ring, gc, SC, EC, F.tid); } RETID();
            pg8::Gemm g{F.PB(), (const bf16_t*)(F.ws + WS_WD0), RROWS, 1024, FFN, FFN, FFN}; pg8::StaticOrder S; if (CTX_SPLITK) S.init(GB * 32 * 256, 1024, F.G, bx, 1); else S.init(RROWS, 1024, F.G, bx, 0, WGM_N1024);
            pg8::EpiResid E{F.X16(), F.CX(), rep_ ? (const float*)(F.ws + 512 * 1024) : F.MOD(), 5, grp, 0}; pg8::gemm_phase<pg8::EpiResid, pg8::StaticOrder>(ring, g, S, E, F.tid);
            if (grp == 0 && args.do_pro && rep_ == 0 && bx >= 16 && F.G == 256) { RETID(); F.lane = F.tid & 63; p0_deferred_gu(F, KA(26), 4, 8, bx - 16, F.G - 16); } } SEAM(11); }
        if (IN(12)) { for (int rep_ = 0; rep_ < RUNS(12); ++rep_) { REFRESH(); norm_pass<false, false, I8_WIN1 != 0>(F, grp, 1, 0, KA(6), nullptr, nullptr, nullptr, CTX_SPLITK ? F.PART() : nullptr, FFN / 256, 5, F.MOD()); } SEAM(12); }
        if (IN(13)) { for (int rep_ = 0; rep_ < RUNS(13); ++rep_) { REFRESH(); pg8::Gemm g{F.HB(), (const bf16_t*)(F.ws + WS_WI1), RROWS, OD_IN, 1024, 1024, 1024}; pg8::StaticOrder S; S.init(RROWS, OD_IN, F.G, bx, 0, WGM_WIN);
            if (I8_WIN1) { pg8::EpiBf16I8 E{F.PB(), OD_IN, F.SATOK(), F.SWD2() + EV_INP + 2 * FFN}; pg8::gemm_phase<pg8::EpiBf16I8, pg8::StaticOrder, true, true, true>(ring, g, S, E, F.tid); }
            else { pg8::EpiBf16 E{F.PB(), OD_IN}; pg8::gemm_phase<pg8::EpiBf16, pg8::StaticOrder>(ring, g, S, E, F.tid); } } SEAM(13); }
        if (IN(14)) { if (RUNS(14) == 2) { REFRESH(); fix_odd(F, KA(22), KA(23), grp, true); } { REFRESH(); fix_odd(F, KA(22), KA(23), grp); } SEAM(14); }
        if (IN(15)) { for (int rep_ = 0; rep_ < RUNS(15); ++rep_) { REFRESH(); attn_l1_phase(F, (F.G % 8 == 0) ? (bx % 8) * (F.G / 8) + bx / 8 : bx, grp, KA(23)); } SEAM(15); }
        if (IN(16)) { for (int rep_ = 0; rep_ < RUNS(16); ++rep_) { REFRESH(); diff_post(F, KA(20), KA(21)); } SEAM(16); }
        if (IN(17)) { for (int rep_ = 0; rep_ < RUNS(17); ++rep_) { REFRESH(); pg8::Gemm g{F.HB(), (const bf16_t*)(F.ws + WS_WO1), RROWS, 1024, 1024, 1024, 1024}; pg8::StaticOrder S; S.init(GB * 32 * 256, 1024, F.G, bx, 1, WGM_N1024);
            pg8::EpiResid E{F.X16(), F.CX(), rep_ ? (const float*)(F.ws + 512 * 1024) : F.MOD() + 9 * MOD_ROW, 2, grp, 1}; pg8::gemm_phase<pg8::EpiResid, pg8::StaticOrder>(ring, g, S, E, F.tid); } SEAM(17); }
        if (IN(18)) { if (RUNS(18) == 2) { REFRESH(); norm_pass<false, true>(F, grp, 1, 1, KA(6), nullptr, nullptr, KA(25), nullptr, 0, 0, nullptr, true); __syncthreads(); } { REFRESH(); norm_pass<false, true>(F, grp, 1, 1, KA(6), nullptr, nullptr, KA(25)); } SEAM(18); }
        if (IN(19)) { REFRESH(); moe_tends(F, grp); if (RUNS(19) == 2) { moe_gather(F, grp, true); GRID_BAR(); } moe_gather(F, grp); SEAM(19); }
        if (IN(20)) { for (int rep_ = 0; rep_ < RUNS(20); ++rep_) { REFRESH(); moe_tends(F, grp); const int ntile = (int)F.MISC[23];
            pg8::Gemm g{F.HB(), (const bf16_t*)(F.ws + WS_WGU1), ntile * 256, 2 * EXD, 1024, 1024, 1024, (const int*)((const signed char*)F.XG() + (size_t)MOE_ROWS * DM + (size_t)MOE_ROWS * 4)}; pg8::StaticOrder S; S.init(ntile * 256, 2 * EXD, F.G, bx, 0, WGM_MOEGU);
            S.tend = (const int*)(lds + LDSCTL_OFF + 16 * 4); S.estride = (size_t)2 * EXD * 1024;
            pg8::EpiSwiGLUI8 E{F.ACT1(), EXD, (const float*)((const signed char*)F.XG() + (size_t)MOE_ROWS * DM), F.SWD()}; pg8::gemm_phase<pg8::EpiSwiGLUI8, pg8::StaticOrder, true, true, true, true>(ring, g, S, E, F.tid); } SEAM(20); }
        if (IN(21)) { for (int rep_ = 0; rep_ < RUNS(21); ++rep_) { REFRESH(); moe_tends(F, grp); const int ntile = (int)F.MISC[23];
            pg8::Gemm g{F.ACT1(), (const bf16_t*)(F.ws + WS_WD1), ntile * 256, 1024, EXD, EXD, EXD}; pg8::StaticOrder S; S.init(ntile * 256, 1024, F.G, bx, 0, WGM_MOED);
            S.tend = (const int*)(lds + LDSCTL_OFF + 16 * 4); S.estride = (size_t)1024 * EXD * 2;
            pg8::EpiBf16 E{F.XG(), 1024}; pg8::gemm_phase<pg8::EpiBf16, pg8::StaticOrder>(ring, g, S, E, F.tid); } SEAM(21); }
        if (IN(22)) { if (RUNS(22) == 2) { REFRESH(); final_pass(F, grp, KA(28), true); } { REFRESH(); final_pass(F, grp, KA(28)); } SEAM(22); }
#undef IN
#undef SEAM
    }
}

extern "C" void kernel_launch(void* const* d_in, const int* in_sizes, int n_in, void* d_out, int out_size, void* d_ws, size_t ws_size, hipStream_t stream) {
    static int grid = 0;
    if (grid == 0) {
        if (n_in != 29 || out_size != NBATCH * SEQ * DM || ws_size < WS_END) { fprintf(stderr, "kernel_launch: unexpected shapes: n_in %d out %d ws %zu (need %zu)\n", n_in, out_size, ws_size, (size_t)WS_END); grid = -1; return; }
        int dev = 0, cus = 0, per_cu = 0;
        if (hipGetDevice(&dev) != hipSuccess || hipDeviceGetAttribute(&cus, hipDeviceAttributeMultiprocessorCount, dev) != hipSuccess) { grid = -1; return; }
        if (hipFuncSetAttribute((const void*)mega_fwd, hipFuncAttributeMaxDynamicSharedMemorySize, LDS_BYTES) != hipSuccess) { fprintf(stderr, "kernel_launch: hipFuncSetAttribute failed\n"); grid = -1; return; }
        if (hipOccupancyMaxActiveBlocksPerMultiprocessor(&per_cu, (const void*)mega_fwd, NTHREADS, LDS_BYTES) != hipSuccess || per_cu < 1) { fprintf(stderr, "kernel_launch: occupancy query says %d\n", per_cu); }
        (void)hipGetLastError();
        grid = cus;
    }
    if (grid < 0) return;
    (void)hipMemsetAsync((char*)d_ws + WS_CTL, 0, CTL_BYTES, stream);
    Args a{};
    for (int i = 0; i < 29; ++i) a.in[i] = (const float*)d_in[i];
    a.out = (float*)d_out; a.ws = (unsigned char*)d_ws;
#ifndef MK_SPLIT
    a.do_pro = 1; a.g_lo = 0; a.g_hi = NGRP; a.ph_lo = 1; a.ph_hi = NPH + 1; a.li = 0;
    hipLaunchKernelGGL(mega_fwd, dim3(grid), dim3(NTHREADS), LDS_BYTES, stream, a);
#else
    a.li = 0;
    a.do_pro = 1; a.g_lo = 0; a.g_hi = 0; a.ph_lo = 1; a.ph_hi = 1;
    hipLaunchKernelGGL(mega_fwd, dim3(grid), dim3(NTHREADS), LDS_BYTES, stream, a);
    for (int g = 0; g < NGRP; ++g) for (int ph = 1; ph <= NPH; ++ph) { a.do_pro = 0; a.g_lo = g; a.g_hi = g + 1; a.ph_lo = ph; a.ph_hi = ph + 1;
        hipLaunchKernelGGL(mega_fwd, dim3(grid), dim3(NTHREADS), LDS_BYTES, stream, a); }
#endif
}
```

```cpp
#include <hip/hip_runtime.h>
#include <cstdio>
#include <cstdint>

#define LAS __attribute__((address_space(3)))
#define GAS __attribute__((address_space(1)))
typedef unsigned short bf16_t;
typedef short bf16x8 __attribute__((ext_vector_type(8)));
typedef short s16x4 __attribute__((ext_vector_type(4)));
typedef float f32x4 __attribute__((ext_vector_type(4)));
typedef float f32x2 __attribute__((ext_vector_type(2)));
typedef float f32x16 __attribute__((ext_vector_type(16)));
typedef unsigned u32x4 __attribute__((ext_vector_type(4)));
typedef unsigned u32x2 __attribute__((ext_vector_type(2)));
typedef int i32x4 __attribute__((ext_vector_type(4)));

#ifndef I8_STRIP
#define I8_STRIP 1
#endif
#ifndef I8_WIN0
#define I8_WIN0 1
#endif
#ifndef I8_GU0
#define I8_GU0 1
#endif
#ifndef I8_WIN1
#define I8_WIN1 1
#endif
constexpr int DM = 1024, NBATCH = 8, SEQ = 8192, CTXL = 256, TT = SEQ + CTXL;
constexpr int GB = 4, NGRP = NBATCH / GB, RROWS = GB * TT, RTILES = RROWS / 256;
constexpr int EV_IN = 2752, EV_INP = 2816, OD_IN = 2304, FFN = 2816, EXD = 3584, NEXP = 8;
constexpr int MOD_ROW = 6 * DM;
constexpr int NTOK_G = GB * SEQ;
constexpr int MOE_ROWS = 2 * NTOK_G + NEXP * 256;
constexpr float NORM_EPS = 1e-6f;
constexpr float ATT_C64 = 0.125f * 1.4426950408889634f, ATT_C96 = 0.10206207261596575f * 1.4426950408889634f;
constexpr int PC_CQ = 0, PC_CKV = 384, PC_KPE = 640, PC_GQKV = 672, PC_Z = 2208, PC_A = 2720, PC_B = 2736;
constexpr int P1_DQ = 0, P1_DK = 512, P1_DV = 1024, P1_GQ = 1536, P1_GK = 2048, P1_GV = 2176;
constexpr int NCHUNK = TT / 64;
constexpr int GPRE_CHUNK = 3 * 8192;

constexpr size_t MiB = 1u << 20;
constexpr size_t WS_CTL = 0, CTL_BYTES = 1 * MiB;
constexpr size_t WS_MOD = 1 * MiB;
constexpr size_t WS_TAB8 = WS_MOD + 448 * 1024;
constexpr size_t WS_TAB16 = WS_TAB8 + 8 * 1024;
constexpr size_t WS_TOPE = WS_TAB16 + 16 * 1024;
constexpr size_t WS_TOPW = WS_TOPE + 256 * 1024;
constexpr size_t WS_SLOT = WS_TOPW + 256 * 1024;
constexpr size_t WS_SWD = 2 * MiB + 256 * 1024;
constexpr size_t WS_SATOK = 2 * MiB + 512 * 1024;
constexpr size_t WS_SWD2 = 2 * MiB + 704 * 1024;
static_assert(WS_SLOT + 256 * 1024 <= WS_SWD && WS_SWD + 8 * 7168 * 4 <= WS_SATOK && WS_SATOK + RROWS * 4 <= WS_SWD2 && WS_SWD2 + (2816 + 5632 + 2304) * 4 <= 3 * MiB, "small region");
constexpr size_t WS_CX = 3 * MiB;
constexpr size_t WS_W = 11 * MiB;
constexpr size_t WS_WI0 = WS_W;
constexpr size_t WS_WUQ = WS_WI0 + (size_t)EV_INP * 1024 * 2;
constexpr size_t WS_WUKV = WS_WUQ + (size_t)768 * 384 * 2;
constexpr size_t WS_WO0 = WS_WUKV + (size_t)1024 * 256 * 2;
constexpr size_t WS_WGU0 = WS_WO0 + (size_t)1024 * 1024 * 2;
constexpr size_t WS_WD0 = WS_WGU0 + (size_t)2 * FFN * 1024 * 2;
constexpr size_t WS_WI1 = WS_WD0 + (size_t)1024 * FFN * 2;
constexpr size_t WS_WO1 = WS_WI1 + (size_t)OD_IN * 1024 * 2;
constexpr size_t WS_WGU1 = WS_WO1 + (size_t)1024 * 1024 * 2;
constexpr size_t WS_WD1 = WS_WGU1 + (size_t)NEXP * 2 * EXD * 1024 * 2;
constexpr size_t WS_WEND = WS_WD1 + (size_t)NEXP * 1024 * EXD * 2;
static_assert(WS_WEND <= 211 * MiB, "weights region");
constexpr size_t WS_HB = 211 * MiB;
constexpr size_t WS_PB = 277 * MiB;
constexpr size_t WS_QR = 459 * MiB;
constexpr size_t WS_KV = 509 * MiB;
constexpr size_t WS_KPE = 575 * MiB;
constexpr size_t WS_GQ = 578 * MiB, WS_GK = 611 * MiB, WS_GV = 644 * MiB;
constexpr size_t WS_GG = 677 * MiB, WS_GBT = 680 * MiB;
constexpr size_t WS_OF = 683 * MiB, WS_OB = 716 * MiB;
constexpr size_t WS_GPRE = 749 * MiB;
constexpr size_t WS_ACT1 = 277 * MiB;
constexpr size_t WS_PART = 749 * MiB;
constexpr size_t WS_XG = 749 * MiB;
constexpr size_t WS_X16 = 947 * MiB;
constexpr size_t WS_GCB = 1011 * MiB;
constexpr size_t WS_END = 1014 * MiB;
static_assert(WS_ACT1 + (size_t)MOE_ROWS * EXD * 2 <= WS_XG && WS_XG + (size_t)MOE_ROWS * 1024 * 2 <= WS_END, "moe map");
static_assert(WS_GPRE + (size_t)GB * 8 * 2 * NCHUNK * GPRE_CHUNK <= WS_END, "gpre map");
constexpr int CW_BAR = 4096;
constexpr int CW_KMAX = 40960;
constexpr int CW_SWMAX = 65536;
constexpr int CW_GFLAG = 140000;
constexpr int CW_SWMAX2 = 122880;
constexpr int CW_WGB = 32768;
constexpr int CW_CNT = 16384;

constexpr int RING_BYTES = 131072;
constexpr int LDSCTL_OFF = 147456;
constexpr int LDS_BYTES = 163840;
constexpr int NWAVES = 8, NTHREADS = 512;

#define RLX_AGENT __ATOMIC_RELAXED, __HIP_MEMORY_SCOPE_AGENT
__device__ __forceinline__ unsigned f2bf(float f) { unsigned u = __builtin_bit_cast(unsigned, f); return (u + 0x7fffu + ((u >> 16) & 1u)) >> 16; }
__device__ __forceinline__ unsigned pk2(float lo, float hi) { return f2bf(lo) | (f2bf(hi) << 16); }
__device__ __forceinline__ float bflo(unsigned w) { return __builtin_bit_cast(float, w << 16); }
__device__ __forceinline__ float bfhi(unsigned w) { return __builtin_bit_cast(float, w & 0xffff0000u); }
__device__ __forceinline__ float bf2f(bf16_t v) { return __builtin_bit_cast(float, (unsigned)v << 16); }
typedef __bf16 bf16x2_t __attribute__((ext_vector_type(2)));
__device__ __forceinline__ unsigned cvt_pk_bf16(float lo, float hi) { const f32x2 v = {lo, hi}; return __builtin_bit_cast(unsigned, __builtin_convertvector(v, bf16x2_t)); }
__device__ __forceinline__ float sx(float v, int mask, int lane) { return __builtin_bit_cast(float, __builtin_amdgcn_ds_bpermute((lane ^ mask) << 2, __builtin_bit_cast(int, v))); }
template <int CTRL> __device__ __forceinline__ float dppf(float v) { return __builtin_bit_cast(float, __builtin_amdgcn_update_dpp(0, __builtin_bit_cast(int, v), CTRL, 0xf, 0xf, true)); }
template <int N> __device__ __forceinline__ float red_sum(float v) {
    if constexpr (N >= 2) v += dppf<0xB1>(v);
    if constexpr (N >= 4) v += dppf<0x4E>(v);
    if constexpr (N >= 8) v += dppf<0x141>(v);
    if constexpr (N >= 16) v += dppf<0x140>(v);
    if constexpr (N >= 32) { auto rr = __builtin_amdgcn_permlane16_swap(__float_as_uint(v), __float_as_uint(v), false, false); v = __uint_as_float(rr[0]) + __uint_as_float(rr[1]); }
    if constexpr (N >= 64) { auto rr = __builtin_amdgcn_permlane32_swap(__float_as_uint(v), __float_as_uint(v), false, false); v = __uint_as_float(rr[0]) + __uint_as_float(rr[1]); }
    return v;
}
template <int N> __device__ __forceinline__ float red_max(float v) {
    if constexpr (N >= 2) v = fmaxf(v, dppf<0xB1>(v));
    if constexpr (N >= 4) v = fmaxf(v, dppf<0x4E>(v));
    if constexpr (N >= 8) v = fmaxf(v, dppf<0x141>(v));
    if constexpr (N >= 16) v = fmaxf(v, dppf<0x140>(v));
    if constexpr (N >= 32) { auto rr = __builtin_amdgcn_permlane16_swap(__float_as_uint(v), __float_as_uint(v), false, false); v = fmaxf(__uint_as_float(rr[0]), __uint_as_float(rr[1])); }
    if constexpr (N >= 64) { auto rr = __builtin_amdgcn_permlane32_swap(__float_as_uint(v), __float_as_uint(v), false, false); v = fmaxf(__uint_as_float(rr[0]), __uint_as_float(rr[1])); }
    return v;
}
__device__ __forceinline__ float wave_sum(float v, int lane) { (void)lane; return red_sum<64>(v); }
__device__ __forceinline__ float silu_f(float x) { return x * __builtin_amdgcn_rcpf(1.f + __expf(-x)); }
__device__ __forceinline__ float rsq_f(float x) { return __builtin_amdgcn_rsqf(x); }

namespace pg8 {
constexpr int BM = 256, BK = 64, HALF = 128, HTB = HALF * BK * 2, STAGE_BYTES = 8 * HTB, NXCD = 8, WGM = 4;
__host__ __device__ __forceinline__ int lds_byte(int r, int c) { const int st = (r >> 4) * 2 + (c >> 5), rr = r & 15, cc = c & 31, ob = rr * 64 + cc * 2; return st * 1024 + (ob ^ (((ob >> 9) & 1) << 5)); }
__host__ __device__ __forceinline__ void stage_rc(int b, int& R, int& C) { const int st = b / 1024, sb = b % 1024, swz = sb ^ (((sb >> 9) & 1) << 5); R = (st >> 1) * 16 + swz / 64; C = (st & 1) * 32 + (swz % 64) / 2; }
__host__ __device__ __forceinline__ int perm32(int rho) { const int n = rho >> 4, i = rho & 15; return 8 * (i >> 2) + 4 * n + (i & 3); }

struct Unit { int pm, pn; size_t boff, aoff; };
struct Gemm { const bf16_t* A; const bf16_t* Bt; int M, N, K, lda, ldb; const int* rowtab; };

struct StaticOrder {
    int nM, nN, nwg, G, c, lat, wgm; const int* tend; size_t estride;
    __device__ void init(int M, int N, int G_, int c_, int lat_ = 0, int wgm_ = WGM) { nM = M / BM; nN = N / BM; nwg = nM * nN; G = G_; c = c_; tend = nullptr; estride = 0; lat = lat_; wgm = wgm_; }
    __device__ bool next(int i, Unit& u) const {
        const long L = (long)i * G + c; if (L >= nwg) return false;
        int wgid = (int)L; { const int q = nwg / NXCD, r = nwg % NXCD, xcd = wgid % NXCD, off = wgid / NXCD; wgid = (xcd < r ? xcd * (q + 1) : r * (q + 1) + (xcd - r) * q) + off; }
        const int nig = wgm * nN, gid = wgid / nig, fm = gid * wgm, gsz = (nM - fm) < wgm ? (nM - fm) : wgm;
        u.pm = fm + ((wgid % nig) % gsz); u.pn = (wgid % nig) / gsz; u.boff = 0; u.aoff = 0;
        if (lat) u.pm = u.pm + (u.pm >> 5) + 1;
        if (tend) { int e = 0;
#pragma unroll
            for (int j = 0; j < 7; ++j) e += (u.pm >= tend[j]) ? 1 : 0;
            u.boff = (size_t)e * estride; }
        return true;
    }
};

struct MoeTailOrder {
    int n, G, c; const int* tend; size_t estride;
    __device__ void init(int ntail, int G_, int c_) { n = ntail * 16; G = G_; c = c_; tend = nullptr; estride = 0; }
    __device__ bool next(int i, Unit& u) const {
        const int L = i * G + c; if (L >= n) return false;
        const int ks = L & 3; u.pn = (L >> 2) & 3; u.pm = 256 + (L >> 4);
        int e = 0;
#pragma unroll
        for (int j = 0; j < 7; ++j) e += (u.pm >= tend[j]) ? 1 : 0;
        u.boff = (size_t)e * estride + (size_t)ks * 1792; u.aoff = (size_t)ks * 1792; return true;
    }
};
struct CtxSplitOrder {
    int S, G, c;
    __device__ void init(int S_, int G_, int c_) { S = S_; G = G_; c = c_; }
    __device__ bool next(int i, Unit& u) const {
        const int L = i * G + c; if (L >= GB * 4 * S) return false;
        const int sl = L % S, r = L / S; u.pn = r & 3; u.pm = (r >> 2) * 33; u.boff = (size_t)sl * 512; u.aoff = (size_t)sl * 512; return true;
    }
};
struct EpiBf16 {
    static constexpr bool PERM = true;
    bf16_t* O; int ldc;
    __device__ __forceinline__ void operator()(const f32x4 (&acc)[2][2][4][2], const Unit& u, int wr, int wc, int fr_, int fq) const {
        const int fr = fr_;
        const int row0 = u.pm * BM + wr * 64 + fr, col0 = u.pn * BM + wc * 32 + 8 * fq;
#pragma unroll
        for (int ai = 0; ai < 2; ++ai)
#pragma unroll
            for (int m = 0; m < 4; ++m) { bf16_t* rowp = O + (size_t)(row0 + ai * HALF + m * 16) * ldc + col0;
#pragma unroll
                for (int bj = 0; bj < 2; ++bj) { const f32x4 v0 = acc[ai][bj][m][0], v1 = acc[ai][bj][m][1];
                    u32x4 w; w.x = cvt_pk_bf16(v0[0], v0[1]); w.y = cvt_pk_bf16(v0[2], v0[3]); w.z = cvt_pk_bf16(v1[0], v1[1]); w.w = cvt_pk_bf16(v1[2], v1[3]);
                    *(u32x4*)(rowp + bj * HALF) = w; } }
    }
};
struct EpiBf16K4 {
    static constexpr bool PERM = true;
    bf16_t* O; bf16_t* P;
    __device__ __forceinline__ void operator()(const f32x4 (&acc)[2][2][4][2], const Unit& u, int wr, int wc, int fr_, int fq) const {
        const int fr = fr_;
        const int ks = (int)(u.aoff / 1792);
        bf16_t* base = (ks == 0 ? O + (size_t)u.pm * BM * 1024 : P + ((size_t)(ks - 1) * 8 + (size_t)(u.pm - 256)) * BM * 1024) + (size_t)(wr * 64 + fr) * 1024 + u.pn * BM + wc * 32 + 8 * fq;
#pragma unroll
        for (int ai = 0; ai < 2; ++ai)
#pragma unroll
            for (int m = 0; m < 4; ++m) { bf16_t* rowp = base + (size_t)(ai * HALF + m * 16) * 1024;
#pragma unroll
                for (int bj = 0; bj < 2; ++bj) { const f32x4 v0 = acc[ai][bj][m][0], v1 = acc[ai][bj][m][1];
                    u32x4 w; w.x = cvt_pk_bf16(v0[0], v0[1]); w.y = cvt_pk_bf16(v0[2], v0[3]); w.z = cvt_pk_bf16(v1[0], v1[1]); w.w = cvt_pk_bf16(v1[2], v1[3]);
                    *(u32x4*)(rowp + bj * HALF) = w; } }
    }
};
struct EpiBf16I8 {
    static constexpr bool PERM = true;
    bf16_t* O; int ldc; const float* sa; const float* swd;
    __device__ __forceinline__ void operator()(const i32x4 (&acc)[2][2][4][2], const Unit& u, int wr, int wc, int fr_, int fq) const {
        const int fr = fr_;
        const int row0 = u.pm * BM + wr * 64 + fr, col0 = u.pn * BM + wc * 32 + 8 * fq;
        f32x4 sw[2][2];
#pragma unroll
        for (int bj = 0; bj < 2; ++bj) { sw[bj][0] = *(const f32x4*)(swd + col0 + bj * HALF); sw[bj][1] = *(const f32x4*)(swd + col0 + bj * HALF + 4); }
        float srv[2][4];
#pragma unroll
        for (int ai = 0; ai < 2; ++ai)
#pragma unroll
            for (int m = 0; m < 4; ++m) srv[ai][m] = sa[row0 + ai * HALF + m * 16];
#pragma unroll
        for (int ai = 0; ai < 2; ++ai)
#pragma unroll
            for (int m = 0; m < 4; ++m) { const int row = row0 + ai * HALF + m * 16; bf16_t* rowp = O + (size_t)row * ldc + col0; const float sr = srv[ai][m];
#pragma unroll
                for (int bj = 0; bj < 2; ++bj) { const i32x4 a0 = acc[ai][bj][m][0], a1 = acc[ai][bj][m][1]; const f32x4 s0 = sw[bj][0] * sr, s1 = sw[bj][1] * sr;
                    u32x4 w; w.x = cvt_pk_bf16((float)a0[0] * s0[0], (float)a0[1] * s0[1]); w.y = cvt_pk_bf16((float)a0[2] * s0[2], (float)a0[3] * s0[3]);
                    w.z = cvt_pk_bf16((float)a1[0] * s1[0], (float)a1[1] * s1[1]); w.w = cvt_pk_bf16((float)a1[2] * s1[2], (float)a1[3] * s1[3]);
                    *(u32x4*)(rowp + bj * HALF) = w; } }
    }
};
struct EpiSwiGLU {
    static constexpr bool PERM = true;
    bf16_t* O; int ldc;
    __device__ __forceinline__ void operator()(const f32x4 (&acc)[2][2][4][2], const Unit& u, int wr, int wc, int fr_, int fq) const {
        const int fr = fr_;
        const int row0 = u.pm * BM + wr * 64 + fr, col0 = u.pn * HALF + wc * 32 + 8 * fq;
#pragma unroll
        for (int ai = 0; ai < 2; ++ai)
#pragma unroll
            for (int m = 0; m < 4; ++m) { bf16_t* rowp = O + (size_t)(row0 + ai * HALF + m * 16) * ldc + col0;
                float h[8];
#pragma unroll
                for (int n = 0; n < 2; ++n)
#pragma unroll
                    for (int e = 0; e < 4; ++e) { const float g = acc[ai][0][m][n][e], up = acc[ai][1][m][n][e]; h[n * 4 + e] = g * __builtin_amdgcn_rcpf(1.f + __builtin_amdgcn_exp2f(-1.4426950408889634f * g)) * up; }
                u32x4 w; w.x = cvt_pk_bf16(h[0], h[1]); w.y = cvt_pk_bf16(h[2], h[3]); w.z = cvt_pk_bf16(h[4], h[5]); w.w = cvt_pk_bf16(h[6], h[7]);
                *(u32x4*)rowp = w; }
    }
};
struct EpiSwiGLUI8 {
    static constexpr bool PERM = true;
    bf16_t* O; int ldc; const float* sa; const float* swd;
    __device__ __forceinline__ void operator()(const i32x4 (&acc)[2][2][4][2], const Unit& u, int wr, int wc, int fr_, int fq) const {
        const int fr = fr_;
        const int row0 = u.pm * BM + wr * 64 + fr, col0 = u.pn * HALF + wc * 32 + 8 * fq;
        const float* sw = swd + (u.boff / ((size_t)2 * EXD * 1024)) * (size_t)(2 * EXD) + u.pn * BM + wc * 32 + 8 * fq;
        const f32x4 sg0 = *(const f32x4*)sw, sg1 = *(const f32x4*)(sw + 4), su0 = *(const f32x4*)(sw + HALF), su1 = *(const f32x4*)(sw + HALF + 4);
        const float sgv[8] = {sg0.x, sg0.y, sg0.z, sg0.w, sg1.x, sg1.y, sg1.z, sg1.w}, suv[8] = {su0.x, su0.y, su0.z, su0.w, su1.x, su1.y, su1.z, su1.w};
        float srv[2][4];
#pragma unroll
        for (int ai = 0; ai < 2; ++ai)
#pragma unroll
            for (int m = 0; m < 4; ++m) srv[ai][m] = sa[row0 + ai * HALF + m * 16];
#pragma unroll
        for (int ai = 0; ai < 2; ++ai)
#pragma unroll
            for (int m = 0; m < 4; ++m) { const int row = row0 + ai * HALF + m * 16; bf16_t* rowp = O + (size_t)row * ldc + col0; const float sr = srv[ai][m];
                float h[8];
#pragma unroll
                for (int n = 0; n < 2; ++n)
#pragma unroll
                    for (int e = 0; e < 4; ++e) { const float g = (float)acc[ai][0][m][n][e] * (sr * sgv[n * 4 + e]), up = (float)acc[ai][1][m][n][e] * (sr * suv[n * 4 + e]);
                        h[n * 4 + e] = g * __builtin_amdgcn_rcpf(1.f + __builtin_amdgcn_exp2f(-1.4426950408889634f * g)) * up; }
                u32x4 w; w.x = cvt_pk_bf16(h[0], h[1]); w.y = cvt_pk_bf16(h[2], h[3]); w.z = cvt_pk_bf16(h[4], h[5]); w.w = cvt_pk_bf16(h[6], h[7]);
                *(u32x4*)rowp = w; }
    }
};
struct EpiResid {
    static constexpr bool PERM = true;
    bf16_t* X16; float* CX; const float* mod; int gidx; int grp; int skip_ctx;
    __device__ __forceinline__ void operator()(const f32x4 (&acc)[2][2][4][2], const Unit& u, int wr, int wc, int fr_, int fq) const {
        const int fr = fr_;
        const int bl = u.pm / 33, tt = u.pm % 33, b = grp * GB + bl;
        const int col0 = u.pn * BM + wc * 32 + 8 * fq;
        if (tt == 0) { if (skip_ctx) return;
            float* base = CX + (size_t)b * CTXL * DM; const float* gate = mod + 8 * MOD_ROW + gidx * DM;
#pragma unroll
            for (int bj = 0; bj < 2; ++bj) { const f32x4 g0 = *(const f32x4*)(gate + col0 + bj * HALF), g1 = *(const f32x4*)(gate + col0 + bj * HALF + 4);
#pragma unroll
                for (int ai = 0; ai < 2; ++ai) {
#pragma unroll
                    for (int m = 0; m < 4; ++m) { f32x4* p = (f32x4*)(base + (size_t)(ai * HALF + wr * 64 + m * 16 + fr) * DM + col0 + bj * HALF); p[0] = p[0] + g0 * acc[ai][bj][m][0]; p[1] = p[1] + g1 * acc[ai][bj][m][1]; }
                    asm volatile("" ::: "memory"); } }
        } else {
            bf16_t* base = X16 + ((size_t)bl * SEQ + (size_t)(tt - 1) * 256) * DM; const float* gate = mod + b * MOD_ROW + gidx * DM;
#pragma unroll
            for (int bj = 0; bj < 2; ++bj) { const f32x4 g0 = *(const f32x4*)(gate + col0 + bj * HALF), g1 = *(const f32x4*)(gate + col0 + bj * HALF + 4);
#pragma unroll
                for (int ai = 0; ai < 2; ++ai) {
#pragma unroll
                    for (int m = 0; m < 4; ++m) { u32x4* p = (u32x4*)(base + (size_t)(ai * HALF + wr * 64 + m * 16 + fr) * DM + col0 + bj * HALF); const u32x4 w = *p; const f32x4 a0 = acc[ai][bj][m][0], a1 = acc[ai][bj][m][1];
                        u32x4 o; o.x = cvt_pk_bf16(bflo(w.x) + g0.x * a0.x, bfhi(w.x) + g0.y * a0.y); o.y = cvt_pk_bf16(bflo(w.y) + g0.z * a0.z, bfhi(w.y) + g0.w * a0.w);
                        o.z = cvt_pk_bf16(bflo(w.z) + g1.x * a1.x, bfhi(w.z) + g1.y * a1.y); o.w = cvt_pk_bf16(bflo(w.w) + g1.z * a1.z, bfhi(w.w) + g1.w * a1.w); *p = o; }
                    } asm volatile("" ::: "memory"); }
        }
    }
};

struct EpiCtxPartial {
    static constexpr bool PERM = false;
    float* PART;
    __device__ __forceinline__ void operator()(const f32x4 (&acc)[2][2][4][2], const Unit& u, int wr, int wc, int fr_, int fq) const {
        int fr = fr_; asm volatile("" : "+v"(fr));
        const int bl = u.pm / 33, sl = (int)(u.aoff >> 9);
        float* base = PART + ((size_t)sl * (GB * CTXL) + (size_t)bl * CTXL) * DM;
        const int col0 = u.pn * BM + wc * 32 + 4 * fq;
#pragma unroll
        for (int ai = 0; ai < 2; ++ai)
#pragma unroll
            for (int m = 0; m < 4; ++m) { float* rowp = base + (size_t)(ai * HALF + wr * 64 + m * 16 + fr) * DM + col0;
#pragma unroll
                for (int bj = 0; bj < 2; ++bj)
#pragma unroll
                    for (int n = 0; n < 2; ++n) *(f32x4*)(rowp + bj * HALF + n * 16) = acc[ai][bj][m][n]; }
    }
};

template <bool I8> struct AccT { typedef f32x4 T; };
template <> struct AccT<true> { typedef i32x4 T; };
template <class Epi, class Sched, bool ALIGN_EPI = true, bool SP2 = true, bool I8 = false, bool GATHER = false>
__device__ __forceinline__ void gemm_phase(LAS unsigned char* lds, const Gemm g, const Sched& S, const Epi& E, const int tid) {
    const int wid = __builtin_amdgcn_readfirstlane(tid >> 6), lane = tid & 63, wr = wid >> 2, wc = wid & 3, fr = lane & 15, fq = lane >> 4;
    constexpr int ES = I8 ? 1 : 2; typedef typename AccT<I8>::T acc_t;
    const int K = g.K, nt = K * ES / (BK * 2);
    unsigned voffA[2], voffB[2];
    int gRow[2]; unsigned gC2[2];
#pragma unroll
    for (int i = 0; i < 2; ++i) { int R, C; stage_rc(tid * 16 + i * 8192, R, C); const int Rb = Epi::PERM ? ((R & ~31) + perm32(R & 31)) : R;
        voffA[i] = (unsigned)(R * g.lda * ES + C * 2); voffB[i] = (unsigned)(Rb * g.ldb * ES + C * 2); gRow[i] = R; gC2[i] = (unsigned)(C * 2); }
    unsigned vc0[2], vc1[2], vn0[2], vn1[2], vq0[2], vq1[2];
#define PG8_GATH(u, v0, v1) do { _Pragma("unroll") for (int _i = 0; _i < 2; ++_i) { const GAS int* _tp = (const GAS int*)g.rowtab + (u).pm * BM + gRow[_i]; \
        v0[_i] = (unsigned)_tp[0] * (unsigned)(g.lda * ES) + gC2[_i]; v1[_i] = (unsigned)_tp[HALF] * (unsigned)(g.lda * ES) + gC2[_i]; } } while (0)
    const size_t kstep = (size_t)(BK * 2);
    const size_t hstepA = GATHER ? (size_t)0 : (size_t)HALF * g.lda * ES, hstepB = (size_t)HALF * g.ldb * ES;
    const size_t tstepA = 2 * hstepA, tstepB = 2 * hstepB;
    const unsigned ldsw = (unsigned)wid * 1024u;
    const int aoff = lds_byte(wr * 64 + fr, fq * 8), boff = lds_byte(wc * 32 + fr, fq * 8);
#define PG8_SA(b, h) (((b) * 2 + (h)) * HTB)
#define PG8_SB(b, h) ((4 + (b) * 2 + (h)) * HTB)
#define PG8_STAGE(bufoff, gbase, voff) do { _Pragma("unroll") for (int _i = 0; _i < 2; ++_i) \
        __builtin_amdgcn_global_load_lds((const unsigned*)((const char*)(gbase) + (voff)[_i]), (LAS unsigned*)(lds + (bufoff) + ldsw + _i * 8192), 16, 0, 0); } while (0)
#define PG8_LDA(dst, b, h) do { _Pragma("unroll") for (int m = 0; m < 4; ++m) _Pragma("unroll") for (int k = 0; k < 2; ++k) dst[m][k] = *(const LAS bf16x8*)(lds + PG8_SA(b, h) + aoff + m * 2048 + k * 1024); } while (0)
#define PG8_LDB(dst, b, h) do { _Pragma("unroll") for (int n = 0; n < 2; ++n) _Pragma("unroll") for (int k = 0; k < 2; ++k) dst[n][k] = *(const LAS bf16x8*)(lds + PG8_SB(b, h) + boff + n * 2048 + k * 1024); } while (0)
#define PG8_MMA(ai, bj, At, Bt) do { __builtin_amdgcn_s_setprio(1); _Pragma("unroll") for (int m = 0; m < 4; ++m) _Pragma("unroll") for (int n = 0; n < 2; ++n) _Pragma("unroll") for (int k = 0; k < 2; ++k) \
        { if constexpr (I8) acc[ai][bj][m][n] = __builtin_amdgcn_mfma_i32_16x16x64_i8(__builtin_bit_cast(i32x4, Bt[n][k]), __builtin_bit_cast(i32x4, At[m][k]), acc[ai][bj][m][n], 0, 0, 0); \
          else acc[ai][bj][m][n] = __builtin_amdgcn_mfma_f32_16x16x32_bf16(Bt[n][k], At[m][k], acc[ai][bj][m][n], 0, 0, 0); } __builtin_amdgcn_s_setprio(0); } while (0)
#define PG8_WAIT_V(n) asm volatile("s_waitcnt vmcnt(" #n ")" ::: "memory")
#define PG8_WAIT_L(n) asm volatile("s_waitcnt lgkmcnt(" #n ")" ::: "memory")
#define PG8_BAR __builtin_amdgcn_s_barrier()
#define PG8_SCHED __builtin_amdgcn_sched_barrier(0)
    Unit cur, nxt; int ui = 0;
    if (!S.next(0, cur)) return;
    acc_t acc[2][2][4][2];
#pragma unroll
    for (int a = 0; a < 2; ++a)
#pragma unroll
        for (int b = 0; b < 2; ++b)
#pragma unroll
            for (int m = 0; m < 4; ++m)
#pragma unroll
                for (int n = 0; n < 2; ++n) acc[a][b][m][n] = acc_t{};
    bf16x8 At[4][2], B0[2][2], B1[2][2];
    const char* cA = (const char*)g.A + cur.aoff + (size_t)cur.pm * tstepA; const char* cB = (const char*)g.Bt + cur.boff + (size_t)cur.pn * tstepB;
    if constexpr (GATHER) { PG8_GATH(cur, vc0, vc1); Unit t1; if (S.next(1, t1)) PG8_GATH(t1, vn0, vn1); else { vn0[0] = vc0[0]; vn0[1] = vc0[1]; vn1[0] = vc1[0]; vn1[1] = vc1[1]; } }
    else {
#pragma unroll
        for (int i = 0; i < 2; ++i) { vc0[i] = vc1[i] = vn0[i] = vn1[i] = voffA[i]; } }
    if constexpr (SP2) {
        PG8_STAGE(PG8_SB(0, 0), cB, voffB); PG8_STAGE(PG8_SB(0, 1), cB + hstepB, voffB); PG8_STAGE(PG8_SA(0, 0), cA, vc0); PG8_STAGE(PG8_SA(0, 1), cA + hstepA, vc1);
        if (wr == 1) PG8_BAR;
        PG8_WAIT_V(2); PG8_BAR;
        PG8_STAGE(PG8_SB(1, 0), cB + kstep, voffB); PG8_STAGE(PG8_SA(1, 0), cA + kstep, vc0); PG8_STAGE(PG8_SB(1, 1), cB + hstepB + kstep, voffB);
        PG8_WAIT_V(6); PG8_BAR;
    } else {
        PG8_STAGE(PG8_SB(0, 0), cB, voffB); PG8_STAGE(PG8_SA(0, 0), cA, voffA); PG8_STAGE(PG8_SB(0, 1), cB + hstepB, voffB); PG8_STAGE(PG8_SA(0, 1), cA + hstepA, voffA);
        if (wr == 1) PG8_BAR;
        PG8_WAIT_V(4); PG8_BAR;
        PG8_STAGE(PG8_SB(1, 0), cB + kstep, voffB); PG8_STAGE(PG8_SA(1, 0), cA + kstep, voffA); PG8_STAGE(PG8_SB(1, 1), cB + hstepB + kstep, voffB);
        PG8_WAIT_V(6); PG8_BAR;
    }
    for (;;) {
        const bool has_next = S.next(ui + 1, nxt);
        const char* nA = has_next ? (const char*)g.A + nxt.aoff + (size_t)nxt.pm * tstepA : cA; const char* nB = has_next ? (const char*)g.Bt + nxt.boff + (size_t)nxt.pn * tstepB : cB;
        for (int t = 0; t < nt; t += 2) {
            const bool last = (t == nt - 2);
            const char* a1 = cA + (size_t)(t + 1) * kstep;
            const char* a2 = last ? nA : cA + (size_t)(t + 2) * kstep; const char* b2 = last ? nB : cB + (size_t)(t + 2) * kstep;
            const char* a3 = a2 + kstep; const char* b3 = b2 + kstep;
            if constexpr (SP2) {
            unsigned sA0[2], sA1[2];
            if constexpr (GATHER) {
#pragma unroll
                for (int i = 0; i < 2; ++i) { sA0[i] = last ? vn0[i] : vc0[i]; sA1[i] = last ? vn1[i] : vc1[i]; } }
            else { sA0[0] = sA1[0] = voffA[0]; sA0[1] = sA1[1] = voffA[1]; }
            PG8_LDB(B0, 0, 0); PG8_LDB(B1, 0, 1); PG8_SCHED; PG8_LDA(At, 0, 0); PG8_STAGE(PG8_SA(1, 1), a1 + hstepA, vc1);
            PG8_WAIT_V(8); PG8_WAIT_L(0); PG8_BAR; PG8_MMA(0, 0, At, B0); PG8_MMA(0, 1, At, B1); PG8_BAR; PG8_SCHED;
            PG8_LDA(At, 0, 1); PG8_STAGE(PG8_SB(0, 0), b2, voffB); PG8_STAGE(PG8_SB(0, 1), b2 + hstepB, voffB); PG8_STAGE(PG8_SA(0, 0), a2, sA0);
            PG8_WAIT_V(8); PG8_WAIT_L(0); PG8_BAR; PG8_MMA(1, 0, At, B0); PG8_MMA(1, 1, At, B1); PG8_BAR; PG8_SCHED;
            PG8_LDB(B0, 1, 0); PG8_LDB(B1, 1, 1); PG8_SCHED; PG8_LDA(At, 1, 0); PG8_STAGE(PG8_SA(0, 1), a2 + hstepA, sA1);
            PG8_WAIT_V(8); PG8_WAIT_L(0); PG8_BAR; PG8_MMA(0, 0, At, B0); PG8_MMA(0, 1, At, B1); PG8_BAR; PG8_SCHED;
            PG8_LDA(At, 1, 1); PG8_STAGE(PG8_SB(1, 0), b3, voffB); PG8_STAGE(PG8_SB(1, 1), b3 + hstepB, voffB); PG8_STAGE(PG8_SA(1, 0), a3, sA0);
            PG8_WAIT_V(8); PG8_WAIT_L(0); PG8_BAR; PG8_MMA(1, 0, At, B0); PG8_MMA(1, 1, At, B1); PG8_BAR; PG8_SCHED;
            } else {
            PG8_LDB(B0, 0, 0); PG8_SCHED; PG8_LDA(At, 0, 0); PG8_STAGE(PG8_SA(1, 1), a1 + hstepA, voffA);
            PG8_WAIT_L(8); PG8_BAR; PG8_WAIT_L(0); PG8_MMA(0, 0, At, B0); PG8_BAR; PG8_SCHED;
            PG8_LDB(B1, 0, 1); PG8_STAGE(PG8_SB(0, 0), b2, voffB);
            PG8_BAR; PG8_WAIT_L(0); PG8_MMA(0, 1, At, B1); PG8_BAR;
            PG8_LDA(At, 0, 1); PG8_STAGE(PG8_SA(0, 0), a2, voffA);
            PG8_BAR; PG8_WAIT_L(0); PG8_MMA(1, 0, At, B0); PG8_BAR; PG8_SCHED;
            PG8_STAGE(PG8_SB(0, 1), b2 + hstepB, voffB);
            PG8_WAIT_V(6); PG8_BAR; PG8_MMA(1, 1, At, B1); PG8_BAR;
            PG8_LDB(B0, 1, 0); PG8_SCHED; PG8_LDA(At, 1, 0); PG8_STAGE(PG8_SA(0, 1), a2 + hstepA, voffA);
            PG8_WAIT_L(8); PG8_BAR; PG8_WAIT_L(0); PG8_MMA(0, 0, At, B0); PG8_BAR; PG8_SCHED;
            PG8_LDB(B1, 1, 1); PG8_STAGE(PG8_SB(1, 0), b3, voffB);
            PG8_BAR; PG8_WAIT_L(0); PG8_MMA(0, 1, At, B1); PG8_BAR;
            PG8_LDA(At, 1, 1); PG8_STAGE(PG8_SA(1, 0), a3, voffA);
            PG8_BAR; PG8_WAIT_L(0); PG8_MMA(1, 0, At, B0); PG8_BAR; PG8_SCHED;
            PG8_STAGE(PG8_SB(1, 1), b3 + hstepB, voffB);
            PG8_WAIT_V(6); PG8_BAR; PG8_MMA(1, 1, At, B1); PG8_BAR;
            }
        }
        if constexpr (ALIGN_EPI) { if (wr == 0) PG8_BAR; }
        bool has_q = false;
        if constexpr (GATHER) { Unit t2; has_q = has_next && S.next(ui + 2, t2); if (has_q) PG8_GATH(t2, vq0, vq1); }
        E(acc, cur, wr, wc, fr, fq);
        if (!has_next) break;
        if constexpr (GATHER) {
#pragma unroll
            for (int i = 0; i < 2; ++i) { vc0[i] = vn0[i]; vc1[i] = vn1[i]; if (has_q) { vn0[i] = vq0[i]; vn1[i] = vq1[i]; } } }
#pragma unroll
        for (int a = 0; a < 2; ++a)
#pragma unroll
            for (int b = 0; b < 2; ++b)
#pragma unroll
                for (int m = 0; m < 4; ++m)
#pragma unroll
                    for (int n = 0; n < 2; ++n) acc[a][b][m][n] = acc_t{};
        cur = nxt; cA = nA; cB = nB; ++ui;
        if constexpr (ALIGN_EPI) { if (wr == 1) PG8_BAR; }
    }
    PG8_WAIT_V(0);
    if constexpr (!ALIGN_EPI) { if (wr == 0) PG8_BAR; }
    PG8_BAR;
#undef PG8_GATH
#undef PG8_SA
#undef PG8_SB
#undef PG8_STAGE
#undef PG8_LDA
#undef PG8_LDB
#undef PG8_MMA
#undef PG8_WAIT_V
#undef PG8_WAIT_L
#undef PG8_BAR
#undef PG8_SCHED
}
}

#define XB_TMO      128
#define XB_XCNT(j)  (256  + 64 * (j))
#define XB_XSUB(j)  (1280 + 64 * (j))
#define XB_XGEN(j)  (2304 + 64 * (j))
#define XB_TOP      3328
#define XB_TOPGEN   3392
#define XCD_BAR_WORDS 3456
#define XB_SPIN_CAP (1u << 22)
__device__ __forceinline__ unsigned xb_ld(unsigned* p)              { return __hip_atomic_load(p, __ATOMIC_RELAXED, __HIP_MEMORY_SCOPE_AGENT); }
__device__ __forceinline__ unsigned xb_add(unsigned* p, unsigned v) { return __hip_atomic_fetch_add(p, v, __ATOMIC_RELAXED, __HIP_MEMORY_SCOPE_AGENT); }
__device__ __forceinline__ unsigned xb_xcc_id() { return (unsigned)__builtin_amdgcn_s_getreg((3 << 11) | 20) & 0xFu; }
#define XB_SPIN(cond, bar) do { unsigned _sp = 0; while (cond) { __builtin_amdgcn_s_sleep(1); \
    if ((++_sp & 255u) == 0u) { if (xb_ld(&(bar)[XB_TMO])) break; if (_sp > XB_SPIN_CAP) { atomicAdd(&(bar)[XB_TMO], 1u); break; } } } } while (0)
struct XcdBarrier { unsigned* bar; unsigned x; volatile LAS unsigned* st; };
__device__ __forceinline__ XcdBarrier xcd_barrier_post(unsigned* bar, volatile LAS unsigned* st) {
    XcdBarrier b; b.bar = bar; b.x = xb_xcc_id(); b.st = st;
    if (threadIdx.x == 0) (void)xb_add(&bar[XB_XCNT(b.x)], 1u);
    return b;
}
__device__ __forceinline__ void xcd_barrier_complete(unsigned* bar, unsigned x, unsigned& nloc, unsigned& nx) {
    const unsigned G = gridDim.x * gridDim.y * gridDim.z;
    unsigned sum, cnt, mine, sp = 0u;
    for (;;) {
        sum = 0u; cnt = 0u; mine = 0u;
#pragma unroll
        for (unsigned j = 0; j < 16; ++j) { const unsigned c = xb_ld(&bar[XB_XCNT(j)]); sum += c; cnt += (c > 0u) ? 1u : 0u; mine = (j == x) ? c : mine; }
        if (sum == G) break;
        __builtin_amdgcn_s_sleep(1);
        if ((++sp & 255u) == 0u) { if (xb_ld(&bar[XB_TMO])) break; if (sp > XB_SPIN_CAP) { atomicAdd(&bar[XB_TMO], 1u); break; } }
    }
    nloc = mine > 0u ? mine : 1u; nx = cnt > 0u ? cnt : 1u;
}
__device__ __forceinline__ void xcd_barrier(const XcdBarrier& b) {
    asm volatile("s_waitcnt vmcnt(0)" ::: "memory");
    __syncthreads();
    if (threadIdx.x == 0) {
        unsigned* bar = b.bar;
        __builtin_amdgcn_s_waitcnt(0);
        unsigned nloc = b.st[0], nx = b.st[1];
        if (nloc == 0u) { xcd_barrier_complete(bar, b.x, nloc, nx); b.st[0] = nloc; b.st[1] = nx; }
        const unsigned old = xb_add(&bar[XB_XSUB(b.x)], 1u);
        const unsigned gen = old / nloc;
        if (old + 1u == (gen + 1u) * nloc) {
            __builtin_amdgcn_fence(__ATOMIC_RELEASE, "agent");
            asm volatile("s_waitcnt vmcnt(0)" ::: "memory");
            const unsigned og = xb_add(&bar[XB_TOP], 1u);
            const unsigned tg = og / nx;
            if (og + 1u == (tg + 1u) * nx) xb_add(&bar[XB_TOPGEN], 1u);
            else XB_SPIN(xb_ld(&bar[XB_TOPGEN]) == tg, bar);
            __builtin_amdgcn_fence(__ATOMIC_ACQUIRE, "agent");
            xb_add(&bar[XB_XGEN(b.x)], 1u);
            asm volatile("s_waitcnt vmcnt(0)" ::: "memory");
        } else {
            XB_SPIN(xb_ld(&bar[XB_XGEN(b.x)]) == gen, bar);
            __builtin_amdgcn_fence(__ATOMIC_ACQUIRE, "agent");
            asm volatile("s_waitcnt vmcnt(0)" ::: "memory");
        }
    }
    __syncthreads();
}

namespace att {
#define SBAR() __builtin_amdgcn_sched_barrier(0)
__device__ __forceinline__ int crow(int r, int hi) { return (r & 3) + 8 * (r >> 2) + 4 * hi; }
template <int KPB> __device__ __forceinline__ int kswz(int row, int colB) {
    if constexpr (KPB == 128) return row * 128 + (colB ^ (((row >> 1) & 7) << 4));
    else return row * 256 + (colB ^ ((row & 15) << 4));
}
template <int NCB> __device__ __forceinline__ int v_st(int k, int c) { const int kk = k; return ((kk >> 3) * NCB + (c >> 5)) * 512 + ((kk & 7) * 32 + (c & 31)) * 2; }
__device__ __forceinline__ int v_rd_base(int lane) { return ((lane & 3) << 3) | (((lane >> 2) & 3) << 6) | (((lane >> 4) & 1) << 5) | (((lane >> 5) & 1) << 8); }
template <int OFF> __device__ __forceinline__ s16x4 tr_read(int vb) { s16x4 r; asm volatile("ds_read_b64_tr_b16 %0, %1 offset:%2" : "=&v"(r) : "v"(vb), "i"(OFF) : "memory"); return r; }

constexpr float ATT_THR = 11.541560327111707f;
template <bool FIRST>
__device__ __forceinline__ void partialSM(f32x16& p0, f32x16& p1, float& mhat, float& alpha, const bool nomax) {
    alpha = 1.f;
    if (!nomax) {
        float pmax = fmaxf(p0[0], p1[0]);
#pragma unroll
        for (int r = 1; r < 16; ++r) pmax = fmaxf(fmaxf(pmax, p0[r]), p1[r]);
        { auto rr = __builtin_amdgcn_permlane32_swap(__float_as_uint(pmax), __float_as_uint(pmax), false, false);
          pmax = fmaxf(__uint_as_float(rr[0]), __uint_as_float(rr[1])); }
        const float d = pmax - mhat; const bool move = FIRST ? (d > ATT_THR || d < -ATT_THR) : (d > ATT_THR);
        if (__builtin_expect(__any(move), 0)) { const float mn = move ? pmax : mhat; alpha = FIRST ? 1.f : __builtin_amdgcn_exp2f(mhat - mn); mhat = mn; }
        if (__builtin_expect(__any(mhat != 0.f), 0)) {
#pragma unroll
            for (int r = 0; r < 16; ++r) { p0[r] -= mhat; p1[r] -= mhat; } }
    }
#pragma unroll
    for (int r = 0; r < 16; ++r) p0[r] = __builtin_amdgcn_exp2f(p0[r]);
}
template <bool LM>
__device__ __forceinline__ void finishSM(f32x16& p0, f32x16& p1, float alpha, float& l_reg, bf16x8& pa0, bf16x8& pa1, bf16x8& pa2, bf16x8& pa3) {
#pragma unroll
    for (int r = 0; r < 16; ++r) p1[r] = __builtin_amdgcn_exp2f(p1[r]);
    if constexpr (!LM) { float ps = 0;
#pragma unroll
        for (int r = 0; r < 16; ++r) ps += p0[r];
#pragma unroll
        for (int r = 0; r < 16; ++r) ps += p1[r];
        { auto rr = __builtin_amdgcn_permlane32_swap(__float_as_uint(ps), __float_as_uint(ps), false, false);
          ps = __uint_as_float(rr[0]) + __uint_as_float(rr[1]); }
        l_reg = l_reg * alpha + ps; }
#define PK4(P, BASE, OUT) do { const u32x4 w = {cvt_pk_bf16(P[BASE + 0], P[BASE + 1]), cvt_pk_bf16(P[BASE + 2], P[BASE + 3]), cvt_pk_bf16(P[BASE + 4], P[BASE + 5]), cvt_pk_bf16(P[BASE + 6], P[BASE + 7])}; \
    OUT = __builtin_bit_cast(bf16x8, w); } while (0)
    PK4(p0, 0, pa0); PK4(p0, 8, pa1); PK4(p1, 0, pa2); PK4(p1, 8, pa3);
#undef PK4
}
template <int DQK, int KPB> __device__ __forceinline__ void qkt(f32x16& p0, f32x16& p1, const char* Ks, const bf16x8* qr, int r32, int hi) {
    p0 = f32x16{}; p1 = f32x16{};
#pragma unroll
    for (int d0 = 0; d0 < DQK / 16; ++d0) { const int cb = (d0 * 16 + hi * 8) * 2;
        const bf16x8 b0 = *reinterpret_cast<const bf16x8*>(Ks + kswz<KPB>(r32, cb));
        const bf16x8 b1 = *reinterpret_cast<const bf16x8*>(Ks + kswz<KPB>(32 + r32, cb));
        p0 = __builtin_amdgcn_mfma_f32_32x32x16_bf16(b0, qr[d0], p0, 0, 0, 0);
        p1 = __builtin_amdgcn_mfma_f32_32x32x16_bf16(b1, qr[d0], p1, 0, 0, 0); }
}
template <int NCB, int D0> __device__ __forceinline__ void pv_one(f32x16& od, int vb, bf16x8 pa0, bf16x8 pa1, bf16x8 pa2, bf16x8 pa3) {
    constexpr int KS = 2 * NCB * 512, HF = NCB * 512, B0 = D0 * 512;
    const s16x4 l0 = tr_read<B0>(vb), h0 = tr_read<B0 + HF>(vb), l1 = tr_read<B0 + KS>(vb), h1 = tr_read<B0 + KS + HF>(vb);
    const s16x4 l2 = tr_read<B0 + 2 * KS>(vb), h2 = tr_read<B0 + 2 * KS + HF>(vb), l3 = tr_read<B0 + 3 * KS>(vb), h3 = tr_read<B0 + 3 * KS + HF>(vb);
    asm volatile("s_waitcnt lgkmcnt(0)" ::: "memory"); SBAR();
#define PKV(L, H) (bf16x8){L[0], L[1], L[2], L[3], H[0], H[1], H[2], H[3]}
    od = __builtin_amdgcn_mfma_f32_32x32x16_bf16(pa0, PKV(l0, h0), od, 0, 0, 0);
    od = __builtin_amdgcn_mfma_f32_32x32x16_bf16(pa1, PKV(l1, h1), od, 0, 0, 0);
    od = __builtin_amdgcn_mfma_f32_32x32x16_bf16(pa2, PKV(l2, h2), od, 0, 0, 0);
    od = __builtin_amdgcn_mfma_f32_32x32x16_bf16(pa3, PKV(l3, h3), od, 0, 0, 0);
#undef PKV
}
template <int NCB, bool LM> __device__ __forceinline__ void pv_all(f32x16* o, f32x16& ol, int vb, bf16x8 pa0, bf16x8 pa1, bf16x8 pa2, bf16x8 pa3) {
    pv_one<NCB, 0>(o[0], vb, pa0, pa1, pa2, pa3); pv_one<NCB, 1>(o[1], vb, pa0, pa1, pa2, pa3);
    if constexpr (NCB == 4) { pv_one<NCB, 2>(o[2], vb, pa0, pa1, pa2, pa3); pv_one<NCB, 3>(o[3], vb, pa0, pa1, pa2, pa3); }
    if constexpr (LM) { const bf16x8 ones = {0x3F80, 0x3F80, 0x3F80, 0x3F80, 0x3F80, 0x3F80, 0x3F80, 0x3F80};
        ol = __builtin_amdgcn_mfma_f32_32x32x16_bf16(pa0, ones, ol, 0, 0, 0); ol = __builtin_amdgcn_mfma_f32_32x32x16_bf16(pa1, ones, ol, 0, 0, 0);
        ol = __builtin_amdgcn_mfma_f32_32x32x16_bf16(pa2, ones, ol, 0, 0, 0); ol = __builtin_amdgcn_mfma_f32_32x32x16_bf16(pa3, ones, ol, 0, 0, 0); }
}

template <int DQK, int DV>
__device__ __forceinline__ void attn_unit(const bf16_t* __restrict__ Qb, int ldq, const bf16_t* __restrict__ Kh, int ldk, const bf16_t* __restrict__ Kpe,
                                          const bf16_t* __restrict__ Vh, int ldv, bf16_t* __restrict__ Ob, int ldo, int seq, char* lds, const int tid, const float* ropetab = nullptr, const int rope_t0 = -1, const float kmax2 = -1.f) {
    constexpr int KPB = (DQK == 64) ? 128 : 256, NCB = DV / 32, SHM_K = 64 * KPB, SHM_V = 64 * DV * 2, NV = DV / 64;
    constexpr bool KS = (DQK == 96), LM = false;
    const int wid = tid >> 6, lane = tid & 63, r32 = lane & 31, hi = lane >> 5;
    char* V_lds = lds; char* K_lds = lds + 3 * SHM_V;
    float* ws = (float*)(lds + 3 * SHM_V + 3 * SHM_K) + wid * 64; float* li_l = ws; float* al_l = ws + 32;
    float mhat = 0.f, l_reg = 0; f32x16 o[NCB], ol = f32x16{}; bf16x8 qr[DQK / 16];
#pragma unroll
    for (int d = 0; d < NCB; ++d) o[d] = f32x16{};
    const bf16_t* Qw = Qb + (long)(wid * 32 + r32) * ldq + hi * 8;
#pragma unroll
    for (int d0 = 0; d0 < DQK / 16; ++d0) qr[d0] = *reinterpret_cast<const bf16x8*>(Qw + d0 * 16);
    if constexpr (DQK == 96) { if (rope_t0 >= 0) {
        const int tl = rope_t0 + wid * 32 + r32;
#pragma unroll
        for (int d0 = 4; d0 < 6; ++d0) { const int pos = (d0 == 4) ? (tl >> 6) : (tl & 63); const float* tb = ropetab + pos * 8;
            const f32x4 c0 = *(const f32x4*)tb, c1 = *(const f32x4*)(tb + 4), s0 = *(const f32x4*)(tb + 1024), s1 = *(const f32x4*)(tb + 1028);
            const float cs[8] = {c0.x, c0.y, c0.z, c0.w, c1.x, c1.y, c1.z, c1.w}, sn[8] = {s0.x, s0.y, s0.z, s0.w, s1.x, s1.y, s1.z, s1.w};
            const u32x4 own = __builtin_bit_cast(u32x4, qr[d0]); u32x4 res;
#pragma unroll
            for (int w = 0; w < 4; ++w) { auto rr = __builtin_amdgcn_permlane32_swap(own[w], own[w], false, false); const unsigned oth = hi ? rr[0] : rr[1];
                const float a0 = bflo(own[w]), a1 = bfhi(own[w]), b0 = bflo(oth), b1 = bfhi(oth);
                const float r0 = hi ? (a0 * cs[2 * w] + b0 * sn[2 * w]) : (a0 * cs[2 * w] - b0 * sn[2 * w]);
                const float r1 = hi ? (a1 * cs[2 * w + 1] + b1 * sn[2 * w + 1]) : (a1 * cs[2 * w + 1] - b1 * sn[2 * w + 1]);
                res[w] = pk2(r0, r1); }
            qr[d0] = __builtin_bit_cast(bf16x8, res); } } }
    bool nomax = false;
    if (kmax2 >= 0.f) {
        float qn = 0.f;
#pragma unroll
        for (int d0 = 0; d0 < DQK / 16; ++d0) { const u32x4 w = __builtin_bit_cast(u32x4, qr[d0]);
#pragma unroll
            for (int e = 0; e < 4; ++e) { const float a = bflo(w[e]), b = bfhi(w[e]); qn += a * a + b * b; } }
        { auto rr = __builtin_amdgcn_permlane32_swap(__float_as_uint(qn), __float_as_uint(qn), false, false); qn = __uint_as_float(rr[0]) + __uint_as_float(rr[1]); }
        nomax = __all(qn * kmax2 * 1.1f < 3600.f);
    }
    const int krow = tid >> 3, kch = tid & 7, kst = kswz<KPB>(krow, kch * 16);
    const int k2row = (tid >> 2) & 63, k2ch = tid & 3, k2st = kswz<KPB>(k2row, 128 + k2ch * 16);
    const int vrow = (NV == 1) ? (tid >> 3) : (tid >> 4), vcol = (NV == 1) ? (tid & 7) * 8 : (tid & 15) * 8;
    const int vst0 = v_st<NCB>(vrow, vcol), vst1 = v_st<NCB>(32 + vrow, vcol);
    const int vb0 = (int)(uintptr_t)V_lds + v_rd_base(lane);
    struct { bf16x8 k0, k1, v0, v1; } sr_[2];
    const unsigned koff = (unsigned)(krow * ldk + kch * 8), k2off = (unsigned)(k2row * 32 + k2ch * 8), voff0 = (unsigned)(vrow * ldv + vcol), voff1 = (unsigned)((32 + vrow) * ldv + vcol);
#define SLOAD(i, k0_) do { const bf16_t* kt_ = Kh + (size_t)(k0_) * ldk; const bf16_t* vt_ = Vh + (size_t)(k0_) * ldv; sr_[i].k0 = *reinterpret_cast<const bf16x8*>(kt_ + koff); \
    if constexpr (KS) { if (tid < 256) sr_[i].k1 = *reinterpret_cast<const bf16x8*>(Kpe + (size_t)(k0_) * 32 + k2off); } \
    sr_[i].v0 = *reinterpret_cast<const bf16x8*>(vt_ + voff0); \
    if constexpr (NV == 2) sr_[i].v1 = *reinterpret_cast<const bf16x8*>(vt_ + voff1); } while (0)
#define SWRITE(slot, i) do { char* kd_ = K_lds + (slot) * SHM_K; char* vd_ = V_lds + (slot) * SHM_V; *(bf16x8*)(kd_ + kst) = sr_[i].k0; \
    if constexpr (KS) { if (tid < 256) *(bf16x8*)(kd_ + k2st) = sr_[i].k1; } \
    *(bf16x8*)(vd_ + vst0) = sr_[i].v0; \
    if constexpr (NV == 2) *(bf16x8*)(vd_ + vst1) = sr_[i].v1; } while (0)
    constexpr int NLD = 1 + (KS ? 1 : 0) + NV;
#define SWAIT() do { if constexpr (KS) asm volatile("s_waitcnt vmcnt(2)" ::: "memory"); else if constexpr (NLD == 2) asm volatile("s_waitcnt vmcnt(2)" ::: "memory"); else asm volatile("s_waitcnt vmcnt(3)" ::: "memory"); } while (0)
#define RESC(a) do { if (__any((a) < 1.f)) { if (hi == 0) al_l[r32] = (a); asm volatile("s_waitcnt lgkmcnt(0)" ::: "memory"); \
    _Pragma("unroll") for (int r = 0; r < 16; ++r) { const float f_ = al_l[crow(r, hi)]; _Pragma("unroll") for (int d = 0; d < NCB; ++d) o[d][r] *= f_; if constexpr (LM) ol[r] *= f_; } } } while (0)
    f32x16 pA0, pA1, pB0, pB1; float alA, alB; bf16x8 pa0, pa1, pa2, pa3; const int NT = seq / 64;
    SLOAD(0, 0); asm volatile("s_waitcnt vmcnt(0)" ::: "memory"); SWRITE(0, 0); __syncthreads();
    qkt<DQK, KPB>(pA0, pA1, K_lds, qr, r32, hi); partialSM<true>(pA0, pA1, mhat, alA, nomax);
    SLOAD(1, 64); if (2 < NT) SLOAD(0, 128);
    SWAIT(); SWRITE(1, 1); __syncthreads();
    int sp = 0, sc = 1, sn = 2;
#define ROT() do { const int t_ = sp; sp = sc; sc = sn; sn = t_; } while (0)
    for (int j = 1; j + 1 < NT; j += 2) {
        SBAR(); qkt<DQK, KPB>(pB0, pB1, K_lds + sc * SHM_K, qr, r32, hi);
        finishSM<LM>(pA0, pA1, alA, l_reg, pa0, pa1, pa2, pa3); SBAR();
        SLOAD(1, (j + 2) * 64); SBAR();
        pv_all<NCB, LM>(o, ol, vb0 + sp * SHM_V, pa0, pa1, pa2, pa3); partialSM<false>(pB0, pB1, mhat, alB, nomax);
        SWAIT(); SWRITE(sn, 0);
        RESC(alB); __syncthreads(); ROT();
        SBAR(); qkt<DQK, KPB>(pA0, pA1, K_lds + sc * SHM_K, qr, r32, hi);
        finishSM<LM>(pB0, pB1, alB, l_reg, pa0, pa1, pa2, pa3); SBAR();
        if (j + 3 < NT) SLOAD(0, (j + 3) * 64); SBAR();
        pv_all<NCB, LM>(o, ol, vb0 + sp * SHM_V, pa0, pa1, pa2, pa3); partialSM<false>(pA0, pA1, mhat, alA, nomax);
        SWAIT(); SWRITE(sn, 1);
        RESC(alA); __syncthreads(); ROT();
    }
    SBAR(); qkt<DQK, KPB>(pB0, pB1, K_lds + sc * SHM_K, qr, r32, hi);
    finishSM<LM>(pA0, pA1, alA, l_reg, pa0, pa1, pa2, pa3); SBAR();
    pv_all<NCB, LM>(o, ol, vb0 + sp * SHM_V, pa0, pa1, pa2, pa3); partialSM<false>(pB0, pB1, mhat, alB, nomax);
    RESC(alB);
    finishSM<LM>(pB0, pB1, alB, l_reg, pa0, pa1, pa2, pa3); SBAR();
    pv_all<NCB, LM>(o, ol, vb0 + sc * SHM_V, pa0, pa1, pa2, pa3);
#undef ROT
    float rli[16];
    if constexpr (LM) {
#pragma unroll
        for (int r = 0; r < 16; ++r) rli[r] = __builtin_amdgcn_rcpf(ol[r]);
    } else { if (hi == 0) li_l[r32] = l_reg; asm volatile("s_waitcnt lgkmcnt(0)" ::: "memory");
#pragma unroll
        for (int r = 0; r < 16; ++r) rli[r] = __builtin_amdgcn_rcpf(li_l[crow(r, hi)]); }
    bf16_t* Ow = Ob + (long)(wid * 32) * ldo;
    { char* stg = lds + 3 * SHM_V + 3 * SHM_K + 8 * 256 + wid * (32 * DV * 2);
#pragma unroll
      for (int r = 0; r < 16; ++r) { const int orow = crow(r, hi);
#pragma unroll
          for (int d0 = 0; d0 < NCB; ++d0) *(bf16_t*)(stg + (orow * DV + d0 * 32 + r32) * 2) = (bf16_t)f2bf(o[d0][r] * rli[r]); }
      asm volatile("s_waitcnt lgkmcnt(0)" ::: "memory");
      constexpr int LPR = DV / 8, RPI = 64 / LPR;
#pragma unroll
      for (int i = 0; i < 32 / RPI; ++i) { const int row = i * RPI + lane / LPR, ch = lane % LPR; const u32x4 v = *(const u32x4*)(stg + (row * DV + ch * 8) * 2); *(u32x4*)(Ow + (long)row * ldo + ch * 8) = v; } }
    __syncthreads();
#undef SLOAD
#undef SWRITE
#undef SWAIT
#undef RESC
}
#undef SBAR
}

struct Frame {
    LAS unsigned char* lds; char* ldsg;
    volatile LAS unsigned* MISC;
    unsigned* ctl;
    int tid, lane, wave, G, gw, NGW;
    float* X; unsigned char* ws;
#define WSP(T, name, off) __device__ __forceinline__ T* name() const { return (T*)(ws + (off)); }
    WSP(float, CX, WS_CX) WSP(float, MOD, WS_MOD) WSP(float, TAB8, WS_TAB8) WSP(float, TAB16, WS_TAB16)
    WSP(bf16_t, HB, WS_HB) WSP(bf16_t, PB, WS_PB) WSP(bf16_t, QR, WS_QR) WSP(bf16_t, KV, WS_KV) WSP(bf16_t, KPE, WS_KPE)
    WSP(bf16_t, GQ, WS_GQ) WSP(bf16_t, GK, WS_GK) WSP(bf16_t, GV, WS_GV) WSP(bf16_t, OF, WS_OF) WSP(bf16_t, OB, WS_OB)
    WSP(bf16_t, ACT1, WS_ACT1) WSP(bf16_t, XG, WS_XG) WSP(float, GG, WS_GG) WSP(float, GBT, WS_GBT) WSP(unsigned char, GPRE, WS_GPRE)
    WSP(float, GCB, WS_GCB) WSP(float, SWD, WS_SWD) WSP(float, SATOK, WS_SATOK) WSP(float, SWD2, WS_SWD2) WSP(bf16_t, X16, WS_X16) WSP(float, PART, WS_PART) WSP(int, TOPE, WS_TOPE) WSP(int, SLOT, WS_SLOT) WSP(float, TOPW, WS_TOPW)
#undef WSP
};
struct ProIn { const float *w_in0, *w_uq, *w_ukv, *w_out0, *w_gu0, *w_d0, *w_in1, *w_out1, *w_gu1, *w_d1, *c, *c_ctx, *mod_w, *mod_b; };
__device__ __forceinline__ void row_bt(int r, int& bl, int& t) { bl = r / TT; t = r - bl * TT; }

__device__ __forceinline__ void p0_transpose_block(const float* W, int K, int N, bf16_t* WT, int ldt, int k0, int n0, int drow, LAS float* scr, int lane, const float sc) {
    float tv[32];
#pragma unroll
    for (int i = 0; i < 32; ++i) { const int kk = 2 * i + (lane >> 5); tv[i] = __builtin_nontemporal_load(W + (size_t)(k0 + kk) * N + n0 + (lane & 31)); }
#pragma unroll
    for (int i = 0; i < 32; ++i) { const int kk = 2 * i + (lane >> 5); scr[kk * 33 + (lane & 31)] = sc * tv[i]; }
    asm volatile("s_waitcnt lgkmcnt(0)" ::: "memory");
    const int c = lane & 7;
#pragma unroll
    for (int j = 0; j < 4; ++j) { const int n = (lane >> 3) + 8 * j; const LAS float* s = scr + (8 * c) * 33 + n;
        u32x4 o; o.x = pk2(s[0 * 33], s[1 * 33]); o.y = pk2(s[2 * 33], s[3 * 33]); o.z = pk2(s[4 * 33], s[5 * 33]); o.w = pk2(s[6 * 33], s[7 * 33]);
        *(u32x4*)(WT + (size_t)(drow + n) * ldt + k0 + 8 * c) = o; }
    asm volatile("s_waitcnt lgkmcnt(0)" ::: "memory");
}
__device__ __forceinline__ void p0_transpose_block_i8(const float* W, int K, int N, signed char* WT, int k0, int n0, int drow, LAS float* scr, int lane, const unsigned* smax, float* swd, const float presc) {
    float tv[32];
#pragma unroll
    for (int i = 0; i < 32; ++i) { const int kk = 2 * i + (lane >> 5); tv[i] = __builtin_nontemporal_load(W + (size_t)(k0 + kk) * N + n0 + (lane & 31)); }
    const float mx = __builtin_bit_cast(float, smax[n0 + (lane & 31)]); const float inv = mx > 0.f ? 127.0f / mx : 0.f;
#pragma unroll
    for (int i = 0; i < 32; ++i) { const int kk = 2 * i + (lane >> 5); scr[kk * 33 + (lane & 31)] = rintf(tv[i] * inv); }
    if (lane < 32 && k0 == 0) swd[drow + lane] = mx * presc * (1.0f / 127.0f);
    asm volatile("s_waitcnt lgkmcnt(0)" ::: "memory");
    const int c = lane & 3;
#pragma unroll
    for (int j = 0; j < 2; ++j) { const int n = (lane >> 2) + 16 * j; const LAS float* sp = scr + (16 * c) * 33 + n; u32x4 o;
#pragma unroll
        for (int q = 0; q < 4; ++q) { const int b0 = (int)sp[(4 * q + 0) * 33], b1 = (int)sp[(4 * q + 1) * 33], b2 = (int)sp[(4 * q + 2) * 33], b3 = (int)sp[(4 * q + 3) * 33];
            o[q] = (unsigned)(b0 & 0xff) | ((unsigned)(b1 & 0xff) << 8) | ((unsigned)(b2 & 0xff) << 16) | ((unsigned)(b3 & 0xff) << 24); }
        *(u32x4*)(WT + (size_t)(drow + n) * K + k0 + 16 * c) = o; }
    asm volatile("s_waitcnt lgkmcnt(0)" ::: "memory");
}
__device__ __forceinline__ int p0_matrix_i8(Frame& F, const float* W, int K, int N, signed char* WT, int F_gu, int base, LAS float* scr, const unsigned* smax, float* swd, int gw = -1, int ngw = 0, const float scale = 1.f, const int nscale = 0) {
    const int nblk = N / 32, items = (K / 64) * nblk; if (gw < 0) { gw = F.gw; ngw = F.NGW; }
    int first = (gw - base) % ngw; if (first < 0) first += ngw;
    for (int it = first; it < items; it += ngw) {
        const int kb = it / nblk, nb = it % nblk, n0 = 32 * nb;
        int drow = n0; if (F_gu) { const int up = n0 >= F_gu ? 1 : 0, f = n0 - up * F_gu; drow = (f >> 7) * 256 + up * 128 + (f & 127); }
        p0_transpose_block_i8(W, K, N, WT, 64 * kb, n0, drow, scr, F.lane, smax, swd, n0 < nscale ? scale : 1.f);
    }
    return base + items;
}
__device__ __forceinline__ int p0_absmax(Frame& F, const float* W, int K, int N, unsigned* smax, int base) {
    const int ncb = N / 64, nkh = K / 512, items = ncb * nkh;
    int first = (F.gw - base) % F.NGW; if (first < 0) first += F.NGW;
    for (int it = first; it < items; it += F.NGW) { const int kh = it % nkh, cb = it / nkh;
        const float* w = W + (size_t)(kh * 512) * N + cb * 64 + F.lane; float m = 0.f;
#pragma unroll 16
        for (int k = 0; k < 512; ++k) m = fmaxf(m, fabsf(w[(size_t)k * N]));
        atomicMax(smax + cb * 64 + F.lane, __builtin_bit_cast(unsigned, m)); }
    return base + items;
}
__device__ __forceinline__ int p0_matrix(Frame& F, const float* W, int K, int N, bf16_t* WT, int F_gu, int base, LAS float* scr, const float scale = 1.f, const int nscale = 0, int gw = -1, int ngw = 0) {
    const int nblk = N / 32, items = (K / 64) * nblk; if (gw < 0) { gw = F.gw; ngw = F.NGW; }
    int first = (gw - base) % ngw; if (first < 0) first += ngw;
    for (int it = first; it < items; it += ngw) {
        const int kb = it / nblk, nb = it % nblk, n0 = 32 * nb;
        int drow = n0;
        if (F_gu) { const int up = n0 >= F_gu ? 1 : 0, f = n0 - up * F_gu; drow = (f >> 7) * 256 + up * 128 + (f & 127); }
        p0_transpose_block(W, K, N, WT, K, 64 * kb, n0, drow, scr, F.lane, n0 < nscale ? scale : 1.f);
    }
    return base + items;
}
__device__ __forceinline__ void p0_strip_i8(Frame& F, const float* W, int N, signed char* WT, int n0, int drow, float* swd, const float presc, int par) {
    LAS float* scr = (LAS float*)(F.lds + F.wave * 16384);
    LAS float* red = (LAS float*)(F.lds + 131072 + par * 2048);
    const int lane = F.lane, kb = F.wave * 128;
    float tv[64];
#pragma unroll
    for (int i = 0; i < 64; ++i) { const int kk = 64 * (i >> 5) + 2 * (i & 31) + (lane >> 5); tv[i] = __builtin_nontemporal_load(W + (size_t)(kb + kk) * N + n0 + (lane & 31)); }
    float m = 0.f;
#pragma unroll
    for (int i = 0; i < 64; ++i) m = fmaxf(m, fabsf(tv[i]));
    red[(F.wave * 2 + (lane >> 5)) * 32 + (lane & 31)] = m;
    __syncthreads();
    float mx = 0.f;
#pragma unroll
    for (int j = 0; j < 16; ++j) mx = fmaxf(mx, red[j * 32 + (lane & 31)]);
    const float inv = mx > 0.f ? 127.0f / mx : 0.f;
    if (F.wave == 0 && lane < 32) swd[drow + lane] = mx * presc * (1.0f / 127.0f);
    const int c = lane & 3;
#pragma unroll
    for (int h = 0; h < 2; ++h) {
#pragma unroll
        for (int i = 0; i < 32; ++i) { const int kk = 2 * i + (lane >> 5); scr[kk * 33 + (lane & 31)] = rintf(tv[32 * h + i] * inv); }
        asm volatile("s_waitcnt lgkmcnt(0)" ::: "memory");
#pragma unroll
        for (int j = 0; j < 2; ++j) { const int n = (lane >> 2) + 16 * j; const LAS float* sp = scr + (16 * c) * 33 + n; u32x4 o;
#pragma unroll
            for (int q = 0; q < 4; ++q) { const int b0 = (int)sp[(4 * q + 0) * 33], b1 = (int)sp[(4 * q + 1) * 33], b2 = (int)sp[(4 * q + 2) * 33], b3 = (int)sp[(4 * q + 3) * 33];
                o[q] = (unsigned)(b0 & 0xff) | ((unsigned)(b1 & 0xff) << 8) | ((unsigned)(b2 & 0xff) << 16) | ((unsigned)(b3 & 0xff) << 24); }
            *(u32x4*)(WT + (size_t)(drow + n) * 1024 + kb + 64 * h + 16 * c) = o; }
        asm volatile("s_waitcnt lgkmcnt(0)" ::: "memory");
    }
}
__device__ __forceinline__ void p0_strips(Frame& F, int wg, int nwg, const float* w_in0, const float* w_gu0, const float* w_in1, const float* w_gu1, int e0, int e1) {
    constexpr int S0 = EV_IN / 32, S1 = 2 * FFN / 32, S2 = OD_IN / 32, SE = 2 * EXD / 32;
    const int nd = w_in0 ? S0 + S1 + S2 : 0, total = nd + (e1 - e0) * SE;
    int par = 0;
    __syncthreads();
    for (int it = wg; it < total; it += nwg, par ^= 1) {
        const float* W; int N, n0, drow, fgu = 0; signed char* WT; float* sd; float presc = 1.f;
        if (it < nd) {
            if (it < S0) { W = w_in0; N = EV_IN; n0 = 32 * it; WT = (signed char*)(F.ws + WS_WI0); sd = F.SWD2(); }
            else if (it < S0 + S1) { W = w_gu0; N = 2 * FFN; n0 = 32 * (it - S0); WT = (signed char*)(F.ws + WS_WGU0); sd = F.SWD2() + EV_INP; fgu = FFN; }
            else { W = w_in1; N = OD_IN; n0 = 32 * (it - S0 - S1); WT = (signed char*)(F.ws + WS_WI1); sd = F.SWD2() + EV_INP + 2 * FFN; if (n0 < 512) presc = ATT_C64; }
        } else { const int j = it - nd, e = e0 + j / SE; n0 = 32 * (j % SE); W = w_gu1 + (size_t)e * 1024 * 2 * EXD; N = 2 * EXD; WT = (signed char*)(F.ws + WS_WGU1) + (size_t)e * 2 * EXD * 1024; sd = F.SWD() + e * (2 * EXD); fgu = EXD; }
        drow = n0; if (fgu) { const int up = n0 >= fgu ? 1 : 0, f = n0 - up * fgu; drow = (f >> 7) * 256 + up * 128 + (f & 127); }
        p0_strip_i8(F, W, N, WT, n0, drow, sd, presc, par);
    }
    if (w_in0) { u32x4 z = {0u, 0u, 0u, 0u}; u32x4* p = (u32x4*)((signed char*)(F.ws + WS_WI0) + (size_t)EV_IN * 1024); const int gw = wg * NWAVES + F.wave, ngw = nwg * NWAVES;
        for (int i = gw * 64 + F.lane; i < (EV_INP - EV_IN) * 1024 / 16; i += ngw * 64) p[i] = z;
        if (gw == 0) F.SWD2()[EV_IN + F.lane] = 0.f; }
    __syncthreads();
}
constexpr int MOE_DEFER_GU = 3;
constexpr int MOE_DEFER_GU_OLD = 8;
__device__ __forceinline__ void p0_deferred(Frame& F, const float* w_gu1, const float* w_d1, int wg, int nwg) {
    LAS float* scr = (LAS float*)(F.lds + F.wave * 16384);
    const int gw = wg * NWAVES + F.wave, ngw = nwg * NWAVES; int base = 0;
    for (int e = 0; e < NEXP; ++e) base = p0_matrix(F, w_d1 + (size_t)e * EXD * 1024, EXD, 1024, (bf16_t*)(F.ws + WS_WD1) + (size_t)e * 1024 * EXD, 0, base, scr, 1.f, 0, gw, ngw);
    __syncthreads();
}
__device__ __forceinline__ void p0_deferred_gu(Frame& F, const float* w_gu1, int e0, int e1, int wg, int nwg, const float* w_in0 = nullptr, const float* w_gu0 = nullptr, const float* w_in1 = nullptr) {
    if (I8_STRIP) { p0_strips(F, wg, nwg, w_in0, w_gu0, w_in1, w_gu1, e0, e1); return; }
    LAS float* scr = (LAS float*)(F.lds + F.wave * 16384);
    const int gw = wg * NWAVES + F.wave, ngw = nwg * NWAVES; int base = 0;
    if (w_in0) {
        unsigned* sm = F.ctl + CW_SWMAX2; float* sd = F.SWD2();
        if (I8_WIN0) base = p0_matrix_i8(F, w_in0, 1024, EV_IN, (signed char*)(F.ws + WS_WI0), 0, base, scr, sm, sd, gw, ngw);
        if (I8_GU0) base = p0_matrix_i8(F, w_gu0, 1024, 2 * FFN, (signed char*)(F.ws + WS_WGU0), FFN, base, scr, sm + EV_IN, sd + EV_INP, gw, ngw);
        if (I8_WIN1) base = p0_matrix_i8(F, w_in1, 1024, OD_IN, (signed char*)(F.ws + WS_WI1), 0, base, scr, sm + EV_IN + 2 * FFN, sd + EV_INP + 2 * FFN, gw, ngw, ATT_C64, 512);
        if (I8_WIN0) { u32x4 z = {0u, 0u, 0u, 0u}; u32x4* p = (u32x4*)((signed char*)(F.ws + WS_WI0) + (size_t)EV_IN * 1024);
          for (int i = gw * 64 + F.lane; i < (EV_INP - EV_IN) * 1024 / 16; i += ngw * 64) p[i] = z;
          if (gw == 0) sd[EV_IN + F.lane] = 0.f; } }
    for (int e = e0; e < e1; ++e) base = p0_matrix_i8(F, w_gu1 + (size_t)e * 1024 * 2 * EXD, 1024, 2 * EXD, (signed char*)(F.ws + WS_WGU1) + (size_t)e * 2 * EXD * 1024, EXD, base, scr, F.ctl + CW_SWMAX + e * (2 * EXD), F.SWD() + e * (2 * EXD), gw, ngw);
    __syncthreads();
}
__device__ __forceinline__ void p0_prologue(Frame& F, const ProIn I) {
    LAS float* scr = (LAS float*)(F.lds + F.wave * 16384);
    unsigned char* ws = F.ws;
    int base = 0;
    if (I8_STRIP) p0_strips(F, (int)blockIdx.x, F.G, I.w_in0, I.w_gu0, I.w_in1, I.w_gu1, 0, MOE_DEFER_GU);
    if (!I8_WIN0) base = p0_matrix(F, I.w_in0, 1024, EV_IN, (bf16_t*)(ws + WS_WI0), 0, base, scr);
    if (!I8_GU0) base = p0_matrix(F, I.w_gu0, 1024, 2 * FFN, (bf16_t*)(ws + WS_WGU0), FFN, base, scr);
    if (!I8_WIN1) base = p0_matrix(F, I.w_in1, 1024, OD_IN, (bf16_t*)(ws + WS_WI1), 0, base, scr, ATT_C64, 512);
    if (!I8_WIN0) { u32x4 z = {0u, 0u, 0u, 0u}; u32x4* p = (u32x4*)((bf16_t*)(ws + WS_WI0) + (size_t)EV_IN * 1024); for (int i = F.gw * 64 + F.lane; i < (EV_INP - EV_IN) * 1024 / 8; i += F.NGW * 64) p[i] = z; }
    base = p0_matrix(F, I.w_uq, 384, 768, (bf16_t*)(ws + WS_WUQ), 0, base, scr, ATT_C96, 768);
    base = p0_matrix(F, I.w_ukv, 256, 1024, (bf16_t*)(ws + WS_WUKV), 0, base, scr);
    base = p0_matrix(F, I.w_out0, 1024, 1024, (bf16_t*)(ws + WS_WO0), 0, base, scr);
    base = p0_matrix(F, I.w_d0, FFN, 1024, (bf16_t*)(ws + WS_WD0), 0, base, scr);
    base = p0_matrix(F, I.w_out1, 1024, 1024, (bf16_t*)(ws + WS_WO1), 0, base, scr);
    if (!I8_STRIP) for (int e = 0; e < NEXP; ++e) base = p0_absmax(F, I.w_gu1 + (size_t)e * 1024 * 2 * EXD, 1024, 2 * EXD, F.ctl + CW_SWMAX + e * (2 * EXD), base);
    if (!I8_STRIP) { base = p0_absmax(F, I.w_in0, 1024, EV_IN, F.ctl + CW_SWMAX2, base); } if (!I8_STRIP) base = p0_absmax(F, I.w_gu0, 1024, 2 * FFN, F.ctl + CW_SWMAX2 + EV_IN, base); if (!I8_STRIP) base = p0_absmax(F, I.w_in1, 1024, OD_IN, F.ctl + CW_SWMAX2 + EV_IN + 2 * FFN, base);
    if (blockIdx.x == F.G - 1) {
        for (int i = F.tid; i < 128 * 8; i += NTHREADS) { const int pos = i >> 3, f = i & 7; const float inv = 1.0f / powf(10000.0f, (float)f / 8.0f); const float a = (float)pos * inv; F.TAB8()[i] = cosf(a); F.TAB8()[1024 + i] = sinf(a); }
        for (int i = F.tid; i < 128 * 16; i += NTHREADS) { const int pos = i >> 4, f = i & 15; const float inv = 1.0f / powf(10000.0f, (float)f / 16.0f); const float a = (float)pos * inv; F.TAB16()[i] = cosf(a); F.TAB16()[2048 + i] = sinf(a); }
    }
    __syncthreads();
    if ((int)blockIdx.x < 192) {
        LAS float* sc = (LAS float*)F.lds;
        LAS float* red = (LAS float*)(F.lds + 40960);
        for (int i = F.tid; i < 9 * 1024; i += NTHREADS) { const int r = i >> 10, k = i & 1023; const float v = (r < 8) ? I.c[r * 1024 + k] : I.c_ctx[k]; sc[i] = silu_f(v); }
        __syncthreads();
        const int layer = blockIdx.x / 96, n0 = (blockIdx.x % 96) * 64;
        const float* w = I.mod_w + (size_t)layer * 1024 * MOD_ROW + n0 + F.lane;
        float acc[9];
#pragma unroll
        for (int r = 0; r < 9; ++r) acc[r] = 0.f;
        const int kb = F.wave * 128;
#pragma unroll 16
        for (int k = 0; k < 128; ++k) { const float wv = w[(size_t)(kb + k) * MOD_ROW];
#pragma unroll
            for (int r = 0; r < 9; ++r) acc[r] += sc[r * 1024 + kb + k] * wv; }
#pragma unroll
        for (int r = 0; r < 9; ++r) red[(F.wave * 9 + r) * 64 + F.lane] = acc[r];
        __syncthreads();
        for (int i = F.tid; i < 9 * 64; i += NTHREADS) { const int r = i >> 6, l = i & 63; float s = I.mod_b[layer * MOD_ROW + n0 + l];
#pragma unroll
            for (int wv = 0; wv < 8; ++wv) s += red[(wv * 9 + r) * 64 + l];
            F.MOD()[((size_t)layer * 9 + r) * MOD_ROW + n0 + l] = s; }
    }
}

template <bool SRC_IN, bool ROUTER, bool OUT8 = true>
__device__ __forceinline__ void norm_pass(Frame& F, int grp, int layer, int which, const float* norm_g, const float* xin, const float* ctxin, const float* router_w, const float* part = nullptr, const int nslice = 0, const int gidx = 0, const float* gmod = nullptr, const bool dry = false) {
    const float* gain = norm_g + (size_t)(layer * 2 + which) * DM;
    const float* mod = F.MOD() + (size_t)layer * 9 * MOD_ROW;
    LAS float* rw = (LAS float*)F.lds;
    LAS unsigned* lcnt = (LAS unsigned*)(F.lds + 32768);
    if constexpr (ROUTER) { for (int i = F.tid; i < 1024 * 8; i += NTHREADS) rw[i] = router_w[i]; if (F.tid < 8) lcnt[F.tid] = 0u; __syncthreads(); }
    constexpr int RPW = (RROWS + 2047) / 2048;
    const int rpw = (RROWS + F.NGW - 1) / F.NGW; (void)RPW;
    const int r0 = F.gw * rpw, r1 = (r0 + rpw < RROWS) ? r0 + rpw : RROWS;
    constexpr int NLAT = GB * SEQ, NCTX = GB * CTXL;
    const int lpw = (NLAT + F.NGW - 1) / F.NGW, l0 = F.gw * lpw, l1 = (l0 + lpw < NLAT) ? l0 + lpw : NLAT, nlat = l1 > l0 ? l1 - l0 : 0;
    const int nctx = F.gw < NCTX ? (NCTX - F.gw + F.NGW - 1) / F.NGW : 0;
    const int nrows = ROUTER ? (r1 > r0 ? r1 - r0 : 0) : nlat + nctx;
#define NP_ROW(it) (ROUTER ? r0 + (it) : ((it) < nlat ? ((l0 + (it)) / SEQ) * TT + CTXL + ((l0 + (it)) % SEQ) : ((F.gw + ((it) - nlat) * F.NGW) / CTXL) * TT + ((F.gw + ((it) - nlat) * F.NGW) % CTXL)))
    f32x4 pg[4], psc[4], psh[4]; int cur = -1;
#pragma unroll
    for (int j = 0; j < 4; ++j) pg[j] = *(const f32x4*)(gain + 4 * F.lane + 256 * j);
    f32x4 nf[4]; u32x2 nb[4]; bool have = false;
#define NP_ISSUE(rr) do { int bl_, t_; row_bt((rr), bl_, t_); if (t_ >= CTXL) { have = true; \
        if constexpr (SRC_IN) { const float* s_ = xin + ((size_t)(grp * GB + bl_) * SEQ + (t_ - CTXL)) * DM + 4 * F.lane; _Pragma("unroll") for (int j = 0; j < 4; ++j) nf[j] = __builtin_nontemporal_load((const f32x4*)(s_ + 256 * j)); } \
        else { const bf16_t* s_ = F.X16() + ((size_t)bl_ * SEQ + (t_ - CTXL)) * DM + 4 * F.lane; _Pragma("unroll") for (int j = 0; j < 4; ++j) nb[j] = *(const u32x2*)(s_ + 256 * j); } } } while (0)
    if (nrows > 0) NP_ISSUE(NP_ROW(0));
    for (int it = 0; it < nrows; ++it) { const int r = NP_ROW(it);
        int bl, t; row_bt(r, bl, t); const int b = grp * GB + bl; const bool isctx = t < CTXL;
        f32x4 v[4]; const bool pre = have;
        if (pre) {
#pragma unroll
            for (int j = 0; j < 4; ++j) { if constexpr (SRC_IN) v[j] = nf[j]; else v[j] = (f32x4){bflo(nb[j].x), bfhi(nb[j].x), bflo(nb[j].y), bfhi(nb[j].y)}; } }
        have = false; if (it + 1 < nrows) NP_ISSUE(NP_ROW(it + 1));
        if (ROUTER && isctx) continue;
        const int mrow = isctx ? 8 : b;
        if (mrow != cur) { cur = mrow;
#pragma unroll
            for (int j = 0; j < 4; ++j) { psh[j] = *(const f32x4*)(mod + mrow * MOD_ROW + (which ? 3 : 0) * DM + 4 * F.lane + 256 * j); psc[j] = *(const f32x4*)(mod + mrow * MOD_ROW + (which ? 4 : 1) * DM + 4 * F.lane + 256 * j); } }
        const float* src = nullptr; float* dst = nullptr; bf16_t* x16 = F.X16() + ((size_t)bl * SEQ + (t - CTXL)) * DM;
        if (isctx) { dst = F.CX() + ((size_t)b * CTXL + t) * DM; src = SRC_IN ? ctxin + ((size_t)b * CTXL + t) * DM : dst; }
        else if (SRC_IN) src = xin + ((size_t)b * SEQ + (t - CTXL)) * DM;
        float s = 0.f;
        if (!pre) {
#pragma unroll
            for (int j = 0; j < 4; ++j) v[j] = *(const f32x4*)(src + 4 * F.lane + 256 * j); }
        if (part != nullptr && isctx) {
            const float* pr = part + ((size_t)bl * CTXL + t) * DM + 4 * F.lane;
#pragma unroll
            for (int j = 0; j < 4; ++j) { f32x4 ps[11];
#pragma unroll
                for (int sl = 0; sl < 11; ++sl) ps[sl] = *(const f32x4*)(pr + (size_t)(sl < nslice ? sl : 0) * (GB * CTXL) * DM + 256 * j);
                f32x4 a = ps[0];
#pragma unroll
                for (int sl = 1; sl < 11; ++sl) if (sl < nslice) a = a + ps[sl];
                v[j] = v[j] + a * *(const f32x4*)(gmod + 8 * MOD_ROW + gidx * DM + 4 * F.lane + 256 * j); *(f32x4*)(dst + 4 * F.lane + 256 * j) = v[j]; } }
#pragma unroll
        for (int j = 0; j < 4; ++j) s += (v[j].x * v[j].x + v[j].y * v[j].y) + (v[j].z * v[j].z + v[j].w * v[j].w);
        if constexpr (SRC_IN) {
            if (isctx) {
#pragma unroll
                for (int j = 0; j < 4; ++j) *(f32x4*)(dst + 4 * F.lane + 256 * j) = v[j];
            } else {
#pragma unroll
                for (int j = 0; j < 4; ++j) { u32x2 w; w.x = pk2(v[j].x, v[j].y); w.y = pk2(v[j].z, v[j].w); *(u32x2*)(x16 + 4 * F.lane + 256 * j) = w; } } }
        const float rstd = rsq_f(wave_sum(s, F.lane) * (1.0f / DM) + NORM_EPS);
#pragma unroll
        for (int j = 0; j < 4; ++j) v[j] = (v[j] * rstd) * pg[j] * (psc[j] + 1.0f) + psh[j];
        if constexpr (!OUT8) {
#pragma unroll
            for (int j = 0; j < 4; ++j) { u32x2 w; w.x = pk2(v[j].x, v[j].y); w.y = pk2(v[j].z, v[j].w); *(u32x2*)(F.HB() + (size_t)r * DM + 4 * F.lane + 256 * j) = w; }
        } else {
            float mx = 0.f;
#pragma unroll
            for (int j = 0; j < 4; ++j) mx = fmaxf(fmaxf(fmaxf(mx, fabsf(v[j].x)), fabsf(v[j].y)), fmaxf(fabsf(v[j].z), fabsf(v[j].w)));
            mx = red_max<64>(mx);
            const float inv = mx > 0.f ? 127.0f / mx : 0.f; signed char* h8 = (signed char*)F.HB() + (size_t)r * DM;
#pragma unroll
            for (int j = 0; j < 4; ++j) { const int b0 = (int)rintf(v[j].x * inv), b1 = (int)rintf(v[j].y * inv), b2 = (int)rintf(v[j].z * inv), b3 = (int)rintf(v[j].w * inv);
                *(unsigned*)(h8 + 4 * F.lane + 256 * j) = (unsigned)(b0 & 0xff) | ((unsigned)(b1 & 0xff) << 8) | ((unsigned)(b2 & 0xff) << 16) | ((unsigned)(b3 & 0xff) << 24); }
            if (F.lane == 0 && !dry) F.SATOK()[r] = mx * (1.0f / 127.0f); }
        if constexpr (ROUTER) {
            float lg[8];
#pragma unroll
            for (int e = 0; e < 8; ++e) lg[e] = 0.f;
#pragma unroll
            for (int j = 0; j < 4; ++j)
#pragma unroll
                for (int q = 0; q < 4; ++q) { const int col = 4 * F.lane + 256 * j + q; const f32x4 wa = *(const LAS f32x4*)(rw + col * 8), wb = *(const LAS f32x4*)(rw + col * 8 + 4); const float hv = v[j][q];
                    lg[0] += hv * wa.x; lg[1] += hv * wa.y; lg[2] += hv * wa.z; lg[3] += hv * wa.w; lg[4] += hv * wb.x; lg[5] += hv * wb.y; lg[6] += hv * wb.z; lg[7] += hv * wb.w; }
#pragma unroll
            for (int e = 0; e < 8; ++e) lg[e] = wave_sum(lg[e], F.lane);
            int e0 = 0; float l0 = lg[0];
#pragma unroll
            for (int e = 1; e < 8; ++e) if (lg[e] > l0) { l0 = lg[e]; e0 = e; }
            int e1 = -1; float l1 = -3.0e38f;
#pragma unroll
            for (int e = 0; e < 8; ++e) if (e != e0 && lg[e] > l1) { l1 = lg[e]; e1 = e; }
            if (F.lane == 0 && !dry) { const int tok = bl * SEQ + (t - CTXL); const float w1 = 1.0f / (1.0f + __expf(l0 - l1)), w0 = 1.0f - w1;
                F.TOPE()[tok * 2] = e0; F.TOPE()[tok * 2 + 1] = e1; F.TOPW()[tok * 2] = w0; F.TOPW()[tok * 2 + 1] = w1;
                F.SLOT()[tok * 2] = (int)__hip_atomic_fetch_add(lcnt + e0, 1u, __ATOMIC_RELAXED, __HIP_MEMORY_SCOPE_WORKGROUP); F.SLOT()[tok * 2 + 1] = (int)__hip_atomic_fetch_add(lcnt + e1, 1u, __ATOMIC_RELAXED, __HIP_MEMORY_SCOPE_WORKGROUP); }
        }
    }
#undef NP_ISSUE
#undef NP_ROW
    if constexpr (ROUTER) if (!dry) { __syncthreads();
        if (F.tid < 8) { const unsigned c = lcnt[F.tid]; const unsigned base = __hip_atomic_fetch_add(F.ctl + CW_CNT + grp * 64 + F.tid, c, RLX_AGENT); F.ctl[CW_WGB + (grp * 256 + (F.gw >> 3)) * 8 + F.tid] = base; } }
}

__device__ __forceinline__ void fix_even(Frame& F, const float* qn, const float* kvn, const float* cw, const float* alog, const float* dtb, const int conv_reps, const bool dry = false) {
    LAS float* cwl = (LAS float*)F.lds;
    for (int i = F.tid; i < 5 * 1536; i += NTHREADS) cwl[i] = cw[i];
    __syncthreads();
    const int rpw = (RROWS + F.NGW - 1) / F.NGW, r0w = F.gw * rpw, r1w = (r0w + rpw < RROWS) ? r0w + rpw : RROWS;
    unsigned win[5][12];
    unsigned ncq[3], nckv[2]; bf16_t nkpe, na, nb;
#define FE_ISSUE(rr) do { const bf16_t* pr_ = F.PB() + (size_t)(rr) * EV_INP; _Pragma("unroll") for (int j = 0; j < 3; ++j) ncq[j] = *(const unsigned*)(pr_ + PC_CQ + 2 * (F.lane + 64 * j)); \
        _Pragma("unroll") for (int j = 0; j < 2; ++j) nckv[j] = *(const unsigned*)(pr_ + PC_CKV + 2 * (F.lane + 64 * j)); nkpe = pr_[PC_KPE + (F.lane & 31)]; na = pr_[PC_A + (F.lane & 15)]; nb = pr_[PC_B + (F.lane & 15)]; } while (0)
    if (r0w < r1w) FE_ISSUE(r0w);
    for (int r = r0w; r < r1w; ++r) {
        int bl, t; row_bt(r, bl, t); const bool isctx = t < CTXL;
        bf16_t* prow = F.PB() + (size_t)r * EV_INP;
        unsigned ccq[3], cckv[2];
#pragma unroll
        for (int j = 0; j < 3; ++j) ccq[j] = ncq[j];
        cckv[0] = nckv[0]; cckv[1] = nckv[1]; const bf16_t ckpe = nkpe, ca = na, cb = nb;
        if (r + 1 < r1w) FE_ISSUE(r + 1);
        { unsigned w[3]; float s = 0.f;
#pragma unroll
          for (int j = 0; j < 3; ++j) { w[j] = ccq[j]; const float a = bflo(w[j]), b2 = bfhi(w[j]); s += a * a + b2 * b2; }
          const float rstd = rsq_f(wave_sum(s, F.lane) * (1.0f / 384.0f) + NORM_EPS);
#pragma unroll
          for (int j = 0; j < 3; ++j) { const int c = 2 * (F.lane + 64 * j); if (!dry) *(unsigned*)(prow + PC_CQ + c) = pk2(bflo(w[j]) * rstd * qn[c], bfhi(w[j]) * rstd * qn[c + 1]); } }
        { unsigned w[2]; float s = 0.f;
#pragma unroll
          for (int j = 0; j < 2; ++j) { w[j] = cckv[j]; const float a = bflo(w[j]), b2 = bfhi(w[j]); s += a * a + b2 * b2; }
          const float rstd = rsq_f(wave_sum(s, F.lane) * (1.0f / 256.0f) + NORM_EPS);
#pragma unroll
          for (int j = 0; j < 2; ++j) { const int c = 2 * (F.lane + 64 * j); if (!dry) *(unsigned*)(prow + PC_CKV + c) = pk2(bflo(w[j]) * rstd * kvn[c], bfhi(w[j]) * rstd * kvn[c + 1]); } }
        { const int i = F.lane & 31; const float v = bf2f(ckpe); const float pu = dppf<0x108>(v), pd = dppf<0x118>(v); const float pv = (i & 8) ? pd : pu; float o = v;
          if (!isctx) { const int tl = t - CTXL; const int pos = (i >> 4) ? (tl & 63) : (tl >> 6); const int f = i & 7; const float cs = F.TAB8()[pos * 8 + f], sn = F.TAB8()[1024 + pos * 8 + f];
              o = (i & 8) ? (v * cs + pv * sn) : (v * cs - pv * sn); }
          if (F.lane < 32) F.KPE()[(size_t)r * 32 + i] = (bf16_t)f2bf(o); }
        if (F.lane < 16) { const float a = bf2f(ca), bb = bf2f(cb); const float xx = a + dtb[F.lane];
            const float sp = (xx > 20.f) ? xx : __logf(1.0f + __expf(xx)); F.GG()[(size_t)r * 16 + F.lane] = -__expf(alog[F.lane]) * sp; F.GBT()[(size_t)r * 16 + F.lane] = __builtin_amdgcn_rcpf(1.0f + __expf(-bb)); }
        for (int crep = 0; crep < conv_reps; ++crep) { const int tlo = isctx ? 0 : CTXL, thi = isctx ? CTXL : TT;
          unsigned cwa = (unsigned)(uintptr_t)(const void*)cwl; asm volatile("" : "+v"(cwa)); const LAS float* cwr = (const LAS float*)(uintptr_t)cwa;
          float va[12], vb[12];
#pragma unroll
          for (int j = 0; j < 12; ++j) { va[j] = 0.f; vb[j] = 0.f; }
          if (r == r0w && crep == 0) {
#pragma unroll
              for (int k = 0; k < 4; ++k) { int rr = r + k - 2; rr = rr < 0 ? 0 : (rr >= RROWS ? RROWS - 1 : rr); const bf16_t* nrow = F.PB() + (size_t)rr * EV_INP + PC_GQKV;
#pragma unroll
                  for (int j = 0; j < 12; ++j) win[k][j] = *(const unsigned*)(nrow + 2 * (F.lane + 64 * j)); } }
          if (crep == 0) { int rr = r + 2; rr = rr >= RROWS ? RROWS - 1 : rr; const bf16_t* nrow = F.PB() + (size_t)rr * EV_INP + PC_GQKV;
#pragma unroll
              for (int j = 0; j < 12; ++j) win[4][j] = *(const unsigned*)(nrow + 2 * (F.lane + 64 * j)); }
#pragma unroll
          for (int k = 0; k < 5; ++k) { const int tk = t + k - 2; const float msk = (tk < tlo || tk >= thi) ? 0.f : 1.f;
#pragma unroll
              for (int j = 0; j < 12; ++j) { const int c = 2 * (F.lane + 64 * j); const unsigned w = win[k][j]; const f32x2 wk = *(const LAS f32x2*)(cwr + k * 1536 + c);
                  va[j] += bflo(w) * (wk.x * msk); vb[j] += bfhi(w) * (wk.y * msk); } }
#pragma unroll
          for (int j = 0; j < 12; ++j) { float a = silu_f(va[j]), b2 = silu_f(vb[j]);
              if (j < 8) { float s = a * a + b2 * b2;
                  s = red_sum<32>(s);
                  const float sc = (j < 4 ? 0.125f : 1.0f) * rsq_f(s + NORM_EPS); a *= sc; b2 *= sc; }
              bf16_t* dst = (j < 4) ? F.GQ() : (j < 8) ? F.GK() : F.GV();
              *(unsigned*)(dst + (size_t)r * 512 + (j & 3) * 128 + 2 * F.lane) = pk2(a, b2); } }
#pragma unroll
        for (int k = 0; k < 4; ++k)
#pragma unroll
            for (int j = 0; j < 12; ++j) win[k][j] = win[k + 1][j];
    }
#undef FE_ISSUE
}

__device__ __forceinline__ void q_rope(Frame& F, const bool dry = false) {
    for (int r = F.gw; r < RROWS; r += F.NGW) {
        int bl, t; row_bt(r, bl, t); if (t < CTXL) continue;
        const int tl = t - CTXL; const int h = F.lane >> 3, gq = F.lane & 7;
        bf16_t* p = F.QR() + (size_t)r * 768 + h * 96 + 64 + 4 * gq;
        const u32x2 w = *(const u32x2*)p; float v[4] = {bflo(w.x), bfhi(w.x), bflo(w.y), bfhi(w.y)}, o[4];
        const int pos = (gq & 4) ? (tl & 63) : (tl >> 6);
#pragma unroll
        for (int e = 0; e < 4; ++e) { const float pv = sx(v[e], 2, F.lane); const int f = 4 * (gq & 1) + e; const float cs = F.TAB8()[pos * 8 + f], sn = F.TAB8()[1024 + pos * 8 + f];
            o[e] = (gq & 2) ? (v[e] * cs + pv * sn) : (v[e] * cs - pv * sn); }
        u32x2 ow; ow.x = pk2(o[0], o[1]); ow.y = pk2(o[2], o[3]); *(u32x2*)p = dry ? w : ow;
    }
}

__device__ __forceinline__ void fix_odd(Frame& F, const float* gqn, const float* gkn, const int grp, const bool dry = false) {
    float kmx[2] = {0.f, 0.f};
    const int s16 = F.lane & 15, vq = F.lane >> 4;
    for (int rb = F.gw; rb < RROWS; rb += 2 * F.NGW) {
        u32x2 wv[2][7];
#pragma unroll
        for (int u = 0; u < 2; ++u) { const int r = (rb + u * F.NGW < RROWS) ? rb + u * F.NGW : rb; const bf16_t* prow = F.PB() + (size_t)r * OD_IN;
#pragma unroll
            for (int it = 0; it < 7; ++it) { const int v = it * 4 + vq; const bool act = v < 26;
                const int col = (v < 8) ? (P1_DQ + 64 * v) : (v < 16) ? (P1_DK + 64 * (v - 8)) : (v < 24) ? (P1_GQ + 64 * (v - 16)) : (P1_GK + 64 * (v - 24));
                wv[u][it] = *(const u32x2*)(prow + (act ? col : 0) + 4 * s16); } }
#pragma unroll
        for (int u = 0; u < 2; ++u) { const int r = rb + u * F.NGW; if (r >= RROWS) break;
            int bl, t; row_bt(r, bl, t); const bool isctx = t < CTXL; const int tl = t - CTXL;
            bf16_t* prow = F.PB() + (size_t)r * OD_IN;
            const int pos = (s16 & 8) ? (tl & 63) : (tl >> 6);
            float cs[4], sn[4];
#pragma unroll
            for (int e = 0; e < 4; ++e) { const int f = 4 * (s16 & 3) + e; cs[e] = isctx ? 1.f : F.TAB16()[pos * 16 + f]; sn[e] = isctx ? 0.f : F.TAB16()[2048 + pos * 16 + f]; if (!(s16 & 4)) sn[e] = -sn[e]; }
#pragma unroll
            for (int it = 0; it < 7; ++it) { const int v = it * 4 + vq; const bool act = v < 26;
                const int col = (v < 8) ? (P1_DQ + 64 * v) : (v < 16) ? (P1_DK + 64 * (v - 8)) : (v < 24) ? (P1_GQ + 64 * (v - 16)) : (P1_GK + 64 * (v - 24));
                bf16_t* p = prow + (act ? col : 0) + 4 * s16;
                const u32x2 w = wv[u][it]; float x[4] = {bflo(w.x), bfhi(w.x), bflo(w.y), bfhi(w.y)};
                if (it == 2 || it == 3) { float s = x[0] * x[0] + x[1] * x[1] + x[2] * x[2] + x[3] * x[3];
                    s = red_sum<16>(s);
                    kmx[it - 2] = fmaxf(kmx[it - 2], s); }
                if (v >= 16) { float s = x[0] * x[0] + x[1] * x[1] + x[2] * x[2] + x[3] * x[3];
                    s = red_sum<16>(s);
                    const float rstd = rsq_f(s * (1.0f / 64.0f) + NORM_EPS); const float* gn = (v < 24) ? gqn : gkn;
#pragma unroll
                    for (int e = 0; e < 4; ++e) x[e] = x[e] * (v < 24 ? rstd * ATT_C64 : rstd) * gn[4 * s16 + e]; }
                float o4[4];
#pragma unroll
                for (int e = 0; e < 4; ++e) { const float pu = dppf<0x104>(x[e]), pd = dppf<0x114>(x[e]); const float pv = (s16 & 4) ? pd : pu;
                    o4[e] = x[e] * cs[e] + pv * sn[e]; }
                if (act) { u32x2 ow; ow.x = pk2(o4[0], o4[1]); ow.y = pk2(o4[2], o4[3]); *(u32x2*)p = dry ? w : ow; }
            }
        }
    }
    { LAS float* red = (LAS float*)F.lds; const int vq = F.lane >> 4;
      if ((F.lane & 15) == 0) { red[F.wave * 8 + vq] = kmx[0]; red[F.wave * 8 + 4 + vq] = kmx[1]; }
      __syncthreads();
      if (F.tid < 8 && !dry) { float m = 0.f;
#pragma unroll
          for (int w = 0; w < 8; ++w) m = fmaxf(m, red[w * 8 + F.tid]);
          ((float*)(F.ctl + CW_KMAX))[(grp * 256 + (F.gw >> 3)) * 8 + F.tid] = m; }
      __syncthreads(); }
}

__device__ __forceinline__ void gdn_out(Frame& F, const float* on) {
    const int c0 = 8 * F.lane;
    float onv[8];
#pragma unroll
    for (int q = 0; q < 8; ++q) onv[q] = on[(c0 & 63) + q];
    for (int rb = F.gw; rb < RROWS; rb += 4 * F.NGW) {
        u32x4 a[4], b[4], z[4];
#pragma unroll
        for (int u = 0; u < 4; ++u) { const int r = rb + u * F.NGW; const size_t rr = r < RROWS ? r : 0;
            a[u] = __builtin_nontemporal_load((const u32x4*)(F.OF() + rr * 512 + c0)); b[u] = __builtin_nontemporal_load((const u32x4*)(F.OB() + rr * 512 + c0)); z[u] = __builtin_nontemporal_load((const u32x4*)(F.PB() + rr * EV_INP + PC_Z + c0)); }
#pragma unroll
        for (int u = 0; u < 4; ++u) { const int r = rb + u * F.NGW;
            float o[8]; float s = 0.f;
#pragma unroll
            for (int q = 0; q < 4; ++q) { o[2 * q] = bflo(a[u][q]) + bflo(b[u][q]); o[2 * q + 1] = bfhi(a[u][q]) + bfhi(b[u][q]); s += o[2 * q] * o[2 * q] + o[2 * q + 1] * o[2 * q + 1]; }
            s = red_sum<8>(s);
            const float rstd = rsq_f(s * (1.0f / 64.0f) + NORM_EPS);
            u32x4 w;
#pragma unroll
            for (int q = 0; q < 4; ++q) { const float y0 = o[2 * q] * rstd * onv[2 * q] * silu_f(bflo(z[u][q])), y1 = o[2 * q + 1] * rstd * onv[2 * q + 1] * silu_f(bfhi(z[u][q])); w[q] = pk2(y0, y1); }
            if (r < RROWS) *(u32x4*)(F.HB() + (size_t)r * DM + 512 + c0) = w; }
    }
}

__device__ __forceinline__ void diff_post(Frame& F, const float* lp, const float* dn) {
    const float lambda_init = 0.8f - 0.6f * expf(-0.3f);
    const float s1 = red_sum<64>(lp[F.lane] * lp[64 + F.lane]), s2 = red_sum<64>(lp[128 + F.lane] * lp[192 + F.lane]);
    const float lam = __expf(s1) - __expf(s2) + lambda_init;
    const int h = F.lane >> 4, j0 = 8 * (F.lane & 15);
    float dnv[8];
#pragma unroll
    for (int q = 0; q < 8; ++q) dnv[q] = dn[j0 + q];
    for (int rb = F.gw; rb < RROWS; rb += 4 * F.NGW) {
        u32x4 a[4], b[4]; bool ok[4];
#pragma unroll
        for (int u = 0; u < 4; ++u) { const int r = rb + u * F.NGW; int bl = 0, t = 0; ok[u] = r < RROWS; if (ok[u]) { row_bt(r, bl, t); ok[u] = t >= CTXL; }
            const bf16_t* od = F.KV() + (size_t)(ok[u] ? r : 0) * DM + h * 256 + j0; a[u] = __builtin_nontemporal_load((const u32x4*)od); b[u] = __builtin_nontemporal_load((const u32x4*)(od + 128)); }
#pragma unroll
        for (int u = 0; u < 4; ++u) { const int r = rb + u * F.NGW;
            float d[8]; float s = 0.f;
#pragma unroll
            for (int q = 0; q < 4; ++q) { d[2 * q] = bflo(a[u][q]) - lam * bflo(b[u][q]); d[2 * q + 1] = bfhi(a[u][q]) - lam * bfhi(b[u][q]); s += d[2 * q] * d[2 * q] + d[2 * q + 1] * d[2 * q + 1]; }
            s = red_sum<16>(s);
            const float rstd = (1.0f - lambda_init) * rsq_f(s * (1.0f / 128.0f) + NORM_EPS);
            u32x4 w;
#pragma unroll
            for (int q = 0; q < 4; ++q) w[q] = pk2(d[2 * q] * rstd * dnv[2 * q], d[2 * q + 1] * rstd * dnv[2 * q + 1]);
            if (ok[u]) *(u32x4*)(F.HB() + (size_t)r * DM + h * 128 + j0) = w; }
    }
}

__device__ __forceinline__ void moe_tends(Frame& F, int grp) {
    if (F.tid < 8) { int c[8];
#pragma unroll
        for (int e = 0; e < 8; ++e) c[e] = (int)__hip_atomic_load(F.ctl + CW_CNT + grp * 64 + e, RLX_AGENT);
        int acc = 0, st = 0, en = 0;
#pragma unroll
        for (int e = 0; e < 8; ++e) { if (e == F.tid) st = acc; acc += (c[e] + 255) >> 8; if (e == F.tid) en = acc; }
        F.MISC[24 + F.tid] = (unsigned)(st * 256); F.MISC[16 + F.tid] = (unsigned)en; }
    __syncthreads();
}
__device__ __forceinline__ void moe_gather(Frame& F, int grp, const bool dry = false) {
    if (dry) return;
    const int rpw = (RROWS + F.NGW - 1) / F.NGW; const int r0 = F.gw * rpw, r1 = (r0 + rpw < RROWS) ? r0 + rpw : RROWS;
    const unsigned* wgb = F.ctl + CW_WGB + (grp * 256 + (F.gw >> 3)) * 8;
    float* ssc = (float*)((signed char*)F.XG() + (size_t)MOE_ROWS * DM); int* s2t = (int*)(ssc + MOE_ROWS);
    for (int rb = r0; rb < r1; rb += 64) { const int r = rb + F.lane;
        if (r < r1) { int bl, t; row_bt(r, bl, t);
            if (t >= CTXL) { const int tok = bl * SEQ + (t - CTXL); const float sat = F.SATOK()[r];
#pragma unroll
                for (int k = 0; k < 2; ++k) { const int e = F.TOPE()[tok * 2 + k]; const int row = (int)F.MISC[24 + e] + (int)wgb[e] + F.SLOT()[tok * 2 + k];
                    s2t[row] = r; ssc[row] = sat; F.SLOT()[tok * 2 + k] = row; } } } }
    if (F.gw < 64) { const int e = F.gw >> 3;
        const int start = (int)F.MISC[24 + e], cnt = (int)__hip_atomic_load(F.ctl + CW_CNT + grp * 64 + e, RLX_AGENT), end = (int)F.MISC[16 + e] * 256;
        for (int sidx = start + cnt + F.tid; sidx < end; sidx += NTHREADS) { s2t[sidx] = 0; ssc[sidx] = 0.f; } }
}
__device__ __forceinline__ void final_pass(Frame& F, int grp, const float* fn, const bool dry = false) {
    const float* mod = F.MOD() + (size_t)1 * 9 * MOD_ROW;
    f32x4 pf[4];
#pragma unroll
    for (int j = 0; j < 4; ++j) pf[j] = *(const f32x4*)(fn + 4 * F.lane + 256 * j);
    constexpr int U = 4;
    for (int tokb = F.gw; tokb < NTOK_G; tokb += U * F.NGW) {
        int s0[U], s1[U]; float w0[U], w1[U];
#pragma unroll
        for (int u = 0; u < U; ++u) { const int tok = (tokb + u * F.NGW < NTOK_G) ? tokb + u * F.NGW : tokb;
            s0[u] = F.SLOT()[tok * 2]; s1[u] = F.SLOT()[tok * 2 + 1]; w0[u] = F.TOPW()[tok * 2]; w1[u] = F.TOPW()[tok * 2 + 1]; }
        u32x2 xr[U][4], ya[U][4], yb[U][4];
#pragma unroll
        for (int u = 0; u < U; ++u) { const int tok = (tokb + u * F.NGW < NTOK_G) ? tokb + u * F.NGW : tokb; const int bl = tok / SEQ, tl = tok - bl * SEQ;
            const bf16_t* x16 = F.X16() + ((size_t)bl * SEQ + tl) * DM + 4 * F.lane; const bf16_t* y0 = F.XG() + (size_t)s0[u] * DM + 4 * F.lane; const bf16_t* y1 = F.XG() + (size_t)s1[u] * DM + 4 * F.lane;
#pragma unroll
            for (int j = 0; j < 4; ++j) { xr[u][j] = __builtin_nontemporal_load((const u32x2*)(x16 + 256 * j)); ya[u][j] = __builtin_nontemporal_load((const u32x2*)(y0 + 256 * j)); yb[u][j] = __builtin_nontemporal_load((const u32x2*)(y1 + 256 * j)); } }
#pragma unroll
        for (int u = 0; u < U; ++u) { const int tok = tokb + u * F.NGW; const bool okt = tok < NTOK_G; const int tk = okt ? tok : tokb;
            const int bl = tk / SEQ, tl = tk - bl * SEQ, b = grp * GB + bl;
            float* xrow = F.X + ((size_t)b * SEQ + tl) * DM; const float* gt = mod + b * MOD_ROW + 5 * DM;
            f32x4 v[4]; float s = 0.f;
#pragma unroll
            for (int j = 0; j < 4; ++j) { const int c = 4 * F.lane + 256 * j; const u32x2 xw = xr[u][j]; v[j] = (f32x4){bflo(xw.x), bfhi(xw.x), bflo(xw.y), bfhi(xw.y)}; const f32x4 g4 = *(const f32x4*)(gt + c);
                const u32x2 a = ya[u][j], bb = yb[u][j];
                f32x4 fa = {bflo(a.x), bfhi(a.x), bflo(a.y), bfhi(a.y)}, fb = {bflo(bb.x), bfhi(bb.x), bflo(bb.y), bfhi(bb.y)};
                if (s0[u] >= 65536) {
#pragma unroll
                    for (int k = 0; k < 3; ++k) { const u32x2 pw = *(const u32x2*)(F.HB() + ((size_t)k * 2048 + (size_t)(s0[u] - 65536)) * DM + c); fa.x += bflo(pw.x); fa.y += bfhi(pw.x); fa.z += bflo(pw.y); fa.w += bfhi(pw.y); } }
                if (s1[u] >= 65536) {
#pragma unroll
                    for (int k = 0; k < 3; ++k) { const u32x2 pw = *(const u32x2*)(F.HB() + ((size_t)k * 2048 + (size_t)(s1[u] - 65536)) * DM + c); fb.x += bflo(pw.x); fb.y += bfhi(pw.x); fb.z += bflo(pw.y); fb.w += bfhi(pw.y); } }
                v[j].x += g4.x * (w0[u] * fa.x + w1[u] * fb.x); v[j].y += g4.y * (w0[u] * fa.y + w1[u] * fb.y);
                v[j].z += g4.z * (w0[u] * fa.z + w1[u] * fb.z); v[j].w += g4.w * (w0[u] * fa.w + w1[u] * fb.w);
                s += (v[j].x * v[j].x + v[j].y * v[j].y) + (v[j].z * v[j].z + v[j].w * v[j].w); }
            const float rstd = rsq_f(wave_sum(s, F.lane) * (1.0f / DM) + NORM_EPS);
            if (okt && !dry) {
#pragma unroll
                for (int j = 0; j < 4; ++j) { const int c = 4 * F.lane + 256 * j; __builtin_nontemporal_store(v[j] * rstd * pf[j], (f32x4*)(xrow + c)); } } }
    }
}

__device__ __forceinline__ void gdn_rows(int bl, int dir, int ci, int& row0, int& step) {
    int T, base, ip; if (ci < 4) { T = CTXL; base = 0; ip = ci; } else { T = SEQ; base = CTXL; ip = ci - 4; }
    row0 = bl * TT + (dir ? base + T - 1 - 64 * ip : base + 64 * ip); step = dir ? -1 : 1;
}
__device__ __forceinline__ float wave_incl_scan(float v, int lane) {
#pragma unroll
    for (int o = 1; o < 64; o <<= 1) { const float t = __builtin_bit_cast(float, __builtin_amdgcn_ds_bpermute((lane - o) << 2, __builtin_bit_cast(int, v))); if (lane >= o) v += t; }
    return v;
}
__device__ __forceinline__ void gdn_pre(Frame& F, const int bx, const int npw, const int grp) {
    const int team = F.wave >> 1, w2 = F.wave & 1, lane = F.lane, r32 = lane & 31, hi = lane >> 5, tt = F.tid & 127;
    LAS float* Lm = (LAS float*)(F.lds + team * 17408);
    LAS unsigned char* Kt = F.lds + 69632 + team * 16384; LAS unsigned char* Vt = Kt + 8192;
    LAS float* gcs = (LAS float*)(F.lds + LDSCTL_OFF + 1024 + F.wave * 512);
    int zv; asm volatile("v_mov_b32 %0, 0" : "=v"(zv));
    const LAS float* gcz = gcs + zv; const LAS float* Lz = Lm + zv;
    constexpr int NC = GB * 8 * 2 * NCHUNK;
    const int per_pass = npw * 4, npass = (NC + per_pass - 1) / per_pass;
    GAS unsigned* gflag = (GAS unsigned*)(F.ctl + CW_GFLAG + grp * NC);
    u32x4 ntk[4], ntv[4]; float ng, nbt;
#define GP_ISSUE(ps) do { const int q_ = (ps) * per_pass + bx * 4 + team; const int qq_ = q_ < NC ? q_ : 0; const int ci_ = qq_ >> 6, rest_ = qq_ & 63, dir_ = rest_ & 1, h_ = (rest_ >> 1) & 7, bl_ = rest_ >> 4; \
        int row0_, step_; gdn_rows(bl_, dir_, ci_, row0_, step_); \
        _Pragma("unroll") for (int i = 0; i < 4; ++i) { const int p = tt + 128 * i, row = p >> 3, ch = p & 7; const size_t rr = (size_t)(row0_ + step_ * row) * 512 + h_ * 64 + ch * 8; ntk[i] = *(const u32x4*)(F.GK() + rr); ntv[i] = *(const u32x4*)(F.GV() + rr); } \
        { const size_t rr = (size_t)(row0_ + step_ * lane) * 16 + dir_ * 8 + h_; ng = F.GG()[rr]; nbt = F.GBT()[rr]; } \
        } while (0)
    GP_ISSUE(0);
    for (int pass = 0; pass < npass; ++pass) {
        const int q = pass * per_pass + bx * 4 + team; const bool active = q < NC;
        const int qe = active ? q : 0; const int ci = qe >> 6, rest = qe & 63, dir = rest & 1, h = (rest >> 1) & 7, bl = rest >> 4;
        const int qq = rest * NCHUNK + ci;
        int row0, step; gdn_rows(bl, dir, ci, row0, step);
        unsigned char* out = F.GPRE() + (size_t)qq * GPRE_CHUNK;
        {
#pragma unroll
          for (int i = 0; i < 4; ++i) { const int p = tt + 128 * i, row = p >> 3, ch = p & 7; *(LAS u32x4*)(Kt + att::kswz<128>(row, ch * 16)) = ntk[i]; *(LAS u32x4*)(Vt + row * 128 + ch * 16) = ntv[i]; } }
        { const float g = ng, bt = nbt; const float gc = wave_incl_scan(g, lane); gcs[lane] = gc; gcs[64 + lane] = bt; if (w2 == 0 && active) __hip_atomic_store((GAS float*)(F.GCB() + (size_t)qq * 64 + lane), gc, RLX_AGENT); }
        __syncthreads();
        { bf16x8 Af[2][4], Bf[2][4];
#pragma unroll
          for (int bi = 0; bi < 2; ++bi)
#pragma unroll
              for (int ks = 0; ks < 4; ++ks) { Bf[bi][ks] = *(const LAS bf16x8*)(Kt + att::kswz<128>(32 * bi + r32, (16 * ks + 8 * hi) * 2));
                  if (w2) Af[bi][ks] = *(const bf16x8*)(F.GQ() + (size_t)(row0 + step * (32 * bi + r32)) * 512 + h * 64 + 8 * hi + 16 * ks); else Af[bi][ks] = Bf[bi][ks]; }
          f32x16 acc[2][2];
#pragma unroll
          for (int bi = 0; bi < 2; ++bi)
#pragma unroll
              for (int bj = 0; bj < 2; ++bj) { acc[bi][bj] = f32x16{};
#pragma unroll
                  for (int ks = 0; ks < 4; ++ks) acc[bi][bj] = __builtin_amdgcn_mfma_f32_32x32x16_bf16(Af[bi][ks], Bf[bj][ks], acc[bi][bj], 0, 0, 0); }
          const int thr = w2 ? 0 : 1; int r32p = r32, hip = hi; asm volatile("" : "+v"(r32p), "+v"(hip));
#pragma unroll
          for (int bi = 0; bi < 2; ++bi)
#pragma unroll
              for (int bj = 0; bj < 2; ++bj) { const int s = 32 * bj + r32p; const float gs = gcs[s];
#pragma unroll
                  for (int r = 0; r < 16; ++r) { const int c = 32 * bi + (r & 3) + 8 * (r >> 2) + 4 * hip; const float gcc = gcs[c];
                      const float v = acc[bi][bj][r] * __expf(fminf(gcc - gs, 0.f)); const int keep = ~((c - s - thr) >> 31);
                      acc[bi][bj][r] = __builtin_bit_cast(float, __builtin_bit_cast(int, v) & keep); } }
          if (w2 == 0) {
#pragma unroll
              for (int bi = 0; bi < 2; ++bi)
#pragma unroll
                  for (int bj = 0; bj < 2; ++bj)
#pragma unroll
                      for (int r = 0; r < 16; ++r) { const int c = 32 * bi + (r & 3) + 8 * (r >> 2) + 4 * hi; Lm[(32 * bj + r32) * 68 + c] = acc[bi][bj][r] * gcs[64 + c]; }
          } else if (active) {
              bf16_t* qo = (bf16_t*)(out + 8192) + (4 * hi) * 64 + r32;
#pragma unroll
              for (int bi = 0; bi < 2; ++bi)
#pragma unroll
                  for (int bj = 0; bj < 2; ++bj)
#pragma unroll
                      for (int r = 0; r < 16; ++r) __hip_atomic_store((GAS bf16_t*)(qo + (32 * bi + (r & 3) + 8 * (r >> 2)) * 64 + 32 * bj), (bf16_t)f2bf(acc[bi][bj][r]), RLX_AGENT);
          } }
        __syncthreads();
        if (pass + 1 < npass) GP_ISSUE(pass + 1);
        { float x[64];
#pragma unroll
          for (int c = 0; c < 64; ++c) x[c] = gcz[64 + c];
          if (w2) {
#pragma unroll
              for (int c = 0; c < 64; ++c) x[c] *= bf2f(*(const LAS bf16_t*)(Kt + c * 128 + ((lane * 2) ^ (((c >> 1) & 7) << 4)))) * __expf(gcz[c]);
          } else {
#pragma unroll
              for (int c = 0; c < 64; ++c) x[c] *= bf2f(*(const LAS bf16_t*)(Vt + c * 128 + lane * 2));
          }
          const unsigned lza = (unsigned)(uintptr_t)(const void*)Lm + (unsigned)zv;
#define PRE_LD(dst, off) asm volatile("ds_read_b128 %0, %1 offset:%2" : "=v"(dst) : "v"(lza), "i"(off))
#define PRE_PIN(i) asm volatile("" : "+v"(x[(i)]), "+v"(x[(i) + 1]), "+v"(x[(i) + 2]), "+v"(x[(i) + 3]))
#define PRE_W4(n, a0, a1, a2, a3) asm volatile("s_waitcnt lgkmcnt(" #n ")" : "+v"(a0), "+v"(a1), "+v"(a2), "+v"(a3))
#pragma unroll
          for (int s4 = 0; s4 < 16; ++s4) { const int s0 = 4 * s4;
              f32x4 A0, A1, A2, A3, B0, B1, B2, B3;
              { f32x4 t0, t1, t2, t3; PRE_LD(t0, ((s0 + 0) * 68 + s0) * 4); PRE_LD(t1, ((s0 + 1) * 68 + s0) * 4); PRE_LD(t2, ((s0 + 2) * 68 + s0) * 4); t3 = t2;
                if (s4 + 1 < 16) { PRE_LD(A0, ((s0 + 0) * 68 + s0 + 4) * 4); PRE_LD(A1, ((s0 + 1) * 68 + s0 + 4) * 4); PRE_LD(A2, ((s0 + 2) * 68 + s0 + 4) * 4); PRE_LD(A3, ((s0 + 3) * 68 + s0 + 4) * 4); PRE_W4(4, t0, t1, t2, t3); }
                else PRE_W4(0, t0, t1, t2, t3);
                x[s0 + 1] -= t0.y * x[s0];
                x[s0 + 2] -= t0.z * x[s0]; x[s0 + 2] -= t1.z * x[s0 + 1];
                x[s0 + 3] -= t0.w * x[s0]; x[s0 + 3] -= t1.w * x[s0 + 1]; x[s0 + 3] -= t2.w * x[s0 + 2]; PRE_PIN(s0); }
#pragma unroll
              for (int r4 = s4 + 1; r4 < 16; ++r4) { const int r0 = 4 * r4; const bool useA = ((r4 - s4) & 1) != 0, more = r4 + 1 < 16;
                  if (useA) { if (more) { PRE_LD(B0, ((s0 + 0) * 68 + r0 + 4) * 4); PRE_LD(B1, ((s0 + 1) * 68 + r0 + 4) * 4); PRE_LD(B2, ((s0 + 2) * 68 + r0 + 4) * 4); PRE_LD(B3, ((s0 + 3) * 68 + r0 + 4) * 4); PRE_W4(4, A0, A1, A2, A3); } else PRE_W4(0, A0, A1, A2, A3);
#pragma unroll
                      for (int e = 0; e < 4; ++e) { float a = x[r0 + e]; a -= A0[e] * x[s0]; a -= A1[e] * x[s0 + 1]; a -= A2[e] * x[s0 + 2]; a -= A3[e] * x[s0 + 3]; x[r0 + e] = a; } PRE_PIN(r0); }
                  else { if (more) { PRE_LD(A0, ((s0 + 0) * 68 + r0 + 4) * 4); PRE_LD(A1, ((s0 + 1) * 68 + r0 + 4) * 4); PRE_LD(A2, ((s0 + 2) * 68 + r0 + 4) * 4); PRE_LD(A3, ((s0 + 3) * 68 + r0 + 4) * 4); PRE_W4(4, B0, B1, B2, B3); } else PRE_W4(0, B0, B1, B2, B3);
#pragma unroll
                      for (int e = 0; e < 4; ++e) { float a = x[r0 + e]; a -= B0[e] * x[s0]; a -= B1[e] * x[s0 + 1]; a -= B2[e] * x[s0 + 2]; a -= B3[e] * x[s0 + 3]; x[r0 + e] = a; } PRE_PIN(r0); } } }
#undef PRE_LD
#undef PRE_W4
#undef PRE_PIN
          if (active) { bf16_t* dst = (bf16_t*)(out + (w2 ? 0 : 16384)) + lane; const float sg = w2 ? -1.f : 1.f;
#pragma unroll
              for (int c = 0; c < 64; ++c) __hip_atomic_store((GAS bf16_t*)(dst + c * 64), (bf16_t)f2bf(sg * x[c]), RLX_AGENT); } }
        asm volatile("s_waitcnt vmcnt(0)" ::: "memory");
        __syncthreads();
        if (tt == 0 && active) __hip_atomic_store(gflag + qq, 1u, RLX_AGENT);
    }
#undef GP_ISSUE
}

constexpr int GS_WM = 0, GS_QK = 9216, GS_Q = 18432, GS_K = 27648, GS_U = 36864, GS_GC = 45056, GS_EG = 45312, GS_ED = 45568, GS_BUF = 46080, GS_OUT = 2 * 46080;
typedef short v4i16_t __attribute__((ext_vector_type(4)));
__device__ __forceinline__ bf16x8 gs_ldA(const LAS unsigned char* m, int row, int ks, int g) {
    return *(const LAS bf16x8*)(m + row * 144 + (32 * ks + 8 * g) * 2);
}
__device__ __forceinline__ bf16x8 gs_ldKT(const LAS unsigned char* km, int mt, int ks, int g, int i16) {
    const int q = i16 >> 2, p = i16 & 3;
    const LAS unsigned char* a0 = km + (32 * ks + 4 * g + q) * 144 + (16 * mt + 4 * p) * 2;
    const s16x4 lo = __builtin_bit_cast(s16x4, __builtin_amdgcn_ds_read_tr16_b64_v4i16((LAS v4i16_t*)a0));
    const s16x4 hi = __builtin_bit_cast(s16x4, __builtin_amdgcn_ds_read_tr16_b64_v4i16((LAS v4i16_t*)(a0 + 16 * 144)));
    return (bf16x8){lo[0], lo[1], lo[2], lo[3], hi[0], hi[1], hi[2], hi[3]};
}
__device__ __forceinline__ bf16x8 gs_pack(const f32x4 a, const f32x4 b) { const u32x4 w = {cvt_pk_bf16(a[0], a[1]), cvt_pk_bf16(a[2], a[3]), cvt_pk_bf16(b[0], b[1]), cvt_pk_bf16(b[2], b[3])}; return __builtin_bit_cast(bf16x8, w); }
__device__ __forceinline__ void gdn_scan(Frame& F, int chain, const int grp) {
    const int dir = chain & 1, h = (chain >> 1) & 7, bl = chain >> 4;
    const int lane = F.lane, n = lane & 15, g = lane >> 4, wq = F.wave;
    if (F.wave >= 4) {
        const int lt = F.tid - 256;
        const GAS unsigned* gflag = (const GAS unsigned*)(F.ctl + CW_GFLAG + grp * (GB * 8 * 2 * NCHUNK));
        int upto = 0;
        struct LSet { u32x4 t[10]; float graw; } A, B;
#define GS_ISSUE(X, ci_) do { const int ci2 = (ci_); if (ci2 < NCHUNK) { int row0, step; gdn_rows(bl, dir, ci2, row0, step); \
        if (ci2 >= upto) { const int we_ = (upto + 12 < NCHUNK) ? upto + 12 : NCHUNK; const GAS unsigned* fl_ = gflag + chain * NCHUNK + ((upto + (lt & 63) < we_) ? upto + (lt & 63) : we_ - 1); unsigned sp_ = 0; \
          while (!__all(__hip_atomic_load(fl_, RLX_AGENT) != 0u) && ++sp_ < (1u << 22)) __builtin_amdgcn_s_sleep(1); \
          __builtin_amdgcn_fence(__ATOMIC_ACQUIRE, "agent"); upto = we_; }        \
        const unsigned char* gp = F.GPRE() + (size_t)(chain * NCHUNK + ci2) * GPRE_CHUNK; \
        _Pragma("unroll") for (int i = 0; i < 2; ++i) { const int p = lt + 256 * i, row = p >> 3, pc = p & 7; \
            X.t[i] = __builtin_nontemporal_load((const u32x4*)(gp + row * 128 + pc * 16)); X.t[2 + i] = __builtin_nontemporal_load((const u32x4*)(gp + 8192 + row * 128 + pc * 16)); X.t[4 + i] = __builtin_nontemporal_load((const u32x4*)(gp + 16384 + row * 128 + pc * 16)); \
            const size_t rr = (size_t)(row0 + step * row) * 512 + h * 64 + pc * 8; X.t[6 + i] = *(const u32x4*)(F.GQ() + rr); X.t[8 + i] = *(const u32x4*)(F.GK() + rr); } \
        X.graw = (lt < 64) ? F.GCB()[(size_t)(chain * NCHUNK + ci2) * 64 + lt] : 0.f; } } while (0)
#define GS_PERM(base, row, pc, v) do { const int pos_ = ((pc) >> 2) * 32 + ((pc) & 1) * 16 + (((pc) & 2) ? 4 : 0); LAS unsigned char* d_ = (base) + (row) * 144 + pos_ * 2; \
        *(LAS u32x2*)d_ = (u32x2){(v).x, (v).y}; *(LAS u32x2*)(d_ + 16) = (u32x2){(v).z, (v).w}; } while (0)
#define GS_WRITE(X, ci_) do { const int ci2 = (ci_); if (ci2 < NCHUNK) { LAS unsigned char* buf = F.lds + (ci2 & 1) * GS_BUF; \
        _Pragma("unroll") for (int i = 0; i < 2; ++i) { const int p = lt + 256 * i, row = p >> 3, pc = p & 7; \
            GS_PERM(buf + GS_WM, row, pc, X.t[i]); GS_PERM(buf + GS_QK, row, pc, X.t[2 + i]); *(LAS u32x4*)(buf + GS_U + row * 128 + pc * 16) = X.t[4 + i]; \
            GS_PERM(buf + GS_Q, row, pc, X.t[6 + i]); *(LAS u32x4*)(buf + GS_K + row * 144 + pc * 16) = X.t[8 + i]; } \
        if (lt < 64) { const float gcv = X.graw; const float gl = __builtin_bit_cast(float, __builtin_amdgcn_readlane(__builtin_bit_cast(int, gcv), 63)); \
            ((LAS float*)(buf + GS_GC))[lt] = gcv; ((LAS float*)(buf + GS_EG))[lt] = __expf(gcv); ((LAS float*)(buf + GS_ED))[lt] = __expf(gl - gcv); } } } while (0)
#define GS_FLUSH(ci_) do { const int ci2 = (ci_); if (ci2 >= 0) { const LAS unsigned char* ob = F.lds + GS_OUT + (ci2 & 1) * 8192; int row0, step; gdn_rows(bl, dir, ci2, row0, step); \
        _Pragma("unroll") for (int i = 0; i < 2; ++i) { const int p = lt + 256 * i, row = p >> 3, pc = p & 7; \
            *(u32x4*)(Od + (size_t)(row0 + step * row) * 512 + h * 64 + pc * 8) = *(const LAS u32x4*)(ob + row * 128 + pc * 16); } } } while (0)
        bf16_t* Od = dir ? F.OB() : F.OF();
        GS_ISSUE(A, 0); GS_ISSUE(B, 1); GS_WRITE(A, 0); GS_ISSUE(A, 2);
        asm volatile("s_waitcnt lgkmcnt(0)" ::: "memory"); __builtin_amdgcn_s_barrier();
        for (int ci = 0; ci < NCHUNK; ci += 2) {
            GS_FLUSH(ci - 1); GS_WRITE(B, ci + 1); GS_ISSUE(B, ci + 3); asm volatile("s_waitcnt lgkmcnt(0)" ::: "memory"); __builtin_amdgcn_s_barrier();
            GS_FLUSH(ci); GS_WRITE(A, ci + 2); GS_ISSUE(A, ci + 4); asm volatile("s_waitcnt lgkmcnt(0)" ::: "memory"); __builtin_amdgcn_s_barrier();
        }
        GS_FLUSH(NCHUNK - 1);
#undef GS_ISSUE
#undef GS_WRITE
#undef GS_PERM
#undef GS_FLUSH
    } else {
        f32x4 S[4];
#pragma unroll
        for (int mt = 0; mt < 4; ++mt) S[mt] = (f32x4){0.f, 0.f, 0.f, 0.f};
        __builtin_amdgcn_s_barrier();
        for (int ci = 0; ci < NCHUNK; ++ci) {
            const LAS unsigned char* buf = F.lds + (ci & 1) * GS_BUF; const LAS float* gc = (const LAS float*)(buf + GS_GC);
            int row0, step; gdn_rows(bl, dir, ci, row0, step);
            bf16x8 aW[4][2], aQ[4][2]; f32x4 uin[4], eg[4], ed[4];
            const float gcl = gc[63];
#pragma unroll
            for (int mt = 0; mt < 4; ++mt) {
#pragma unroll
                for (int ks = 0; ks < 2; ++ks) { aW[mt][ks] = gs_ldA(buf + GS_WM, 16 * mt + n, ks, g); aQ[mt][ks] = gs_ldA(buf + GS_Q, 16 * mt + n, ks, g); }
#pragma unroll
                for (int r = 0; r < 4; ++r) uin[mt][r] = bf2f(*(const LAS bf16_t*)(buf + GS_U + (16 * mt + 4 * g + r) * 128 + (16 * wq + n) * 2));
                eg[mt] = *(const LAS f32x4*)(buf + GS_EG + (16 * mt + 4 * g) * 4); ed[mt] = *(const LAS f32x4*)(buf + GS_ED + (16 * mt + 4 * g) * 4); }
            const float cd = __expf(gcl);
            __builtin_amdgcn_sched_barrier(0);
            bf16x8 Sb[2]; Sb[0] = gs_pack(S[0], S[1]); Sb[1] = gs_pack(S[2], S[3]);
            f32x4 vn[4], o[4];
#pragma unroll
            for (int mt = 0; mt < 4; ++mt) { vn[mt] = __builtin_amdgcn_mfma_f32_16x16x32_bf16(aW[mt][0], Sb[0], uin[mt], 0, 0, 0); o[mt] = __builtin_amdgcn_mfma_f32_16x16x32_bf16(aQ[mt][0], Sb[0], (f32x4){0.f, 0.f, 0.f, 0.f}, 0, 0, 0); }
#pragma unroll
            for (int mt = 0; mt < 4; ++mt) { vn[mt] = __builtin_amdgcn_mfma_f32_16x16x32_bf16(aW[mt][1], Sb[1], vn[mt], 0, 0, 0); o[mt] = __builtin_amdgcn_mfma_f32_16x16x32_bf16(aQ[mt][1], Sb[1], o[mt], 0, 0, 0); }
            __builtin_amdgcn_sched_barrier(0);
            bf16x8 aQK[4][2], aK[4][2];
#pragma unroll
            for (int mt = 0; mt < 4; ++mt)
#pragma unroll
                for (int ks = 0; ks < 2; ++ks) { aQK[mt][ks] = gs_ldA(buf + GS_QK, 16 * mt + n, ks, g); aK[mt][ks] = gs_ldKT(buf + GS_K, mt, ks, g, n); }
            __builtin_amdgcn_sched_barrier(0);
#pragma unroll
            for (int mt = 0; mt < 4; ++mt) o[mt] = o[mt] * eg[mt];
            bf16x8 Vb[2]; Vb[0] = gs_pack(vn[0], vn[1]); Vb[1] = gs_pack(vn[2], vn[3]);
#pragma unroll
            for (int mt = 0; mt < 4; ++mt) vn[mt] = vn[mt] * ed[mt];
            bf16x8 Vd[2]; Vd[0] = gs_pack(vn[0], vn[1]); Vd[1] = gs_pack(vn[2], vn[3]);
#pragma unroll
            for (int mt = 0; mt < 4; ++mt) { o[mt] = __builtin_amdgcn_mfma_f32_16x16x32_bf16(aQK[mt][0], Vb[0], o[mt], 0, 0, 0); S[mt] = __builtin_amdgcn_mfma_f32_16x16x32_bf16(aK[mt][0], Vd[0], S[mt] * cd, 0, 0, 0); }
#pragma unroll
            for (int mt = 0; mt < 4; ++mt) { o[mt] = __builtin_amdgcn_mfma_f32_16x16x32_bf16(aQK[mt][1], Vb[1], o[mt], 0, 0, 0); S[mt] = __builtin_amdgcn_mfma_f32_16x16x32_bf16(aK[mt][1], Vd[1], S[mt], 0, 0, 0); }
#pragma unroll
            for (int mt = 0; mt < 4; ++mt)
#pragma unroll
                for (int r = 0; r < 4; ++r) { const int c = 16 * mt + 4 * g + r; *(LAS bf16_t*)(F.lds + GS_OUT + (ci & 1) * 8192 + c * 128 + (16 * wq + n) * 2) = (bf16_t)f2bf(o[mt][r]); }
            asm volatile("s_waitcnt lgkmcnt(0)" ::: "memory"); __builtin_amdgcn_s_barrier();
        }
    }
    __syncthreads();
}

__device__ __forceinline__ void attn_mla_phase(Frame& F, int vcu) {
    for (int i = 0;; ++i) {
        const int U = i * F.G + vcu; if (U >= GB * 8 * 32 + GB * 8) break;
        int bl, h, q0, seq;
        if (U < GB * 8 * 32) { const int bh = U >> 5; bl = bh >> 3; h = bh & 7; q0 = CTXL + 256 * (U & 31); seq = TT; }
        else { const int cu = U - GB * 8 * 32; bl = cu >> 3; h = cu & 7; q0 = 0; seq = CTXL; }
        const size_t rb = (size_t)bl * TT;
        att::attn_unit<96, 64>(F.QR() + (rb + q0) * 768 + h * 96, 768, F.KV() + rb * 1024 + h * 128, 1024, F.KPE() + rb * 32, F.KV() + rb * 1024 + h * 128 + 64, 1024,
                               F.HB() + (rb + q0) * DM + h * 64, DM, seq, F.ldsg, F.tid, F.TAB8(), (seq == TT) ? q0 - CTXL : -1);
    }
}
__device__ __forceinline__ void attn_l1_phase(Frame& F, int vcu, const int grp, const float* gkn) {
    float kd2[8]; float kg2;
    { const float* tb = (const float*)(F.ctl + CW_KMAX) + (size_t)grp * 256 * 8;
#pragma unroll
      for (int v = 0; v < 8; ++v) { float m = 0.f;
#pragma unroll
          for (int i = 0; i < 4; ++i) m = fmaxf(m, tb[(F.lane * 4 + i) * 8 + v]);
          m = red_max<64>(m);
          kd2[v] = (F.G == 256) ? __builtin_bit_cast(float, __builtin_amdgcn_readfirstlane(__builtin_bit_cast(int, m))) : -1.f; }
      float g = gkn[F.lane] * gkn[F.lane];
      g = red_max<64>(g);
      kg2 = 64.f * __builtin_bit_cast(float, __builtin_amdgcn_readfirstlane(__builtin_bit_cast(int, g))); }
    for (int i = 0;; ++i) {
        const int U = i * F.G + vcu; if (U >= GB * 8 * 32) break;
        const int bh = U >> 5, bl = bh >> 3, vh = bh & 7, hd = vh >> 1, q0 = CTXL + 256 * (U & 31); const size_t rb = (size_t)bl * TT;
        float kb = kd2[0];
#pragma unroll
        for (int v = 1; v < 8; ++v) kb = (vh == v) ? kd2[v] : kb;
        att::attn_unit<64, 128>(F.PB() + (rb + q0) * OD_IN + P1_DQ + vh * 64, OD_IN, F.PB() + rb * OD_IN + P1_DK + vh * 64, OD_IN, nullptr, F.PB() + rb * OD_IN + P1_DV + hd * 128, OD_IN,
                                F.KV() + (rb + q0) * DM + vh * 128, DM, TT, F.ldsg, F.tid, nullptr, -1, kb);
    }
    int tid2 = F.tid; asm volatile("" : "+v"(tid2));
    for (int i = 0;; ++i) {
        const int U = i * F.G + vcu; if (U >= GB * 8 * 32) break;
        const int bh = U >> 5, bl = bh >> 3, hq = bh & 7, kvh = hq >> 2, q0 = CTXL + 256 * (U & 31); const size_t rb = (size_t)bl * TT;
        att::attn_unit<64, 64>(F.PB() + (rb + q0) * OD_IN + P1_GQ + hq * 64, OD_IN, F.PB() + rb * OD_IN + P1_GK + kvh * 64, OD_IN, nullptr, F.PB() + rb * OD_IN + P1_GV + kvh * 64, OD_IN,
                               F.HB() + (rb + q0) * DM + 512 + hq * 64, DM, TT, F.ldsg, tid2, nullptr, -1, kg2);
    }
}

#ifndef PHMASK
#define PHMASK 0xffffffffu
#endif
#ifndef DUPMASK
#define DUPMASK 0u
#endif
#define RUNS(k) (1 + (int)((DUPMASK >> (k)) & 1u))
struct Args { const float* in[29]; float* out; unsigned char* ws; int do_pro, g_lo, g_hi, ph_lo, ph_hi, li, pad0, pad1; };
constexpr int NPH = 22;
__global__ void __launch_bounds__(NTHREADS, 2) mega_fwd(Args args) {
    extern __shared__ __attribute__((aligned(16))) unsigned char lds[];
    Frame F;
    F.lds = (LAS unsigned char*)lds; F.ldsg = (char*)lds;
    F.MISC = (volatile LAS unsigned*)(F.lds + LDSCTL_OFF);
    F.tid = threadIdx.x; F.lane = F.tid & 63; F.wave = __builtin_amdgcn_readfirstlane(F.tid >> 6); const int wave_s = F.wave;
    F.G = gridDim.x; F.gw = blockIdx.x * NWAVES + F.wave; F.NGW = F.G * NWAVES;
    unsigned char* ws = args.ws; F.ws = ws; F.ctl = (unsigned*)(F.ws + WS_CTL); F.X = args.out;
    for (int u = F.tid; u < (LDS_BYTES - LDSCTL_OFF) / 4; u += NTHREADS) ((LAS unsigned*)(F.lds + LDSCTL_OFF))[u] = 0u;
    __syncthreads();
    XcdBarrier bar = xcd_barrier_post((unsigned*)(F.ctl + CW_BAR) + args.li * XCD_BAR_WORDS, F.MISC + 8);
#define GRID_BAR() xcd_barrier(bar)
#define RETID() do { int t_ = F.tid; asm volatile("" : "+v"(t_)); F.tid = t_; } while (0)
#ifndef CTX_SPLITK
#define CTX_SPLITK (grp != 0)
#endif
#ifndef MOE_TAIL_SPLIT
#define MOE_TAIL_SPLIT 1
#endif
#ifndef WGM_N1024
#define WGM_N1024 4
#endif
#ifndef WGM_MOEGU
#define WGM_MOEGU 4
#endif
#ifndef WGM_MOED
#define WGM_MOED 4
#endif
#ifndef WGM_FFNGU
#define WGM_FFNGU 4
#endif
#ifndef WGM_WIN
#define WGM_WIN 4
#endif
#define KA(i) ((const float*)(const GAS float*)ka[i])
    typedef const float* const __attribute__((address_space(4)))* kaptr_t; kaptr_t ka;
#define REFRESH() int bx; do { int w_ = wave_s; asm volatile("" : "+s"(w_)); int l_; asm volatile("v_mbcnt_lo_u32_b32 %0, -1, 0\n\tv_mbcnt_hi_u32_b32 %0, -1, %0" : "=v"(l_)); bx = blockIdx.x; asm volatile("" : "+s"(bx)); GAS unsigned char* ws_ = (GAS unsigned char*)args.ws; asm volatile("" : "+s"(ws_)); GAS float* o_ = (GAS float*)args.out; asm volatile("" : "+s"(o_)); F.ws = (unsigned char*)ws_; F.ctl = (unsigned*)ws_; F.X = (float*)o_; ka = (kaptr_t)__builtin_amdgcn_kernarg_segment_ptr(); asm volatile("" : "+s"(ka)); F.tid = w_ * 64 + l_; F.lane = l_; F.wave = w_; F.gw = bx * NWAVES + w_; } while (0)
    LAS unsigned char* ring = F.lds;

    if (((PHMASK >> 0) & 1u) && args.do_pro) { const ProIn I{args.in[7], args.in[10], args.in[11], args.in[16], args.in[17], args.in[18], args.in[19], args.in[24], args.in[26], args.in[27], args.in[1], args.in[3], args.in[4], args.in[5]};
        for (int rep_ = 0; rep_ < RUNS(0); ++rep_) { p0_prologue(F, I); __syncthreads(); } GRID_BAR();
        if (!I8_STRIP) { p0_deferred_gu(F, args.in[26], 0, MOE_DEFER_GU, (int)blockIdx.x, F.G, args.in[7], args.in[17], args.in[19]); GRID_BAR(); } }

    for (int grp = args.g_lo; grp < args.g_hi; ++grp) {
#ifdef MK_SPLIT
        const int lo = args.ph_lo, hi = args.ph_hi;
#else
        constexpr int lo = 1, hi = NPH + 1;
#endif
#define IN(k) (((PHMASK >> (k)) & 1u) && lo <= (k) && (k) < hi)
#define SEAM(k) do { if ((k) + 1 < hi || ((k) + 1 == hi && grp + 1 < args.g_hi)) { GRID_BAR(); if (RUNS(25) == 2) GRID_BAR(); } } while (0)
        if (IN(1)) { for (int rep_ = 0; rep_ < RUNS(1); ++rep_) { REFRESH(); norm_pass<true, false, I8_WIN0 != 0>(F, grp, 0, 0, KA(6), KA(0), KA(2), nullptr); } SEAM(1); }
        if (IN(2)) { for (int rep_ = 0; rep_ < RUNS(2); ++rep_) { REFRESH(); pg8::Gemm g{F.HB(), (const bf16_t*)(F.ws + WS_WI0), RROWS, EV_INP, 1024, 1024, 1024}; pg8::StaticOrder S; S.init(RROWS, EV_INP, F.G, bx, 0, WGM_WIN);
            if (I8_WIN0) { pg8::EpiBf16I8 E{F.PB(), EV_INP, F.SATOK(), F.SWD2()}; pg8::gemm_phase<pg8::EpiBf16I8, pg8::StaticOrder, true, true, true>(ring, g, S, E, F.tid); }
            else { pg8::EpiBf16 E{F.PB(), EV_INP}; pg8::gemm_phase<pg8::EpiBf16, pg8::StaticOrder>(ring, g, S, E, F.tid); } } SEAM(2); }
        if (IN(3)) { if (RUNS(3) == 2) { REFRESH(); fix_even(F, KA(8), KA(9), KA(12), KA(13), KA(14), 1, true); __syncthreads(); } { REFRESH(); fix_even(F, KA(8), KA(9), KA(12), KA(13), KA(14), RUNS(24)); } SEAM(3); }
        if (IN(5)) { REFRESH();
            if (bx < GB * 16) { gdn_scan(F, bx, grp); }
            else { const int G2 = F.G - GB * 16, c2 = bx - GB * 16;
              gdn_pre(F, c2, G2, grp); RETID(); F.lane = F.tid & 63;
              { pg8::Gemm g{F.PB() + PC_CQ, (const bf16_t*)(F.ws + WS_WUQ), RROWS, 768, 384, EV_INP, 384}; pg8::StaticOrder S; S.init(RROWS, 768, G2, c2);
                pg8::EpiBf16 E{F.QR(), 768}; pg8::gemm_phase<pg8::EpiBf16, pg8::StaticOrder>(ring, g, S, E, F.tid); } RETID();
              { pg8::Gemm g{F.PB() + PC_CKV, (const bf16_t*)(F.ws + WS_WUKV), RROWS, 1024, 256, EV_INP, 256}; pg8::StaticOrder S; S.init(RROWS, 1024, G2, c2);
                pg8::EpiBf16 E{F.KV(), 1024}; pg8::gemm_phase<pg8::EpiBf16, pg8::StaticOrder>(ring, g, S, E, F.tid); }
              if (grp == 0 && args.do_pro) { RETID(); F.lane = F.tid & 63; p0_deferred(F, KA(26), KA(27), c2, G2); if (F.G != 256 || CTX_SPLITK) p0_deferred_gu(F, KA(26), MOE_DEFER_GU, 8, c2, G2); } }
            SEAM(5); }
        if (IN(6)) { for (int rep_ = 0; rep_ < RUNS(6); ++rep_) { REFRESH();
            attn_mla_phase(F, (F.G % 8 == 0) ? (bx % 8) * (F.G / 8) + bx / 8 : bx);
            } SEAM(6); }
        if (IN(7)) { for (int rep_ = 0; rep_ < RUNS(7); ++rep_) { REFRESH(); gdn_out(F, KA(15)); } SEAM(7); }
        if (IN(8)) { for (int rep_ = 0; rep_ < RUNS(8); ++rep_) { REFRESH(); if (CTX_SPLITK) { pg8::Gemm gc{F.HB(), (const bf16_t*)(F.ws + WS_WO0), RROWS, 1024, 256, 1024, 1024}; pg8::CtxSplitOrder SC; SC.init(4, F.G, bx);
              pg8::EpiCtxPartial EC{F.PART()}; pg8::gemm_phase<pg8::EpiCtxPartial, pg8::CtxSplitOrder>(ring, gc, SC, EC, F.tid); } RETID();
            pg8::Gemm g{F.HB(), (const bf16_t*)(F.ws + WS_WO0), RROWS, 1024, 1024, 1024, 1024}; pg8::StaticOrder S; if (CTX_SPLITK) S.init(GB * 32 * 256, 1024, F.G, bx, 1); else S.init(RROWS, 1024, F.G, bx, 0, WGM_N1024);
            pg8::EpiResid E{F.X16(), F.CX(), rep_ ? (const float*)(F.ws + 512 * 1024) : F.MOD(), 2, grp, 0}; pg8::gemm_phase<pg8::EpiResid, pg8::StaticOrder>(ring, g, S, E, F.tid);
            if (!CTX_SPLITK && grp == 0 && args.do_pro && rep_ == 0 && bx >= 16 && F.G == 256) { RETID(); F.lane = F.tid & 63; p0_deferred_gu(F, KA(26), 3, 4, bx - 16, F.G - 16); } } SEAM(8); }
        if (IN(9)) { for (int rep_ = 0; rep_ < RUNS(9); ++rep_) { REFRESH(); norm_pass<false, false, I8_GU0 != 0>(F, grp, 0, 1, KA(6), nullptr, nullptr, nullptr, CTX_SPLITK ? F.PART() : nullptr, 4, 2, F.MOD()); } SEAM(9); }
        if (IN(10)) { for (int rep_ = 0; rep_ < RUNS(10); ++rep_) { REFRESH(); pg8::Gemm g{F.HB(), (const bf16_t*)(F.ws + WS_WGU0), RROWS, 2 * FFN, 1024, 1024, 1024}; pg8::StaticOrder S; S.init(RROWS, 2 * FFN, F.G, bx, 0, WGM_FFNGU);
            if (I8_GU0) { pg8::EpiSwiGLUI8 E{F.PB(), FFN, F.SATOK(), F.SWD2() + EV_INP}; pg8::gemm_phase<pg8::EpiSwiGLUI8, pg8::StaticOrder, true, true, true>(ring, g, S, E, F.tid); }
            else { pg8::EpiSwiGLU E{F.PB(), FFN}; pg8::gemm_phase<pg8::EpiSwiGLU, pg8::StaticOrder>(ring, g, S, E, F.tid); } } SEAM(10); }
        if (IN(11)) { for (int rep_ = 0; rep_ < RUNS(11); ++rep_) { REFRESH(); if (CTX_SPLITK) { pg8::Gemm gc{F.PB(), (const bf16_t*)(F.ws + WS_WD0), RROWS, 1024, 256, FFN, FFN}; pg8::CtxSplitOrder SC; SC.init(FFN / 256, F.G, bx);
              pg8::EpiCtxPartial EC{F.PART()}; pg8::gemm_phase<pg8::EpiCtxPartial, pg8::CtxSplitOrder>(ring, gc, SC, EC, F.tid); } RETID();
            pg8::Gemm g{F.PB(), (const bf16_t*)(F.ws + WS_WD0), RROWS, 1024, FFN, FFN, FFN}; pg8::StaticOrder S; if (CTX_SPLITK) S.init(GB * 32 * 256, 1024, F.G, bx, 1); else S.init(RROWS, 1024, F.G, bx, 0, WGM_N1024);
            pg8::EpiResid E{F.X16(), F.CX(), rep_ ? (const float*)(F.ws + 512 * 1024) : F.MOD(), 5, grp, 0}; pg8::gemm_phase<pg8::EpiResid, pg8::StaticOrder>(ring, g, S, E, F.tid);
            if (!CTX_SPLITK && grp == 0 && args.do_pro && rep_ == 0 && bx >= 16 && F.G == 256) { RETID(); F.lane = F.tid & 63; p0_deferred_gu(F, KA(26), 4, 8, bx - 16, F.G - 16); } } SEAM(11); }
        if (IN(12)) { for (int rep_ = 0; rep_ < RUNS(12); ++rep_) { REFRESH(); norm_pass<false, false, I8_WIN1 != 0>(F, grp, 1, 0, KA(6), nullptr, nullptr, nullptr, CTX_SPLITK ? F.PART() : nullptr, FFN / 256, 5, F.MOD()); } SEAM(12); }
        if (IN(13)) { for (int rep_ = 0; rep_ < RUNS(13); ++rep_) { REFRESH(); pg8::Gemm g{F.HB(), (const bf16_t*)(F.ws + WS_WI1), RROWS, OD_IN, 1024, 1024, 1024}; pg8::StaticOrder S; S.init(RROWS, OD_IN, F.G, bx, 0, WGM_WIN);
            if (I8_WIN1) { pg8::EpiBf16I8 E{F.PB(), OD_IN, F.SATOK(), F.SWD2() + EV_INP + 2 * FFN}; pg8::gemm_phase<pg8::EpiBf16I8, pg8::StaticOrder, true, true, true>(ring, g, S, E, F.tid); }
            else { pg8::EpiBf16 E{F.PB(), OD_IN}; pg8::gemm_phase<pg8::EpiBf16, pg8::StaticOrder>(ring, g, S, E, F.tid); } } SEAM(13); }
        if (IN(14)) { if (RUNS(14) == 2) { REFRESH(); fix_odd(F, KA(22), KA(23), grp, true); } { REFRESH(); fix_odd(F, KA(22), KA(23), grp); } SEAM(14); }
        if (IN(15)) { for (int rep_ = 0; rep_ < RUNS(15); ++rep_) { REFRESH(); attn_l1_phase(F, (F.G % 8 == 0) ? (bx % 8) * (F.G / 8) + bx / 8 : bx, grp, KA(23)); } SEAM(15); }
        if (IN(16)) { for (int rep_ = 0; rep_ < RUNS(16); ++rep_) { REFRESH(); diff_post(F, KA(20), KA(21)); } SEAM(16); }
        if (IN(17)) { for (int rep_ = 0; rep_ < RUNS(17); ++rep_) { REFRESH(); pg8::Gemm g{F.HB(), (const bf16_t*)(F.ws + WS_WO1), RROWS, 1024, 1024, 1024, 1024}; pg8::StaticOrder S; S.init(GB * 32 * 256, 1024, F.G, bx, 1, WGM_N1024);
            pg8::EpiResid E{F.X16(), F.CX(), rep_ ? (const float*)(F.ws + 512 * 1024) : F.MOD() + 9 * MOD_ROW, 2, grp, 1}; pg8::gemm_phase<pg8::EpiResid, pg8::StaticOrder>(ring, g, S, E, F.tid); } SEAM(17); }
        if (IN(18)) { if (RUNS(18) == 2) { REFRESH(); norm_pass<false, true>(F, grp, 1, 1, KA(6), nullptr, nullptr, KA(25), nullptr, 0, 0, nullptr, true); __syncthreads(); } { REFRESH(); norm_pass<false, true>(F, grp, 1, 1, KA(6), nullptr, nullptr, KA(25)); } SEAM(18); }
        if (IN(19)) { REFRESH(); moe_tends(F, grp); if (RUNS(19) == 2) { moe_gather(F, grp, true); GRID_BAR(); } moe_gather(F, grp); SEAM(19); }
        if (IN(20)) { for (int rep_ = 0; rep_ < RUNS(20); ++rep_) { REFRESH(); moe_tends(F, grp); const int ntile = (int)F.MISC[23];
            pg8::Gemm g{F.HB(), (const bf16_t*)(F.ws + WS_WGU1), ntile * 256, 2 * EXD, 1024, 1024, 1024, (const int*)((const signed char*)F.XG() + (size_t)MOE_ROWS * DM + (size_t)MOE_ROWS * 4)}; pg8::StaticOrder S; S.init(ntile * 256, 2 * EXD, F.G, bx, 0, WGM_MOEGU);
            S.tend = (const int*)(lds + LDSCTL_OFF + 16 * 4); S.estride = (size_t)2 * EXD * 1024;
            pg8::EpiSwiGLUI8 E{F.ACT1(), EXD, (const float*)((const signed char*)F.XG() + (size_t)MOE_ROWS * DM), F.SWD()}; pg8::gemm_phase<pg8::EpiSwiGLUI8, pg8::StaticOrder, true, true, true, true>(ring, g, S, E, F.tid); } SEAM(20); }
        if (IN(21)) { for (int rep_ = 0; rep_ < RUNS(21); ++rep_) { REFRESH(); moe_tends(F, grp); const int ntile = (int)F.MISC[23];
            const int nmain = MOE_TAIL_SPLIT ? (ntile < 256 ? ntile : 256) : ntile;
            { pg8::Gemm g{F.ACT1(), (const bf16_t*)(F.ws + WS_WD1), nmain * 256, 1024, EXD, EXD, EXD}; pg8::StaticOrder S; S.init(nmain * 256, 1024, F.G, bx, 0, WGM_MOED);
              S.tend = (const int*)(lds + LDSCTL_OFF + 16 * 4); S.estride = (size_t)1024 * EXD * 2;
              pg8::EpiBf16 E{F.XG(), 1024}; pg8::gemm_phase<pg8::EpiBf16, pg8::StaticOrder>(ring, g, S, E, F.tid); }
            if (ntile > nmain) { RETID();
              pg8::Gemm g{F.ACT1(), (const bf16_t*)(F.ws + WS_WD1), ntile * 256, 1024, EXD / 4, EXD, EXD}; pg8::MoeTailOrder T; T.init(ntile - nmain, F.G, bx);
              T.tend = (const int*)(lds + LDSCTL_OFF + 16 * 4); T.estride = (size_t)1024 * EXD * 2;
              pg8::EpiBf16K4 E{F.XG(), F.HB()}; pg8::gemm_phase<pg8::EpiBf16K4, pg8::MoeTailOrder>(ring, g, T, E, F.tid); } } SEAM(21); }
        if (IN(22)) { if (RUNS(22) == 2) { REFRESH(); final_pass(F, grp, KA(28), true); } { REFRESH(); final_pass(F, grp, KA(28)); } SEAM(22); }
#undef IN
#undef SEAM
    }
}

extern "C" void kernel_launch(void* const* d_in, const int* in_sizes, int n_in, void* d_out, int out_size, void* d_ws, size_t ws_size, hipStream_t stream) {
    static int grid = 0;
    if (grid == 0) {
        if (n_in != 29 || out_size != NBATCH * SEQ * DM || ws_size < WS_END) { fprintf(stderr, "kernel_launch: unexpected shapes: n_in %d out %d ws %zu (need %zu)\n", n_in, out_size, ws_size, (size_t)WS_END); grid = -1; return; }
        int dev = 0, cus = 0, per_cu = 0;
        if (hipGetDevice(&dev) != hipSuccess || hipDeviceGetAttribute(&cus, hipDeviceAttributeMultiprocessorCount, dev) != hipSuccess) { grid = -1; return; }
        if (hipFuncSetAttribute((const void*)mega_fwd, hipFuncAttributeMaxDynamicSharedMemorySize, LDS_BYTES) != hipSuccess) { fprintf(stderr, "kernel_launch: hipFuncSetAttribute failed\n"); grid = -1; return; }
        if (hipOccupancyMaxActiveBlocksPerMultiprocessor(&per_cu, (const void*)mega_fwd, NTHREADS, LDS_BYTES) != hipSuccess || per_cu < 1) { fprintf(stderr, "kernel_launch: occupancy query says %d\n", per_cu); }
        (void)hipGetLastError();
        grid = cus;
    }
    if (grid < 0) return;
    (void)hipMemsetAsync((char*)d_ws + WS_CTL, 0, CTL_BYTES, stream);
    Args a{};
    for (int i = 0; i < 29; ++i) a.in[i] = (const float*)d_in[i];
    a.out = (float*)d_out; a.ws = (unsigned char*)d_ws;
#ifndef MK_SPLIT
    a.do_pro = 1; a.g_lo = 0; a.g_hi = NGRP; a.ph_lo = 1; a.ph_hi = NPH + 1; a.li = 0;
    hipLaunchKernelGGL(mega_fwd, dim3(grid), dim3(NTHREADS), LDS_BYTES, stream, a);
#else
    a.li = 0;
    a.do_pro = 1; a.g_lo = 0; a.g_hi = 0; a.ph_lo = 1; a.ph_hi = 1;
    hipLaunchKernelGGL(mega_fwd, dim3(grid), dim3(NTHREADS), LDS_BYTES, stream, a);
    for (int g = 0; g < NGRP; ++g) for (int ph = 1; ph <= NPH; ++ph) { a.do_pro = 0; a.g_lo = g; a.g_hi = g + 1; a.ph_lo = ph; a.ph_hi = ph + 1;
        hipLaunchKernelGGL(mega_fwd, dim3(grid), dim3(NTHREADS), LDS_BYTES, stream, a); }
#endif
}
```
